# Optimizing an MI355X kernel written in HIP

```python
import jax, jax.numpy as jnp
from jax import lax
import numpy as np

D_MODEL = 1024
BATCH = 2
SEQ = 8192
DEPTH = 2

CHUNK = 64
N_MIXERS = 2
PLE_DIM = 256
EPS = 1e-6
POOL_WINDOWS = (2, 4, 8, 16)
POOL_GROUPS = len(POOL_WINDOWS)
POOL_GROUP_DIM = D_MODEL // POOL_GROUPS
MLA_HEADS = 8
Q_LORA = 384
KV_LORA = 256
NOPE_DIM = 128
ROPE_DIM = 64
V_DIM = 128
QK_DIM = NOPE_DIM + ROPE_DIM
ROPE_THETA = 10000.0
Q_BLOCK = 128
N_EXPERTS = 32
TOP_K = 4
D_FF = 1024
SWIGLU_LIMIT = 7.0
SWIGLU_ALPHA = 1.702
N_POOL_LAYERS = (DEPTH + 1) // 2
N_MLA_LAYERS = DEPTH // 2

kernel_name = "hybrid_pool_mla_moe_ple_trunk"


def rmsnorm(x, g):
    xf = x.astype(jnp.float32)
    out = xf * lax.rsqrt(jnp.mean(xf * xf, axis=-1, keepdims=True) + EPS) * g.astype(jnp.float32)
    return out.astype(x.dtype)


def pool_mixer(h, w, scale):
    B, S, D = h.shape
    hf = h.astype(jnp.float32)
    csum = jnp.concatenate([jnp.zeros((B, 1, D), jnp.float32), jnp.cumsum(hf, axis=1)], axis=1)
    pos1 = jnp.arange(1, S + 1)
    outs = []
    for g, win in enumerate(POOL_WINDOWS):
        sl = slice(g * POOL_GROUP_DIM, (g + 1) * POOL_GROUP_DIM)
        cg = csum[:, :, sl]
        lagged = jnp.concatenate([jnp.zeros((B, win, POOL_GROUP_DIM), jnp.float32), cg[:, :S + 1 - win]], axis=1)
        window_sum = cg[:, 1:] - lagged[:, 1:]
        count = jnp.minimum(pos1, win).astype(jnp.float32)[None, :, None]
        diff = (window_sum / count - hf[:, :, sl]).astype(h.dtype)
        outs.append(jnp.einsum('bsc,cd->bsd', diff, w[g]))
    return jnp.concatenate(outs, axis=-1) * scale


def rope_tables(positions):
    half = ROPE_DIM // 2
    inv_freq = ROPE_THETA ** (-jnp.arange(half, dtype=jnp.float32) / half)
    ang = positions.astype(jnp.float32)[..., None] * inv_freq
    return jnp.cos(ang)[:, :, None, :], jnp.sin(ang)[:, :, None, :]


def apply_rope(x, cos, sin):
    half = ROPE_DIM // 2
    xf = x.astype(jnp.float32)
    x1, x2 = xf[..., :half], xf[..., half:]
    return jnp.concatenate([x1 * cos - x2 * sin, x2 * cos + x1 * sin], axis=-1).astype(x.dtype)


def chunk_causal_attention(q, k, v):
    B, S, H, _ = q.shape
    n_blk = S // Q_BLOCK
    scale = QK_DIM ** -0.5
    k_chunk = jnp.arange(S) // CHUNK
    q_blocks = q.reshape(B, n_blk, Q_BLOCK, H, QK_DIM).transpose(1, 0, 2, 3, 4)

    def one_block(args):
        qb, blk = args
        s = jnp.einsum('bqhd,bkhd->bhqk', qb, k, preferred_element_type=jnp.float32) * scale
        q_chunk = (blk * Q_BLOCK + jnp.arange(Q_BLOCK)) // CHUNK
        mask = k_chunk[None, :] <= q_chunk[:, None]
        s = jnp.where(mask[None, None], s, -jnp.inf)
        pr = jax.nn.softmax(s, axis=-1).astype(v.dtype)
        return jnp.einsum('bhqk,bkhd->bqhd', pr, v)

    o = lax.map(one_block, (q_blocks, jnp.arange(n_blk)))
    return o.transpose(1, 0, 2, 3, 4).reshape(B, S, H, V_DIM)


def mla_mixer(h, positions, w_in, q_norm, w_qb, kv_norm, w_kvb, qh_norm, kh_norm, w_o):
    B, S, _ = h.shape
    lat = h @ w_in
    q_lat = lat[..., :Q_LORA]
    kv_lat = lat[..., Q_LORA:Q_LORA + KV_LORA]
    k_rope = lat[..., Q_LORA + KV_LORA:]
    q = (rmsnorm(q_lat, q_norm) @ w_qb).reshape(B, S, MLA_HEADS, QK_DIM)
    kv = (rmsnorm(kv_lat, kv_norm) @ w_kvb).reshape(B, S, MLA_HEADS, NOPE_DIM + V_DIM)
    k_nope, v = kv[..., :NOPE_DIM], kv[..., NOPE_DIM:]
    k = jnp.concatenate([k_nope, jnp.broadcast_to(k_rope[:, :, None, :], (B, S, MLA_HEADS, ROPE_DIM))], axis=-1)
    q = rmsnorm(q, qh_norm)
    k = rmsnorm(k, kh_norm)
    cos, sin = rope_tables(positions)
    q = jnp.concatenate([q[..., :NOPE_DIM], apply_rope(q[..., NOPE_DIM:], cos, sin)], axis=-1)
    k = jnp.concatenate([k[..., :NOPE_DIM], apply_rope(k[..., NOPE_DIM:], cos, sin)], axis=-1)
    o = chunk_causal_attention(q, k, v)
    return o.reshape(B, S, MLA_HEADS * V_DIM) @ w_o


def moe(h, router_w, router_b, w_gu, b_gu, w_down, b_down):
    B, S, D = h.shape
    t = h.reshape(-1, D)
    logits = (t @ router_w).astype(jnp.float32) + router_b.astype(jnp.float32)
    top_v, top_i = lax.top_k(logits, TOP_K)
    gates = jax.nn.softmax(top_v, axis=-1)
    flat_e = top_i.reshape(-1)
    order = jnp.argsort(flat_e)
    e_sorted = flat_e[order]
    tok = order // TOP_K
    xs = t[tok]
    sizes = jnp.bincount(flat_e, length=N_EXPERTS).astype(jnp.int32)
    gu = lax.ragged_dot(xs, w_gu, sizes) + b_gu[e_sorted]
    gate = jnp.minimum(gu[:, :D_FF], SWIGLU_LIMIT)
    up = jnp.clip(gu[:, D_FF:], -SWIGLU_LIMIT, SWIGLU_LIMIT)
    act = (up + 1) * gate * jax.nn.sigmoid(SWIGLU_ALPHA * gate)
    out = lax.ragged_dot(act, w_down, sizes) + b_down[e_sorted]
    out = out * gates.reshape(-1)[order][:, None].astype(out.dtype)
    y = jnp.zeros_like(t).at[tok].add(out)
    return y.reshape(B, S, D)


def setup_inputs(seed: int = 0) -> dict:
    key = jax.random.key(seed)
    ks = iter(jax.random.split(key, 32))
    nrm = lambda shape, s: jax.random.normal(next(ks), shape, jnp.float32) * s
    gain = lambda shape: 1.0 + 0.05 * jax.random.normal(next(ks), shape, jnp.float32)
    NA, NB = N_POOL_LAYERS, N_MLA_LAYERS
    offset = jax.random.randint(next(ks), (BATCH, 1), 0, 4096, dtype=jnp.int32)
    positions = (offset + jnp.arange(SEQ, dtype=jnp.int32)[None, :]).astype(jnp.int32)
    return {
        "x": nrm((BATCH, SEQ, D_MODEL), 1.0),
        "p": nrm((DEPTH, BATCH, SEQ, PLE_DIM), 1.0),
        "positions": positions,
        "norm_mix": gain((DEPTH, D_MODEL)),
        "pool_w": nrm((NA, POOL_GROUPS, POOL_GROUP_DIM, POOL_GROUP_DIM), POOL_GROUP_DIM ** -0.5),
        "pool_scale": gain((NA, D_MODEL)),
        "mla_w_in": nrm((NB, D_MODEL, Q_LORA + KV_LORA + ROPE_DIM), D_MODEL ** -0.5),
        "mla_q_norm": gain((NB, Q_LORA)),
        "mla_w_qb": nrm((NB, Q_LORA, MLA_HEADS * QK_DIM), Q_LORA ** -0.5),
        "mla_kv_norm": gain((NB, KV_LORA)),
        "mla_w_kvb": nrm((NB, KV_LORA, MLA_HEADS * (NOPE_DIM + V_DIM)), KV_LORA ** -0.5),
        "mla_qh_norm": gain((NB, QK_DIM)),
        "mla_kh_norm": gain((NB, QK_DIM)),
        "mla_w_o": nrm((NB, MLA_HEADS * V_DIM, D_MODEL), (MLA_HEADS * V_DIM) ** -0.5),
        "norm_ffn": gain((DEPTH, D_MODEL)),
        "router_w": nrm((DEPTH, D_MODEL, N_EXPERTS), D_MODEL ** -0.5),
        "router_b": nrm((DEPTH, N_EXPERTS), 0.01),
        "w_gate_up": nrm((DEPTH, N_EXPERTS, D_MODEL, 2 * D_FF), D_MODEL ** -0.5),
        "b_gate_up": nrm((DEPTH, N_EXPERTS, 2 * D_FF), 0.02),
        "w_down": nrm((DEPTH, N_EXPERTS, D_FF, D_MODEL), D_FF ** -0.5),
        "b_down": nrm((DEPTH, N_EXPERTS, D_MODEL), 0.02),
        "ple_norm": gain((DEPTH, D_MODEL)),
        "ple_gate_w": nrm((DEPTH, D_MODEL, D_MODEL), D_MODEL ** -0.5),
        "ple_proj_w": nrm((DEPTH, PLE_DIM, D_MODEL), PLE_DIM ** -0.5),
    }


def reference(x, p, positions, norm_mix, pool_w, pool_scale, mla_w_in, mla_q_norm, mla_w_qb,
              mla_kv_norm, mla_w_kvb, mla_qh_norm, mla_kh_norm, mla_w_o, norm_ffn, router_w,
              router_b, w_gate_up, b_gate_up, w_down, b_down, ple_norm, ple_gate_w, ple_proj_w):
    for i in range(DEPTH):
        h = rmsnorm(x, norm_mix[i])
        j = i // N_MIXERS
        if i % N_MIXERS == 0:
            x = x + pool_mixer(h, pool_w[j], pool_scale[j])
        else:
            x = x + mla_mixer(h, positions, mla_w_in[j], mla_q_norm[j], mla_w_qb[j], mla_kv_norm[j],
                              mla_w_kvb[j], mla_qh_norm[j], mla_kh_norm[j], mla_w_o[j])
        x = x + moe(rmsnorm(x, norm_ffn[i]), router_w[i], router_b[i], w_gate_up[i], b_gate_up[i],
                    w_down[i], b_down[i])
        ple_gate = jax.nn.sigmoid(rmsnorm(x, ple_norm[i]) @ ple_gate_w[i])
        x = x + ple_gate * (p[i] @ ple_proj_w[i])
    return x
```

```cpp
#include <hip/hip_runtime.h>
#include <cstdio>
#include <cstdint>

#ifndef MK_MULTI
#define MK_MULTI 1
#endif

#define LAS __attribute__((address_space(3)))
typedef unsigned short bf16_t;
typedef short bf16x8 __attribute__((ext_vector_type(8)));
typedef short s16x4 __attribute__((ext_vector_type(4)));
typedef float f32x2 __attribute__((ext_vector_type(2)));
typedef float f32x4 __attribute__((ext_vector_type(4)));
typedef float f32x16 __attribute__((ext_vector_type(16)));
typedef unsigned u32x2 __attribute__((ext_vector_type(2)));
typedef unsigned u32x4 __attribute__((ext_vector_type(4)));

constexpr int T = 16384, DM = 1024, SEQ = 8192, NE = 32, DFF = 1024, PLE = 256;
constexpr int NPAIR = T * 4;
constexpr int QL = 384, KVL = 256, NH = 8, QKD = 192, VD = 128, LATP = 768;
constexpr float EPS = 1e-6f;
constexpr int NTHREADS = 512;
constexpr int LDS_BYTES = 147456;
constexpr int MISC_OFF = 131072;
constexpr int BARW_OFF = LDS_BYTES - 16;
constexpr int NPHASE = 19;

enum { I_X = 0, I_P, I_POS, I_NORM_MIX, I_POOL_W, I_POOL_SCALE, I_W_IN, I_Q_NORM, I_W_QB, I_KV_NORM, I_W_KVB, I_QH_NORM, I_KH_NORM, I_W_O,
       I_NORM_FFN, I_ROUTER_W, I_ROUTER_B, I_W_GU, I_B_GU, I_W_DN, I_B_DN, I_PLE_NORM, I_PLE_GATE_W, I_PLE_PROJ_W, N_IN };

constexpr size_t al256(size_t x) { return (x + 255) & ~(size_t)255; }
constexpr size_t CTL_BYTES = 65536;
constexpr size_t WS_CTL  = 0;
constexpr size_t WS_WGU  = WS_CTL + CTL_BYTES;
constexpr size_t WS_WDN  = WS_WGU + (size_t)2 * 32 * 2048 * 1024 * 2;
constexpr size_t WS_WPG  = WS_WDN + (size_t)2 * 32 * 1024 * 1024 * 2;
constexpr size_t WS_WPP  = WS_WPG + (size_t)2 * 1024 * 1024 * 2;
constexpr size_t WS_WPOOL= WS_WPP + (size_t)2 * 1024 * 256 * 2;
constexpr size_t WS_WIN  = WS_WPOOL + (size_t)4 * 256 * 256 * 2;
constexpr size_t WS_WQB  = WS_WIN + (size_t)768 * 1024 * 2;
constexpr size_t WS_WKVB = WS_WQB + (size_t)1536 * 384 * 2;
constexpr size_t WS_WO   = WS_WKVB + (size_t)2048 * 256 * 2;
constexpr size_t WS_PB   = WS_WO + (size_t)1024 * 1024 * 2;
constexpr size_t WS_PP   = WS_PB + (size_t)2 * T * 256 * 2;
constexpr size_t WS_AB   = WS_PP + (size_t)2 * T * 1024 * 2;
constexpr size_t WS_X1   = WS_AB + (size_t)T * 1024 * 2;
constexpr size_t WS_X2   = WS_X1 + (size_t)T * 1024 * 4;
constexpr size_t WS_X3   = WS_X2 + (size_t)T * 1024 * 4;
constexpr size_t WS_HN   = WS_X3 + (size_t)T * 1024 * 4;
constexpr size_t WS_ACT  = WS_HN + (size_t)T * 1024 * 2;
constexpr size_t WS_SLOT = WS_ACT + (size_t)(NPAIR + 256) * 1024 * 2;
constexpr size_t WS_LIST = WS_SLOT + (size_t)NPAIR * 1024 * 2;
constexpr size_t WS_GATE = WS_LIST + (size_t)32 * T * 4;
constexpr size_t WS_LAT  = WS_GATE + (size_t)NPAIR * 4;
constexpr size_t WS_QN   = WS_LAT + (size_t)T * 768 * 4;
constexpr size_t WS_KVN  = WS_QN + (size_t)T * 384 * 2;
constexpr size_t WS_QF   = WS_KVN + (size_t)T * 256 * 2;
constexpr size_t WS_KVF  = WS_QF + (size_t)T * 1536 * 2;
constexpr size_t WS_Q    = WS_KVF + (size_t)T * 2048 * 2;
constexpr size_t WS_K    = WS_Q + (size_t)T * 8 * 192 * 2;
constexpr size_t WS_V    = WS_K + (size_t)T * 8 * 192 * 2;
constexpr size_t WS_END  = WS_V + (size_t)T * 8 * 128 * 2;
constexpr int CW_GCNT = 4096;

struct Params { const float* in[N_IN]; float* out; unsigned char* ws; int ph_lo, ph_hi; };

__device__ __forceinline__ unsigned cvt_pk_bf16(float lo, float hi) { unsigned r; asm volatile("v_cvt_pk_bf16_f32 %0, %1, %2" : "=v"(r) : "v"(lo), "v"(hi)); return r; }
__device__ __forceinline__ float bf_lo(unsigned w) { return __uint_as_float(w << 16); }
__device__ __forceinline__ float bf_hi(unsigned w) { return __uint_as_float(w & 0xffff0000u); }
__device__ __forceinline__ float wave_sum(float v) {
#pragma unroll
    for (int o = 32; o > 0; o >>= 1) v += __shfl_xor(v, o);
    return v;
}
__device__ __forceinline__ f32x4 ld4(const float* p) { return *(const f32x4*)p; }
__device__ __forceinline__ float sigmoidf_(float z) { return __builtin_amdgcn_rcpf(1.0f + __builtin_amdgcn_exp2f(-1.4426950408889634f * z)); }

#define XB_TMO      128
#define XB_XCNT(j)  (256  + 64 * (j))
#define XB_XSUB(j)  (1280 + 64 * (j))
#define XB_XGEN(j)  (2304 + 64 * (j))
#define XB_TOP      3328
#define XB_TOPGEN   3392
#define XCD_BAR_WORDS 3456
#define XB_SPIN_CAP (1u << 24)
__device__ __forceinline__ unsigned xb_ld(unsigned* p)              { return __hip_atomic_load(p, __ATOMIC_RELAXED, __HIP_MEMORY_SCOPE_AGENT); }
__device__ __forceinline__ unsigned xb_add(unsigned* p, unsigned v) { return __hip_atomic_fetch_add(p, v, __ATOMIC_RELAXED, __HIP_MEMORY_SCOPE_AGENT); }
__device__ __forceinline__ unsigned xb_xcc_id() { return (unsigned)__builtin_amdgcn_s_getreg((3 << 11) | 20) & 0xFu; }
#define XB_SPIN(cond, bar) do { unsigned _sp = 0; while (cond) { __builtin_amdgcn_s_sleep(1); \
    if ((++_sp & 255u) == 0u) { if (xb_ld(&(bar)[XB_TMO])) break; if (_sp > XB_SPIN_CAP) { atomicAdd(&(bar)[XB_TMO], 1u); break; } } } } while (0)
struct XcdBarrier { unsigned* bar; unsigned x; volatile LAS unsigned* st; };
__device__ __forceinline__ XcdBarrier xcd_barrier_post(unsigned* bar, volatile LAS unsigned* st) {
    XcdBarrier b; b.bar = bar; b.x = xb_xcc_id(); b.st = st;
    if (threadIdx.x == 0) (void)xb_add(&bar[XB_XCNT(b.x)], 1u);
    return b;
}
__device__ __forceinline__ void xcd_barrier_complete(unsigned* bar, unsigned x, unsigned& nloc, unsigned& nx) {
    const unsigned G = gridDim.x * gridDim.y * gridDim.z;
    unsigned sum, cnt, mine, sp = 0u;
    for (;;) {
        sum = 0u; cnt = 0u; mine = 0u;
#pragma unroll
        for (unsigned j = 0; j < 16; ++j) { const unsigned c = xb_ld(&bar[XB_XCNT(j)]); sum += c; cnt += (c > 0u) ? 1u : 0u; mine = (j == x) ? c : mine; }
        if (sum == G) break;
        __builtin_amdgcn_s_sleep(1);
        if ((++sp & 255u) == 0u) { if (xb_ld(&bar[XB_TMO])) break; if (sp > XB_SPIN_CAP) { atomicAdd(&bar[XB_TMO], 1u); break; } }
    }
    nloc = mine > 0u ? mine : 1u; nx = cnt > 0u ? cnt : 1u;
}
__device__ __forceinline__ void xcd_barrier(const XcdBarrier& b) {
    asm volatile("s_waitcnt vmcnt(0)" ::: "memory");
    __syncthreads();
    if (threadIdx.x == 0) {
        unsigned* bar = b.bar;
        __builtin_amdgcn_s_waitcnt(0);
        unsigned nloc = b.st[0], nx = b.st[1];
        if (nloc == 0u) { xcd_barrier_complete(bar, b.x, nloc, nx); b.st[0] = nloc; b.st[1] = nx; }
        const unsigned old = xb_add(&bar[XB_XSUB(b.x)], 1u);
        const unsigned gen = old / nloc;
        if (old + 1u == (gen + 1u) * nloc) {
            __builtin_amdgcn_fence(__ATOMIC_RELEASE, "agent");
            asm volatile("s_waitcnt vmcnt(0)" ::: "memory");
            const unsigned og = xb_add(&bar[XB_TOP], 1u);
            const unsigned tg = og / nx;
            if (og + 1u == (tg + 1u) * nx) xb_add(&bar[XB_TOPGEN], 1u);
            else XB_SPIN(xb_ld(&bar[XB_TOPGEN]) == tg, bar);
            __builtin_amdgcn_fence(__ATOMIC_ACQUIRE, "agent");
            xb_add(&bar[XB_XGEN(b.x)], 1u);
            asm volatile("s_waitcnt vmcnt(0)" ::: "memory");
        } else {
            XB_SPIN(xb_ld(&bar[XB_XGEN(b.x)]) == gen, bar);
            __builtin_amdgcn_fence(__ATOMIC_ACQUIRE, "agent");
            asm volatile("s_waitcnt vmcnt(0)" ::: "memory");
        }
    }
    __syncthreads();
}

constexpr int HTB = 16384;
__device__ __forceinline__ int lds_byte(int r, int c) { const int st = (r >> 4) * 2 + (c >> 5), rr = r & 15, cc = c & 31, ob = rr * 64 + cc * 2; return st * 1024 + (ob ^ (((ob >> 9) & 1) << 5)); }
__device__ __forceinline__ void stage_rc(int b, int& R, int& C) { const int st = b / 1024, sb = b % 1024, swz = sb ^ (((sb >> 9) & 1) << 5); R = (st >> 1) * 16 + swz / 64; C = (st & 1) * 32 + (swz % 64) / 2; }
#define SA_(b, h) (((b) * 2 + (h)) * HTB)
#define SB_(b, h) ((4 + (b) * 2 + (h)) * HTB)
#define G_STAGE(bufoff, gbase, voff) do { _Pragma("unroll") for (int _i = 0; _i < 2; ++_i) \
    __builtin_amdgcn_global_load_lds((const unsigned*)((gbase) + (voff)[_i]), (LAS unsigned*)(lds + (bufoff) + ldsw + _i * 8192), 16, 0, 0); } while (0)
#define G_LDA(dst, b, h) do { _Pragma("unroll") for (int m = 0; m < 4; ++m) _Pragma("unroll") for (int k = 0; k < 2; ++k) dst[m][k] = *(const LAS bf16x8*)(lds + SA_(b, h) + aoff + m * 2048 + k * 1024); } while (0)
#define G_LDB(dst, b, h) do { _Pragma("unroll") for (int n = 0; n < 2; ++n) _Pragma("unroll") for (int k = 0; k < 2; ++k) dst[n][k] = *(const LAS bf16x8*)(lds + SB_(b, h) + boff + n * 2048 + k * 1024); } while (0)
#define G_MMA(ai, bj, At, Bt) do { __builtin_amdgcn_s_setprio(1); _Pragma("unroll") for (int m = 0; m < 4; ++m) _Pragma("unroll") for (int n = 0; n < 2; ++n) _Pragma("unroll") for (int k = 0; k < 2; ++k) \
    acc[ai][bj][m][n] = __builtin_amdgcn_mfma_f32_16x16x32_bf16(Bt[n][k], At[m][k], acc[ai][bj][m][n], 0, 0, 0); __builtin_amdgcn_s_setprio(0); } while (0)
#define WAIT_V(n) asm volatile("s_waitcnt vmcnt(" #n ")" ::: "memory")
#define WAIT_L(n) asm volatile("s_waitcnt lgkmcnt(" #n ")" ::: "memory")
#define BAR __builtin_amdgcn_s_barrier()
#define SCHED __builtin_amdgcn_sched_barrier(0)

__device__ __forceinline__ void stage_coords(int tid, int (&R)[2], int (&C)[2]) { stage_rc(tid * 16, R[0], C[0]); stage_rc(tid * 16 + 8192, R[1], C[1]); }

template <class Epi>
__device__ __forceinline__ void gemm_unit(LAS unsigned char* lds, const char* Ab, const unsigned (&offA)[2][2], const char* Bb0, const char* Bb1,
                                          const unsigned (&offB)[2], const int nt, const Epi& epi) {
    const int tid = threadIdx.x, wid = __builtin_amdgcn_readfirstlane(tid >> 6), lane = tid & 63, wr = wid >> 2, wc = wid & 3, fr = lane & 15, fq = lane >> 4;
    const unsigned ldsw = (unsigned)wid * 1024u;
    const int aoff = lds_byte(wr * 64 + fr, fq * 8), boff = lds_byte(wc * 32 + fr, fq * 8);
    f32x4 acc[2][2][4][2];
#pragma unroll
    for (int a = 0; a < 2; ++a)
#pragma unroll
        for (int b = 0; b < 2; ++b)
#pragma unroll
            for (int m = 0; m < 4; ++m)
#pragma unroll
                for (int n = 0; n < 2; ++n) acc[a][b][m][n] = (f32x4){0.f, 0.f, 0.f, 0.f};
    bf16x8 At[4][2], B0[2][2], B1[2][2];
    G_STAGE(SB_(0, 0), Bb0, offB); G_STAGE(SA_(0, 0), Ab, offA[0]); G_STAGE(SB_(0, 1), Bb1, offB); G_STAGE(SA_(0, 1), Ab, offA[1]);
    if (wr == 1) BAR;
    WAIT_V(4); BAR;
    G_STAGE(SB_(1, 0), Bb0 + 128, offB); G_STAGE(SA_(1, 0), Ab + 128, offA[0]); G_STAGE(SB_(1, 1), Bb1 + 128, offB);
    WAIT_V(6); BAR;
    for (int t = 0; t < nt - 2; t += 2) {
        const char* a1 = Ab + (t + 1) * 128; const char* a2 = a1 + 128; const char* a3 = a2 + 128;
        const char* p0 = Bb0 + (t + 2) * 128; const char* p1 = Bb1 + (t + 2) * 128;
        G_LDB(B0, 0, 0); SCHED; G_LDA(At, 0, 0); G_STAGE(SA_(1, 1), a1, offA[1]);
        WAIT_L(8); BAR; WAIT_L(0); G_MMA(0, 0, At, B0); BAR; SCHED;
        G_LDB(B1, 0, 1); G_STAGE(SB_(0, 0), p0, offB);
        BAR; WAIT_L(0); G_MMA(0, 1, At, B1); BAR;
        G_LDA(At, 0, 1); G_STAGE(SA_(0, 0), a2, offA[0]);
        BAR; WAIT_L(0); G_MMA(1, 0, At, B0); BAR; SCHED;
        G_STAGE(SB_(0, 1), p1, offB);
        WAIT_V(6); BAR; G_MMA(1, 1, At, B1); BAR;
        G_LDB(B0, 1, 0); SCHED; G_LDA(At, 1, 0); G_STAGE(SA_(0, 1), a2, offA[1]);
        WAIT_L(8); BAR; WAIT_L(0); G_MMA(0, 0, At, B0); BAR; SCHED;
        G_LDB(B1, 1, 1); G_STAGE(SB_(1, 0), p0 + 128, offB);
        BAR; WAIT_L(0); G_MMA(0, 1, At, B1); BAR;
        G_LDA(At, 1, 1); G_STAGE(SA_(1, 0), a3, offA[0]);
        BAR; WAIT_L(0); G_MMA(1, 0, At, B0); BAR; SCHED;
        G_STAGE(SB_(1, 1), p1 + 128, offB);
        WAIT_V(6); BAR; G_MMA(1, 1, At, B1); BAR;
    }
    { G_LDB(B0, 0, 0); G_LDA(At, 0, 0); G_STAGE(SA_(1, 1), Ab + (nt - 1) * 128, offA[1]);
      BAR; WAIT_L(0); G_MMA(0, 0, At, B0); BAR;
      G_LDB(B1, 0, 1); BAR; WAIT_L(0); G_MMA(0, 1, At, B1); BAR;
      G_LDA(At, 0, 1); WAIT_V(4); BAR; WAIT_L(0); G_MMA(1, 0, At, B0); G_MMA(1, 1, At, B1); BAR; }
    { G_LDB(B0, 1, 0); G_LDA(At, 1, 0); WAIT_V(2); BAR; WAIT_L(0); G_MMA(0, 0, At, B0); BAR;
      G_LDB(B1, 1, 1); WAIT_V(0); BAR; WAIT_L(0); G_MMA(0, 1, At, B1); BAR;
      G_LDA(At, 1, 1); BAR; WAIT_L(0); G_MMA(1, 0, At, B0); G_MMA(1, 1, At, B1); BAR; }
    if (wr == 0) BAR;
    { int tz = threadIdx.x; asm volatile("" : "+v"(tz)); const int wz = __builtin_amdgcn_readfirstlane(tz >> 6), lz = tz & 63; epi(acc, wz >> 2, wz & 3, lz & 15, lz >> 4); }
    __syncthreads();
}

#define EPI_ROWS(ai, m) (ai * 128 + wr * 64 + m * 16 + fr)
#define EPI_COLS(bj, n) (bj * 128 + wc * 32 + n * 16 + fq * 4)
typedef const f32x4 (&AccRef)[2][2][4][2];

struct EpiPool {
    const float* x; const float* scale; float* o; int row0, col0;
    __device__ __forceinline__ void operator()(AccRef acc, int wr, int wc, int fr, int fq) const {
#pragma unroll
        for (int ai = 0; ai < 2; ++ai)
#pragma unroll
            for (int m = 0; m < 4; ++m) { const size_t ro = (size_t)(row0 + EPI_ROWS(ai, m)) * DM;
#pragma unroll
                for (int bj = 0; bj < 2; ++bj)
#pragma unroll
                    for (int n = 0; n < 2; ++n) { const int c = col0 + EPI_COLS(bj, n);
                        const f32x4 xv = ld4(x + ro + c), sc = ld4(scale + c); *(f32x4*)(o + ro + c) = xv + sc * acc[ai][bj][m][n]; }
                asm volatile("" ::: "memory"); }
    }
};
struct EpiRes {
    const float* base; float* o; int row0, col0;
    __device__ __forceinline__ void operator()(AccRef acc, int wr, int wc, int fr, int fq) const {
#pragma unroll
        for (int ai = 0; ai < 2; ++ai)
#pragma unroll
            for (int m = 0; m < 4; ++m) { const size_t ro = (size_t)(row0 + EPI_ROWS(ai, m)) * DM;
#pragma unroll
                for (int bj = 0; bj < 2; ++bj)
#pragma unroll
                    for (int n = 0; n < 2; ++n) { const int c = col0 + EPI_COLS(bj, n); *(f32x4*)(o + ro + c) = ld4(base + ro + c) + acc[ai][bj][m][n]; }
                asm volatile("" ::: "memory"); }
    }
};
struct EpiF32 {
    float* o; int ld, row0, col0;
    __device__ __forceinline__ void operator()(AccRef acc, int wr, int wc, int fr, int fq) const {
#pragma unroll
        for (int ai = 0; ai < 2; ++ai)
#pragma unroll
            for (int m = 0; m < 4; ++m) { const size_t ro = (size_t)(row0 + EPI_ROWS(ai, m)) * ld;
#pragma unroll
                for (int bj = 0; bj < 2; ++bj)
#pragma unroll
                    for (int n = 0; n < 2; ++n) { const int c = col0 + EPI_COLS(bj, n); *(f32x4*)(o + ro + c) = acc[ai][bj][m][n]; } }
    }
};
struct EpiBf16 {
    bf16_t* o; int ld, row0, col0;
    __device__ __forceinline__ void operator()(AccRef acc, int wr, int wc, int fr, int fq) const {
#pragma unroll
        for (int ai = 0; ai < 2; ++ai)
#pragma unroll
            for (int m = 0; m < 4; ++m) { const size_t ro = (size_t)(row0 + EPI_ROWS(ai, m)) * ld;
#pragma unroll
                for (int bj = 0; bj < 2; ++bj)
#pragma unroll
                    for (int n = 0; n < 2; ++n) { const int c = col0 + EPI_COLS(bj, n); const f32x4 v = acc[ai][bj][m][n];
                        u32x2 w; w.x = cvt_pk_bf16(v[0], v[1]); w.y = cvt_pk_bf16(v[2], v[3]); *(u32x2*)(o + ro + c) = w; } }
    }
};
struct EpiPle {
    const float* x2; const bf16_t* pp; float* o; int row0, col0;
    __device__ __forceinline__ void operator()(AccRef acc, int wr, int wc, int fr, int fq) const {
#pragma unroll
        for (int ai = 0; ai < 2; ++ai)
#pragma unroll
            for (int m = 0; m < 4; ++m) { const size_t ro = (size_t)(row0 + EPI_ROWS(ai, m)) * DM;
#pragma unroll
                for (int bj = 0; bj < 2; ++bj)
#pragma unroll
                    for (int n = 0; n < 2; ++n) { const int c = col0 + EPI_COLS(bj, n); const f32x4 a = acc[ai][bj][m][n];
                        const f32x4 xv = ld4(x2 + ro + c); const u32x2 pw = *(const u32x2*)(pp + ro + c);
                        f32x4 r; r[0] = xv[0] + sigmoidf_(a[0]) * bf_lo(pw.x); r[1] = xv[1] + sigmoidf_(a[1]) * bf_hi(pw.x);
                        r[2] = xv[2] + sigmoidf_(a[2]) * bf_lo(pw.y); r[3] = xv[3] + sigmoidf_(a[3]) * bf_hi(pw.y);
                        *(f32x4*)(o + ro + c) = r; }
                asm volatile("" ::: "memory"); }
    }
};
struct EpiMoe1 {
    const float* bg; const float* bu; bf16_t* act; int nv;
    __device__ __forceinline__ void operator()(AccRef acc, int wr, int wc, int fr, int fq) const {
#pragma unroll
        for (int ai = 0; ai < 2; ++ai)
#pragma unroll
            for (int m = 0; m < 4; ++m) { const int r = EPI_ROWS(ai, m);
                if (r < nv) {
#pragma unroll
                    for (int n = 0; n < 2; ++n) { const int c = wc * 32 + n * 16 + fq * 4;
                        const f32x4 g4 = acc[ai][0][m][n] + ld4(bg + c), u4 = acc[ai][1][m][n] + ld4(bu + c); float a[4];
#pragma unroll
                        for (int j = 0; j < 4; ++j) { const float g = fminf(g4[j], 7.0f), u = fminf(fmaxf(u4[j], -7.0f), 7.0f); a[j] = (u + 1.0f) * g * sigmoidf_(1.702f * g); }
                        u32x2 w; w.x = cvt_pk_bf16(a[0], a[1]); w.y = cvt_pk_bf16(a[2], a[3]); *(u32x2*)(act + (size_t)r * DFF + c) = w; } } }
    }
};
struct EpiMoe2 {
    const float* bd; const int* lst; const float* gate; bf16_t* slot; int nv, col0;
    __device__ __forceinline__ void operator()(AccRef acc, int wr, int wc, int fr, int fq) const {
#pragma unroll
        for (int ai = 0; ai < 2; ++ai)
#pragma unroll
            for (int m = 0; m < 4; ++m) { const int r = EPI_ROWS(ai, m);
                if (r < nv) { const int pair = lst[r]; const float g = gate[pair];
#pragma unroll
                    for (int bj = 0; bj < 2; ++bj)
#pragma unroll
                        for (int n = 0; n < 2; ++n) { const int c = col0 + EPI_COLS(bj, n); const f32x4 v = (acc[ai][bj][m][n] + ld4(bd + c)) * g;
                            u32x2 w; w.x = cvt_pk_bf16(v[0], v[1]); w.y = cvt_pk_bf16(v[2], v[3]); *(u32x2*)(slot + (size_t)pair * DM + c) = w; } } }
    }
};

__device__ __forceinline__ void offs_contig(const int (&R)[2], const int (&C)[2], unsigned ldaB, unsigned ldbB, unsigned (&offA)[2][2], unsigned (&offB)[2]) {
#pragma unroll
    for (int i = 0; i < 2; ++i) { offA[0][i] = (unsigned)R[i] * ldaB + C[i] * 2; offA[1][i] = (unsigned)(R[i] + 128) * ldaB + C[i] * 2; offB[i] = (unsigned)R[i] * ldbB + C[i] * 2; }
}

template <int N, int K>
__device__ __forceinline__ void tr_load(const float* __restrict__ src, int u, int r, int c4, f32x4 (&v)[8]) {
    constexpr int TN = (N + 255) / 256, TK = K / 64, PTM = TN * TK;
    const int mat = u / PTM, rem = u - mat * PTM, tn = rem / TK, tk = rem - tn * TK;
    const bool ok = (N % 256 == 0) || (tn * 256 + c4 < N);
    const float* s = src + (size_t)mat * K * N + (size_t)(tk * 64 + r) * N + (ok ? tn * 256 + c4 : 0);
#pragma unroll
    for (int p = 0; p < 8; ++p) { f32x4 t = ld4(s + (size_t)p * 8 * N); if (N % 256 != 0) { if (!ok) t = (f32x4){0.f, 0.f, 0.f, 0.f}; } v[p] = t; }
}
template <int N, int K>
__device__ __forceinline__ void transpose_seg(LAS unsigned char* lds, const float* __restrict__ src, bf16_t* __restrict__ dst, int nmat, int& rot) {
    constexpr int TN = (N + 255) / 256, TK = K / 64, PTM = TN * TK;
    const int G = gridDim.x, tid = threadIdx.x, total = nmat * PTM;
    LAS float* tile = (LAS float*)lds;
    const int r = tid >> 6, c4 = (tid & 63) * 4, nl = tid >> 1, kh = (tid & 1) * 32;
    int u = (int)blockIdx.x - rot; if (u < 0) u += G;
    f32x4 v[8];
    if (u < total) tr_load<N, K>(src, u, r, c4, v);
    while (u < total) {
#pragma unroll
        for (int p = 0; p < 8; ++p) *(LAS f32x4*)(tile + (p * 8 + r) * 260 + c4) = v[p];
        __syncthreads();
        const int mat = u / PTM, rem = u - mat * PTM, tn = rem / TK, tk = rem - tn * TK;
        const int un = u + G;
        if (un < total) tr_load<N, K>(src, un, r, c4, v);
        float w[32];
#pragma unroll
        for (int j = 0; j < 32; ++j) w[j] = tile[(kh + j) * 260 + nl];
        bf16_t* d = dst + ((size_t)mat * TN * 256 + tn * 256 + nl) * K + tk * 64 + kh;
#pragma unroll
        for (int q = 0; q < 4; ++q) { u32x4 o; o.x = cvt_pk_bf16(w[q * 8 + 0], w[q * 8 + 1]); o.y = cvt_pk_bf16(w[q * 8 + 2], w[q * 8 + 3]);
            o.z = cvt_pk_bf16(w[q * 8 + 4], w[q * 8 + 5]); o.w = cvt_pk_bf16(w[q * 8 + 6], w[q * 8 + 7]); *(u32x4*)(d + q * 8) = o; }
        __syncthreads();
        u = un;
    }
    rot = (rot + total) % G;
}
__device__ __forceinline__ void cvt_p_phase(const float* __restrict__ p, bf16_t* __restrict__ pb) {
    const size_t n8 = (size_t)2 * T * PLE / 8;
    for (size_t i = (size_t)blockIdx.x * NTHREADS + threadIdx.x; i < n8; i += (size_t)gridDim.x * NTHREADS) {
        const f32x4 a = ld4(p + i * 8), b = ld4(p + i * 8 + 4);
        u32x4 o; o.x = cvt_pk_bf16(a[0], a[1]); o.y = cvt_pk_bf16(a[2], a[3]); o.z = cvt_pk_bf16(b[0], b[1]); o.w = cvt_pk_bf16(b[2], b[3]);
        *(u32x4*)(pb + i * 8) = o;
    }
}
__device__ __forceinline__ void pool_diff_phase(LAS unsigned char* lds, const float* __restrict__ x, const float* __restrict__ g, bf16_t* __restrict__ diff) {
    LAS float* rs = (LAS float*)lds;
    const int tid = threadIdx.x, wid = tid >> 6, lane = tid & 63;
    const int c = tid * 2, win = 2 << (c >> 8);
    const f32x2 gv = *(const f32x2*)(g + c);
    for (int run = blockIdx.x; run < T / 32; run += gridDim.x) {
        const int t0 = run * 32, s0 = t0 % SEQ, back = s0 < 15 ? s0 : 15;
        __syncthreads();
        for (int r = 15 - back + wid; r < 47; r += 8) {
            const float* xr = x + (size_t)(t0 - 15 + r) * DM; float ss = 0.f;
#pragma unroll
            for (int q = 0; q < 4; ++q) { const f32x4 v = ld4(xr + q * 256 + lane * 4); ss += v[0] * v[0] + v[1] * v[1] + v[2] * v[2] + v[3] * v[3]; }
            ss = wave_sum(ss);
            if (lane == 0) rs[r] = rsqrtf(ss * (1.0f / DM) + EPS);
        }
        __syncthreads();
#define POOL_H(row) ((*(const f32x2*)(x + (size_t)(row) * DM + c)) * (rs[(row) - t0 + 15]) * gv)
        f32x2 W = (f32x2){0.f, 0.f};
        for (int j = 0; j < win; ++j) if (s0 - j >= 0) W += POOL_H(t0 - j);
        for (int i = 0; i < 32; ++i) {
            const int row = t0 + i, s = s0 + i;
            const f32x2 h = POOL_H(row);
            if (i > 0) { W += h; if (s - win >= 0) W -= POOL_H(row - win); }
            const int cnt = (s + 1 < win) ? s + 1 : win;
            const f32x2 d = W * (1.0f / (float)cnt) - h;
            *(unsigned*)(diff + (size_t)row * DM + c) = cvt_pk_bf16(d.x, d.y);
        }
#undef POOL_H
    }
}

__device__ __forceinline__ void rmsnorm_phase(const float* __restrict__ x, const float* __restrict__ g, bf16_t* __restrict__ o) {
    const int tid = threadIdx.x, wid = tid >> 6, lane = tid & 63;
    f32x4 gv[4];
#pragma unroll
    for (int q = 0; q < 4; ++q) gv[q] = ld4(g + q * 256 + lane * 4);
    for (int row = blockIdx.x * 8 + wid; row < T; row += gridDim.x * 8) {
        f32x4 v[4]; float ss = 0.f;
#pragma unroll
        for (int q = 0; q < 4; ++q) { v[q] = ld4(x + (size_t)row * DM + q * 256 + lane * 4); ss += v[q][0] * v[q][0] + v[q][1] * v[q][1] + v[q][2] * v[q][2] + v[q][3] * v[q][3]; }
        ss = wave_sum(ss); const float rstd = rsqrtf(ss * (1.0f / DM) + EPS);
#pragma unroll
        for (int q = 0; q < 4; ++q) { const f32x4 h = v[q] * rstd * gv[q]; u32x2 w; w.x = cvt_pk_bf16(h[0], h[1]); w.y = cvt_pk_bf16(h[2], h[3]);
            *(u32x2*)(o + (size_t)row * DM + q * 256 + lane * 4) = w; }
    }
}
__device__ __forceinline__ void combine_phase(const float* __restrict__ x1, const bf16_t* __restrict__ slot, const float* __restrict__ g, float* __restrict__ x2, bf16_t* __restrict__ hp) {
    const int tid = threadIdx.x, wid = tid >> 6, lane = tid & 63;
    f32x4 gv[4];
#pragma unroll
    for (int q = 0; q < 4; ++q) gv[q] = ld4(g + q * 256 + lane * 4);
    for (int row = blockIdx.x * 8 + wid; row < T; row += gridDim.x * 8) {
        f32x4 v[4]; float ss = 0.f;
#pragma unroll
        for (int q = 0; q < 4; ++q) { const int col = q * 256 + lane * 4; f32x4 a = ld4(x1 + (size_t)row * DM + col);
#pragma unroll
            for (int k = 0; k < 4; ++k) { const u32x2 w = *(const u32x2*)(slot + ((size_t)row * 4 + k) * DM + col); a[0] += bf_lo(w.x); a[1] += bf_hi(w.x); a[2] += bf_lo(w.y); a[3] += bf_hi(w.y); }
            v[q] = a; *(f32x4*)(x2 + (size_t)row * DM + col) = a; ss += a[0] * a[0] + a[1] * a[1] + a[2] * a[2] + a[3] * a[3]; }
        ss = wave_sum(ss); const float rstd = rsqrtf(ss * (1.0f / DM) + EPS);
#pragma unroll
        for (int q = 0; q < 4; ++q) { const f32x4 h = v[q] * rstd * gv[q]; u32x2 w; w.x = cvt_pk_bf16(h[0], h[1]); w.y = cvt_pk_bf16(h[2], h[3]);
            *(u32x2*)(hp + (size_t)row * DM + q * 256 + lane * 4) = w; }
    }
}
__device__ __forceinline__ void latnorm_phase(const float* __restrict__ lat, const float* __restrict__ qg, const float* __restrict__ kvg, bf16_t* __restrict__ qn, bf16_t* __restrict__ kvn) {
    const int tid = threadIdx.x, wid = tid >> 6, lane = tid & 63;
    f32x2 qgv[3];
#pragma unroll
    for (int j = 0; j < 3; ++j) qgv[j] = *(const f32x2*)(qg + j * 128 + lane * 2);
    const f32x4 kgv = ld4(kvg + lane * 4);
    for (int row = blockIdx.x * 8 + wid; row < T; row += gridDim.x * 8) {
        const float* l = lat + (size_t)row * LATP;
        f32x2 a[3]; float ss = 0.f;
#pragma unroll
        for (int j = 0; j < 3; ++j) { a[j] = *(const f32x2*)(l + j * 128 + lane * 2); ss += a[j].x * a[j].x + a[j].y * a[j].y; }
        const f32x4 kv = ld4(l + QL + lane * 4); float sk = kv[0] * kv[0] + kv[1] * kv[1] + kv[2] * kv[2] + kv[3] * kv[3];
        ss = wave_sum(ss); sk = wave_sum(sk);
        const float rq = rsqrtf(ss * (1.0f / QL) + EPS), rk = rsqrtf(sk * (1.0f / KVL) + EPS);
#pragma unroll
        for (int j = 0; j < 3; ++j) { const f32x2 h = a[j] * rq * qgv[j]; *(unsigned*)(qn + (size_t)row * QL + j * 128 + lane * 2) = cvt_pk_bf16(h.x, h.y); }
        const f32x4 hk = kv * rk * kgv; u32x2 w; w.x = cvt_pk_bf16(hk[0], hk[1]); w.y = cvt_pk_bf16(hk[2], hk[3]);
        *(u32x2*)(kvn + (size_t)row * KVL + lane * 4) = w;
    }
}
__device__ __forceinline__ void qkv_finalize_phase(const bf16_t* __restrict__ qf, const bf16_t* __restrict__ kvf, const float* __restrict__ lat, const int* __restrict__ pos,
                                                   const float* __restrict__ qhn, const float* __restrict__ khn, bf16_t* __restrict__ Q, bf16_t* __restrict__ K, bf16_t* __restrict__ V) {
    const int tid = threadIdx.x, wid = tid >> 6, lane = tid & 63;
    const bool act = lane < 48, isrope = lane >= 32 && lane < 48, hi2 = lane >= 40;
    const int l4 = (act ? lane : 0) * 4;
    const f32x4 qg = ld4(qhn + l4), kg = ld4(khn + l4);
    float inv[4];
#pragma unroll
    for (int j = 0; j < 4; ++j) inv[j] = exp2f(-(float)(((lane - 32) & 7) * 4 + j) * (13.287712379549449f / 32.0f));
    for (int tok = blockIdx.x * 8 + wid; tok < T; tok += gridDim.x * 8) {
        const int b = tok / SEQ, s = tok % SEQ;
        const float fp = (float)pos[tok];
        float cs[4], sn[4];
#pragma unroll
        for (int j = 0; j < 4; ++j) { const float ang = fp * inv[j]; double tr = (double)ang * 0.15915494309189535; tr -= __builtin_rint(tr); const float frv = (float)tr;
            cs[j] = __builtin_amdgcn_cosf(frv); sn[j] = __builtin_amdgcn_sinf(frv); }
        const f32x4 kr = isrope ? ld4(lat + (size_t)tok * LATP + QL + KVL + (lane - 32) * 4) : (f32x4){0.f, 0.f, 0.f, 0.f};
        for (int h = 0; h < NH; ++h) {
            const size_t orow = ((size_t)(b * NH + h) * SEQ + s);
            { const u32x2 w = *(const u32x2*)(qf + (size_t)tok * (NH * QKD) + h * QKD + l4);
              f32x4 v = (f32x4){bf_lo(w.x), bf_hi(w.x), bf_lo(w.y), bf_hi(w.y)}; if (!act) v = (f32x4){0.f, 0.f, 0.f, 0.f};
              const float ss = wave_sum(v[0] * v[0] + v[1] * v[1] + v[2] * v[2] + v[3] * v[3]); const float rstd = rsqrtf(ss * (1.0f / QKD) + EPS);
              v = v * rstd * qg; f32x4 o;
#pragma unroll
              for (int j = 0; j < 4; ++j) o[j] = __shfl_xor(v[j], 8);
              if (isrope) {
#pragma unroll
                  for (int j = 0; j < 4; ++j) v[j] = hi2 ? (v[j] * cs[j] + o[j] * sn[j]) : (v[j] * cs[j] - o[j] * sn[j]); }
              if (act) { u32x2 ow; ow.x = cvt_pk_bf16(v[0], v[1]); ow.y = cvt_pk_bf16(v[2], v[3]); *(u32x2*)(Q + orow * QKD + l4) = ow; } }
            { const u32x2 w = *(const u32x2*)(kvf + (size_t)tok * (NH * 256) + h * 256 + (lane & 31) * 4);
              f32x4 v = (f32x4){bf_lo(w.x), bf_hi(w.x), bf_lo(w.y), bf_hi(w.y)}; if (lane >= 32) v = kr;
              const float ss = wave_sum(v[0] * v[0] + v[1] * v[1] + v[2] * v[2] + v[3] * v[3]); const float rstd = rsqrtf(ss * (1.0f / QKD) + EPS);
              v = v * rstd * kg; f32x4 o;
#pragma unroll
              for (int j = 0; j < 4; ++j) o[j] = __shfl_xor(v[j], 8);
              if (isrope) {
#pragma unroll
                  for (int j = 0; j < 4; ++j) v[j] = hi2 ? (v[j] * cs[j] + o[j] * sn[j]) : (v[j] * cs[j] - o[j] * sn[j]); }
              if (act) { u32x2 ow; ow.x = cvt_pk_bf16(v[0], v[1]); ow.y = cvt_pk_bf16(v[2], v[3]); *(u32x2*)(K + orow * QKD + l4) = ow; } }
            if (lane < 32) *(u32x2*)(V + orow * VD + lane * 4) = *(const u32x2*)(kvf + (size_t)tok * (NH * 256) + h * 256 + 128 + lane * 4);
        }
    }
}

constexpr int RT_WT = 0, RT_PITCH = 1028, RT_HIST = 32 * RT_PITCH * 4, RT_BASE = RT_HIST + 128, RT_PE = RT_BASE + 128, RT_PRANK = RT_PE + 1024, RT_PGATE = RT_PRANK + 1024;
static_assert(RT_PGATE + 1024 <= BARW_OFF, "router LDS map");
__device__ __forceinline__ void route_phase(LAS unsigned char* lds, const float* __restrict__ x1, const float* __restrict__ g, const float* __restrict__ rw, const float* __restrict__ rb,
                                            bf16_t* __restrict__ hn, unsigned* gcnt, int* __restrict__ list, float* __restrict__ gate) {
    const int tid = threadIdx.x, wid = tid >> 6, lane = tid & 63;
    LAS float* Wt = (LAS float*)(lds + RT_WT);
    LAS int* hist = (LAS int*)(lds + RT_HIST); LAS int* sbase = (LAS int*)(lds + RT_BASE);
    LAS int* pe = (LAS int*)(lds + RT_PE); LAS int* prank = (LAS int*)(lds + RT_PRANK); LAS float* pgate = (LAS float*)(lds + RT_PGATE);
    __syncthreads();
    for (int it = 0; it < 16; ++it) { const int f4 = it * NTHREADS + tid, k = f4 >> 3, e0 = (f4 & 7) * 4; const f32x4 v = ld4(rw + (size_t)k * NE + e0);
#pragma unroll
        for (int j = 0; j < 4; ++j) Wt[(e0 + j) * RT_PITCH + k] = v[j]; }
    f32x4 gv[4];
#pragma unroll
    for (int q = 0; q < 4; ++q) gv[q] = ld4(g + q * 256 + lane * 4);
    const float bias = rb[lane & 31];
    for (int blk = blockIdx.x; blk < T / 64; blk += gridDim.x) {
        if (tid < 32) hist[tid] = 0;
        __syncthreads();
        for (int i = 0; i < 8; ++i) {
            const int tok = blk * 64 + wid * 8 + i;
            f32x4 h[4]; float ss = 0.f;
#pragma unroll
            for (int q = 0; q < 4; ++q) { h[q] = ld4(x1 + (size_t)tok * DM + q * 256 + lane * 4); ss += h[q][0] * h[q][0] + h[q][1] * h[q][1] + h[q][2] * h[q][2] + h[q][3] * h[q][3]; }
            ss = wave_sum(ss); const float rstd = rsqrtf(ss * (1.0f / DM) + EPS);
#pragma unroll
            for (int q = 0; q < 4; ++q) { h[q] = h[q] * rstd * gv[q]; u32x2 w; w.x = cvt_pk_bf16(h[q][0], h[q][1]); w.y = cvt_pk_bf16(h[q][2], h[q][3]);
                *(u32x2*)(hn + (size_t)tok * DM + q * 256 + lane * 4) = w; }
            float p[32];
#pragma unroll
            for (int e = 0; e < 32; ++e) { float a = 0.f;
#pragma unroll
                for (int q = 0; q < 4; ++q) { const f32x4 w = *(const LAS f32x4*)(Wt + e * RT_PITCH + q * 256 + lane * 4); a += h[q][0] * w[0] + h[q][1] * w[1] + h[q][2] * w[2] + h[q][3] * w[3]; }
                p[e] = a; }
#define RS_STEP(NV, MASK) { const bool up = (lane & MASK) != 0; _Pragma("unroll") for (int q = 0; q < NV; ++q) { const float keep = up ? p[NV + q] : p[q], send = up ? p[q] : p[NV + q]; p[q] = keep + __shfl_xor(send, MASK); } }
            RS_STEP(16, 16) RS_STEP(8, 8) RS_STEP(4, 4) RS_STEP(2, 2) RS_STEP(1, 1)
#undef RS_STEP
            float logit = p[0] + __shfl_xor(p[0], 32) + bias;
            const int me = lane & 31;
            float tv[4]; int ti[4];
#pragma unroll
            for (int r = 0; r < 4; ++r) { float bv = logit; int bi = me;
#pragma unroll
                for (int msk = 1; msk < 32; msk <<= 1) { const float ov = __shfl_xor(bv, msk); const int oi = __shfl_xor(bi, msk); if (ov > bv || (ov == bv && oi < bi)) { bv = ov; bi = oi; } }
                tv[r] = bv; ti[r] = bi; if (me == bi) logit = -3.0e38f; }
            const float e1 = __expf(tv[1] - tv[0]), e2 = __expf(tv[2] - tv[0]), e3 = __expf(tv[3] - tv[0]); const float isum = 1.0f / (1.0f + e1 + e2 + e3);
            if (lane < 4) { const int e = lane == 0 ? ti[0] : lane == 1 ? ti[1] : lane == 2 ? ti[2] : ti[3];
                const float gt = (lane == 0 ? 1.0f : lane == 1 ? e1 : lane == 2 ? e2 : e3) * isum;
                const int rank = __hip_atomic_fetch_add(hist + e, 1, __ATOMIC_RELAXED, __HIP_MEMORY_SCOPE_WORKGROUP);
                const int pl = (wid * 8 + i) * 4 + lane; pe[pl] = e; prank[pl] = rank; pgate[pl] = gt; }
        }
        __syncthreads();
        if (tid < 32) sbase[tid] = (int)__hip_atomic_fetch_add(gcnt + tid * 64, (unsigned)hist[tid], __ATOMIC_RELAXED, __HIP_MEMORY_SCOPE_AGENT);
        __syncthreads();
        if (tid < 256) { const int e = pe[tid], slot = sbase[e] + prank[tid], pair = (blk * 64 + (tid >> 2)) * 4 + (tid & 3); list[(size_t)e * T + slot] = pair; gate[pair] = pgate[tid]; }
        __syncthreads();
    }
}

constexpr int MO_CNT = MISC_OFF, MO_OFF = MISC_OFF + 128, MO_TP = MISC_OFF + 256, MO_TE = MISC_OFF + 512;
constexpr int MO_MAXT = 320;
__device__ __forceinline__ void moe_setup(LAS unsigned char* lds, unsigned* gcnt) {
    LAS int* cnt = (LAS int*)(lds + MO_CNT); LAS int* off = (LAS int*)(lds + MO_OFF); LAS int* tp = (LAS int*)(lds + MO_TP); LAS int* te = (LAS int*)(lds + MO_TE);
    const int tid = threadIdx.x;
    __syncthreads();
    if (tid < 32) cnt[tid] = (int)__hip_atomic_load(gcnt + tid * 64, __ATOMIC_RELAXED, __HIP_MEMORY_SCOPE_AGENT);
    __syncthreads();
    if (tid == 0) { int o = 0, t = 0; for (int e = 0; e < 32; ++e) { off[e] = o; tp[e] = t; o += cnt[e]; t += (cnt[e] + 255) >> 8; } tp[32] = t; }
    __syncthreads();
    if (tid < MO_MAXT) { int e = -1; for (int q = 0; q < 32; ++q) if (tp[q] <= tid && tid < tp[q + 1]) e = q; te[tid] = e; }
    __syncthreads();
}
__device__ __forceinline__ void moe_gemm1_phase(LAS unsigned char* lds, const bf16_t* __restrict__ hn, const bf16_t* __restrict__ wgu, const float* __restrict__ bgu, const int* __restrict__ list, bf16_t* __restrict__ actb) {
    LAS int* cnt = (LAS int*)(lds + MO_CNT); LAS int* off = (LAS int*)(lds + MO_OFF); LAS int* tp = (LAS int*)(lds + MO_TP); LAS int* te = (LAS int*)(lds + MO_TE);
    const int tid = threadIdx.x; int R[2], C[2]; stage_coords(tid, R, C);
    const int nunits = tp[32] * 8;
    for (int u = blockIdx.x; u < nunits; u += gridDim.x) {
        const int gt = u >> 3, nt8 = u & 7, e = te[gt], mt = gt - tp[e], nv = min(256, cnt[e] - mt * 256), p0 = off[e] + mt * 256;
        const int* lst = list + (size_t)e * T + mt * 256;
        unsigned offA[2][2], offB[2];
#pragma unroll
        for (int h = 0; h < 2; ++h)
#pragma unroll
            for (int i = 0; i < 2; ++i) { const int r = h * 128 + R[i]; const int pair = lst[r < nv ? r : 0]; offA[h][i] = (unsigned)(pair >> 2) * (DM * 2) + C[i] * 2; }
#pragma unroll
        for (int i = 0; i < 2; ++i) offB[i] = (unsigned)R[i] * (DM * 2) + C[i] * 2;
        const char* Bg = (const char*)(wgu + ((size_t)e * 2048 + nt8 * 128) * DM); const char* Bu = Bg + (size_t)1024 * DM * 2;
        EpiMoe1 E{bgu + e * 2048 + nt8 * 128, bgu + e * 2048 + 1024 + nt8 * 128, actb + (size_t)p0 * DFF + nt8 * 128, nv};
        gemm_unit(lds, (const char*)hn, offA, Bg, Bu, offB, DM / 64, E);
    }
}
__device__ __forceinline__ void moe_gemm2_phase(LAS unsigned char* lds, const bf16_t* __restrict__ actb, const bf16_t* __restrict__ wdn, const float* __restrict__ bdn, const int* __restrict__ list,
                                                const float* __restrict__ gate, bf16_t* __restrict__ slot) {
    LAS int* cnt = (LAS int*)(lds + MO_CNT); LAS int* off = (LAS int*)(lds + MO_OFF); LAS int* tp = (LAS int*)(lds + MO_TP); LAS int* te = (LAS int*)(lds + MO_TE);
    const int tid = threadIdx.x; int R[2], C[2]; stage_coords(tid, R, C);
    unsigned offA[2][2], offB[2]; offs_contig(R, C, DFF * 2, DFF * 2, offA, offB);
    const int nunits = tp[32] * 4;
    for (int u = blockIdx.x; u < nunits; u += gridDim.x) {
        const int gt = u >> 2, nt4 = u & 3, e = te[gt], mt = gt - tp[e], nv = min(256, cnt[e] - mt * 256), p0 = off[e] + mt * 256;
        const char* A = (const char*)(actb + (size_t)p0 * DFF);
        const char* B0 = (const char*)(wdn + ((size_t)e * 1024 + nt4 * 256) * DFF); const char* B1 = B0 + (size_t)128 * DFF * 2;
        EpiMoe2 E{bdn + e * DM, list + (size_t)e * T + mt * 256, gate, slot, nv, nt4 * 256};
        gemm_unit(lds, A, offA, B0, B1, offB, DFF / 64, E);
    }
}

constexpr int AT_VB = 64 * 128 * 2, AT_KB = 64 * 192 * 2, AT_V0 = 0, AT_K0 = 2 * AT_VB, AT_WS = AT_K0 + 2 * AT_KB;
constexpr float AT_SCALE = 0.07216878364870322f;
constexpr float AT_THR = 8.0f;
__device__ __forceinline__ int kswz(int row, int cb) { return row * 384 + (cb ^ (((row >> 1) & 7) << 4)); }
__device__ __forceinline__ int crow(int r, int hi) { return (r & 3) + 8 * (r >> 2) + 4 * hi; }
__device__ __forceinline__ int v_st(int k, int c) { const int kk = (k & ~0xC) | ((k & 4) << 1) | ((k & 8) >> 1); return ((kk >> 3) * 4 + (c >> 5)) * 512 + ((kk & 7) * 32 + (c & 31)) * 2; }
__device__ __forceinline__ int v_rd_base(int lane) { return ((lane & 3) << 3) | (((lane >> 2) & 3) << 6) | (((lane >> 4) & 1) << 5) | (((lane >> 5) & 1) << 8); }
constexpr int v_rd_off(int d0, int ks, int half) { return d0 * 512 + ks * 4096 + half * 2048; }
template <int OFF> __device__ __forceinline__ s16x4 tr_read(int vb) { s16x4 r; asm volatile("ds_read_b64_tr_b16 %0, %1 offset:%2" : "=&v"(r) : "v"(vb), "i"(OFF) : "memory"); return r; }
#define SBAR() __builtin_amdgcn_sched_barrier(0)

__device__ __forceinline__ void at_partialSM(f32x16& p0, f32x16& p1, float& m_reg, float& mn, float& alpha) {
    constexpr float C = AT_SCALE * 1.4426950408889634f;
    float pmax = p0[0];
#pragma unroll
    for (int r = 1; r < 16; ++r) pmax = fmaxf(pmax, p0[r]);
#pragma unroll
    for (int r = 0; r < 16; ++r) pmax = fmaxf(pmax, p1[r]);
    { auto rr = __builtin_amdgcn_permlane32_swap(__float_as_uint(pmax), __float_as_uint(pmax), false, false); pmax = fmaxf(__uint_as_float(rr[0]), __uint_as_float(rr[1])); }
    if (__builtin_expect(__all(pmax - m_reg <= AT_THR / AT_SCALE), 1)) { mn = m_reg; alpha = 1.f; }
    else { mn = fmaxf(m_reg, pmax); alpha = __builtin_amdgcn_exp2f((m_reg - mn) * C); m_reg = mn; }
    const float mnC = -mn * C;
#pragma unroll
    for (int r = 0; r < 16; ++r) p0[r] = fmaf(p0[r], C, mnC);
#pragma unroll
    for (int r = 0; r < 16; ++r) p1[r] = fmaf(p1[r], C, mnC);
#pragma unroll
    for (int r = 0; r < 16; ++r) p0[r] = __builtin_amdgcn_exp2f(p0[r]);
}
__device__ __forceinline__ void at_finishSM(f32x16& p0, f32x16& p1, float alpha, float& l_reg, bf16x8& pa0, bf16x8& pa1, bf16x8& pa2, bf16x8& pa3) {
#pragma unroll
    for (int r = 0; r < 16; ++r) p1[r] = __builtin_amdgcn_exp2f(p1[r]);
    float ps = 0;
#pragma unroll
    for (int r = 0; r < 16; ++r) ps += p0[r];
#pragma unroll
    for (int r = 0; r < 16; ++r) ps += p1[r];
    { auto rr = __builtin_amdgcn_permlane32_swap(__float_as_uint(ps), __float_as_uint(ps), false, false); ps = __uint_as_float(rr[0]) + __uint_as_float(rr[1]); }
    l_reg = l_reg * alpha + ps;
#define PK4(P, BASE, OUT) do { unsigned a0 = cvt_pk_bf16(P[BASE + 0], P[BASE + 1]), a1 = cvt_pk_bf16(P[BASE + 2], P[BASE + 3]); \
    unsigned b0 = cvt_pk_bf16(P[BASE + 4], P[BASE + 5]), b1 = cvt_pk_bf16(P[BASE + 6], P[BASE + 7]); \
    auto r0 = __builtin_amdgcn_permlane32_swap(a0, b0, false, false); auto r1 = __builtin_amdgcn_permlane32_swap(a1, b1, false, false); \
    u32x4 w = {r0[0], r1[0], r0[1], r1[1]}; OUT = *reinterpret_cast<bf16x8*>(&w); } while (0)
    PK4(p0, 0, pa0); PK4(p0, 8, pa1); PK4(p1, 0, pa2); PK4(p1, 8, pa3);
#undef PK4
}
__device__ __forceinline__ void at_qkt(f32x16& p0, f32x16& p1, const LAS unsigned char* Ks, const bf16x8 (&qr)[12], const int (&kb)[4], bool masked) {
    if (masked) {
#pragma unroll
        for (int r = 0; r < 16; ++r) { p0[r] = -1.0e30f; p1[r] = -1.0e30f; }
        return;
    }
#pragma unroll
    for (int r = 0; r < 16; ++r) { p0[r] = 0.f; p1[r] = 0.f; }
#pragma unroll
    for (int d0 = 0; d0 < 12; ++d0) {
        const bf16x8 b0 = *(const LAS bf16x8*)(Ks + kb[d0 & 3] + (d0 >> 2) * 128);
        const bf16x8 b1 = *(const LAS bf16x8*)(Ks + kb[d0 & 3] + (d0 >> 2) * 128 + 32 * 384);
        p0 = __builtin_amdgcn_mfma_f32_32x32x16_bf16(b0, qr[d0], p0, 0, 0, 0);
        p1 = __builtin_amdgcn_mfma_f32_32x32x16_bf16(b1, qr[d0], p1, 0, 0, 0); }
}
template <int D0> __device__ __forceinline__ void at_pv_one(f32x16& od, int vb, bf16x8 pa0, bf16x8 pa1, bf16x8 pa2, bf16x8 pa3) {
    const s16x4 l0 = tr_read<v_rd_off(D0, 0, 0)>(vb), h0 = tr_read<v_rd_off(D0, 0, 1)>(vb), l1 = tr_read<v_rd_off(D0, 1, 0)>(vb), h1 = tr_read<v_rd_off(D0, 1, 1)>(vb);
    const s16x4 l2 = tr_read<v_rd_off(D0, 2, 0)>(vb), h2 = tr_read<v_rd_off(D0, 2, 1)>(vb), l3 = tr_read<v_rd_off(D0, 3, 0)>(vb), h3 = tr_read<v_rd_off(D0, 3, 1)>(vb);
    asm volatile("s_waitcnt lgkmcnt(0)" ::: "memory"); SBAR();
#define PK(L, H) (bf16x8){L[0], L[1], L[2], L[3], H[0], H[1], H[2], H[3]}
    od = __builtin_amdgcn_mfma_f32_32x32x16_bf16(pa0, PK(l0, h0), od, 0, 0, 0);
    od = __builtin_amdgcn_mfma_f32_32x32x16_bf16(pa1, PK(l1, h1), od, 0, 0, 0);
    od = __builtin_amdgcn_mfma_f32_32x32x16_bf16(pa2, PK(l2, h2), od, 0, 0, 0);
    od = __builtin_amdgcn_mfma_f32_32x32x16_bf16(pa3, PK(l3, h3), od, 0, 0, 0);
#undef PK
}
__device__ __forceinline__ void at_pv(f32x16 (&o)[4], int vb, bf16x8 pa0, bf16x8 pa1, bf16x8 pa2, bf16x8 pa3) {
    at_pv_one<0>(o[0], vb, pa0, pa1, pa2, pa3); at_pv_one<1>(o[1], vb, pa0, pa1, pa2, pa3); at_pv_one<2>(o[2], vb, pa0, pa1, pa2, pa3); at_pv_one<3>(o[3], vb, pa0, pa1, pa2, pa3);
}
__device__ __forceinline__ void attn_unit(LAS unsigned char* lds, const bf16_t* __restrict__ Qb, const bf16_t* __restrict__ Kh, const bf16_t* __restrict__ Vh, bf16_t* __restrict__ Ob, const int qb) {
    const int tid = threadIdx.x, wid = __builtin_amdgcn_readfirstlane(tid >> 6), lane = tid & 63, r32 = lane & 31, hi = lane >> 5;
    LAS unsigned char* V_lds = lds + AT_V0; LAS unsigned char* K_lds = lds + AT_K0;
    LAS float* wsf = (LAS float*)(lds + AT_WS) + wid * 64; LAS float* li_l = wsf; LAS float* al_l = wsf + 32;
    float m_reg = -1e30f, l_reg = 0; f32x16 o[4]; bf16x8 qr[12];
#pragma unroll
    for (int d = 0; d < 4; ++d)
#pragma unroll
        for (int r = 0; r < 16; ++r) o[d][r] = 0.f;
    const bf16_t* Qw = Qb + (size_t)(wid * 32 + r32) * QKD + hi * 8;
#pragma unroll
    for (int d0 = 0; d0 < 12; ++d0) qr[d0] = *(const bf16x8*)(Qw + d0 * 16);
    const int NT = 4 * qb + 4, vis = 4 * qb + (wid >> 1);
    int kb[4];
#pragma unroll
    for (int j = 0; j < 4; ++j) kb[j] = r32 * 384 + ((((j << 1) | hi) ^ ((r32 >> 1) & 7)) << 4);
    const int sr = tid >> 4, sc = (tid & 15) * 8, vst0 = v_st(sr, sc);
    const int krow = tid >> 3, ks0 = tid & 7, kst0 = krow * 384 + ((ks0 ^ ((krow >> 1) & 7)) << 4);
    const int vb0 = (int)(unsigned)(size_t)V_lds + v_rd_base(lane);
    bf16x8 sv0, sv1, sk0, sk1, sk2;
#define SLOAD(k0) do { const bf16_t* vp = Vh + (size_t)(k0) * VD + tid * 8; const bf16_t* kp = Kh + (size_t)(k0) * QKD + krow * QKD + ks0 * 8; \
    sv0 = *(const bf16x8*)(vp); sv1 = *(const bf16x8*)(vp + 32 * VD); \
    sk0 = *(const bf16x8*)(kp); sk1 = *(const bf16x8*)(kp + 64); sk2 = *(const bf16x8*)(kp + 128); } while (0)
#define SWRITE(b) do { *(LAS bf16x8*)(V_lds + (b) * AT_VB + vst0) = sv0; *(LAS bf16x8*)(V_lds + (b) * AT_VB + vst0 + 8192) = sv1; \
    *(LAS bf16x8*)(K_lds + (b) * AT_KB + kst0) = sk0; *(LAS bf16x8*)(K_lds + (b) * AT_KB + kst0 + 128) = sk1; *(LAS bf16x8*)(K_lds + (b) * AT_KB + kst0 + 256) = sk2; } while (0)
#define RESC(a) do { if (__any((a) < 1.f)) { if (hi == 0) al_l[r32] = (a); asm volatile("s_waitcnt lgkmcnt(0)" ::: "memory"); \
    _Pragma("unroll") for (int d = 0; d < 4; ++d) _Pragma("unroll") for (int r = 0; r < 16; ++r) o[d][r] *= al_l[crow(r, hi)]; } } while (0)
    f32x16 p0, p1; float mn, al; bf16x8 pa0, pa1, pa2, pa3;
    SLOAD(0); SWRITE(0); __syncthreads();
    for (int j = 0; j < NT; ++j) {
        const int cur = j & 1;
        if (j + 1 < NT) SLOAD((j + 1) * 64);
        SBAR();
        at_qkt(p0, p1, K_lds + cur * AT_KB, qr, kb, j > vis);
        at_partialSM(p0, p1, m_reg, mn, al);
        RESC(al);
        at_finishSM(p0, p1, al, l_reg, pa0, pa1, pa2, pa3); SBAR();
        at_pv(o, vb0 + cur * AT_VB, pa0, pa1, pa2, pa3);
        if (j + 1 < NT) { if (cur) SWRITE(0); else SWRITE(1); }
        __syncthreads();
    }
    if (hi == 0) li_l[r32] = l_reg; asm volatile("s_waitcnt lgkmcnt(0)" ::: "memory");
    { int tz = threadIdx.x; asm volatile("" : "+v"(tz));
      const int lz = tz & 63, rz = lz & 31, hz = lz >> 5; const unsigned loff = (unsigned)(hz * 4 * DM + rz) * 2u;
      const char* Ow = (const char*)(Ob + (size_t)(wid * 32) * DM);
#pragma unroll
      for (int r = 0; r < 16; ++r) { const int rb = (r & 3) + 8 * (r >> 2); const float rl = __builtin_amdgcn_rcpf(li_l[rb + 4 * hz]);
          const char* Or = Ow + (size_t)rb * DM * 2;
#pragma unroll
          for (int d0 = 0; d0 < 4; ++d0) { const unsigned w = cvt_pk_bf16(o[d0][r] * rl, 0.f); *(bf16_t*)(Or + loff + d0 * 64) = (bf16_t)(w & 0xffffu); } } }
    __syncthreads();
#undef SLOAD
#undef SWRITE
#undef RESC
}
__device__ __forceinline__ void attn_phase(LAS unsigned char* lds, const bf16_t* __restrict__ Q, const bf16_t* __restrict__ K, const bf16_t* __restrict__ V, bf16_t* __restrict__ O) {
    for (int u = blockIdx.x; u < 256; u += gridDim.x) {
        const int bh = 2 * (u & 7) + ((u >> 3) >> 4), pi = (u >> 3) & 15, b = bh >> 3, h = bh & 7;
        const bf16_t* Kh = K + (size_t)bh * SEQ * QKD; const bf16_t* Vh = V + (size_t)bh * SEQ * VD;
#pragma unroll 1
        for (int half = 0; half < 2; ++half) {
            const int qb = half == 0 ? 31 - pi : pi;
            attn_unit(lds, Q + ((size_t)bh * SEQ + qb * 256) * QKD, Kh, Vh, O + ((size_t)b * SEQ + qb * 256) * DM + h * VD, qb);
        }
    }
}

__global__ void __launch_bounds__(NTHREADS, 2) mk_fwd(Params P) {
    extern __shared__ __attribute__((aligned(16))) unsigned char lds_raw[];
    LAS unsigned char* lds = (LAS unsigned char*)lds_raw;
    const int tid = threadIdx.x;
    unsigned char* ws = P.ws;
    unsigned* ctl = (unsigned*)(ws + WS_CTL);
    const int lo = P.ph_lo, hi = P.ph_hi;
    const bool multi = (hi - lo) > 1;
    if (tid == 0) { *(volatile LAS unsigned*)(lds + BARW_OFF) = 0u; *(volatile LAS unsigned*)(lds + BARW_OFF + 4) = 0u; }
    __syncthreads();
    XcdBarrier bar; bar.bar = ctl; bar.x = 0; bar.st = (volatile LAS unsigned*)(lds + BARW_OFF);
    if (multi) bar = xcd_barrier_post(ctl, (volatile LAS unsigned*)(lds + BARW_OFF));
#ifndef PH_MASK
#define PH_MASK 0x7FFFF
#endif
#define IN(k) ((((PH_MASK) >> (k)) & 1) && lo <= (k) && (k) < hi)
#define SEAM(k) do { if (IN(k) && IN((k) + 1)) xcd_barrier(bar); } while (0)

    bf16_t* WGU = (bf16_t*)(ws + WS_WGU); bf16_t* WDN = (bf16_t*)(ws + WS_WDN); bf16_t* WPG = (bf16_t*)(ws + WS_WPG); bf16_t* WPP = (bf16_t*)(ws + WS_WPP);
    bf16_t* WPOOL = (bf16_t*)(ws + WS_WPOOL); bf16_t* WIN = (bf16_t*)(ws + WS_WIN); bf16_t* WQB = (bf16_t*)(ws + WS_WQB); bf16_t* WKVB = (bf16_t*)(ws + WS_WKVB); bf16_t* WO = (bf16_t*)(ws + WS_WO);
    bf16_t* PB = (bf16_t*)(ws + WS_PB); bf16_t* PP = (bf16_t*)(ws + WS_PP); bf16_t* AB = (bf16_t*)(ws + WS_AB);
    float* X1 = (float*)(ws + WS_X1); float* X2 = (float*)(ws + WS_X2); float* X3 = (float*)(ws + WS_X3);
    bf16_t* HN = (bf16_t*)(ws + WS_HN); bf16_t* ACT = (bf16_t*)(ws + WS_ACT); bf16_t* SLOT = (bf16_t*)(ws + WS_SLOT);
    int* LIST = (int*)(ws + WS_LIST); float* GATE = (float*)(ws + WS_GATE); float* LAT = (float*)(ws + WS_LAT);
    bf16_t* QN = (bf16_t*)(ws + WS_QN); bf16_t* KVN = (bf16_t*)(ws + WS_KVN); bf16_t* QF = (bf16_t*)(ws + WS_QF); bf16_t* KVF = (bf16_t*)(ws + WS_KVF);
    bf16_t* QB = (bf16_t*)(ws + WS_Q); bf16_t* KB = (bf16_t*)(ws + WS_K); bf16_t* VB = (bf16_t*)(ws + WS_V);

    if (IN(0)) {
        int rot = 0;
        transpose_seg<2048, 1024>(lds, P.in[I_W_GU], WGU, 64, rot);
        transpose_seg<1024, 1024>(lds, P.in[I_W_DN], WDN, 64, rot);
        transpose_seg<1024, 1024>(lds, P.in[I_PLE_GATE_W], WPG, 2, rot);
        transpose_seg<1024, 256>(lds, P.in[I_PLE_PROJ_W], WPP, 2, rot);
        transpose_seg<256, 256>(lds, P.in[I_POOL_W], WPOOL, 4, rot);
        transpose_seg<704, 1024>(lds, P.in[I_W_IN], WIN, 1, rot);
        transpose_seg<1536, 384>(lds, P.in[I_W_QB], WQB, 1, rot);
        transpose_seg<2048, 256>(lds, P.in[I_W_KVB], WKVB, 1, rot);
        transpose_seg<1024, 1024>(lds, P.in[I_W_O], WO, 1, rot);
        cvt_p_phase(P.in[I_P], PB);
        pool_diff_phase(lds, P.in[I_X], P.in[I_NORM_MIX], AB);
    }
    SEAM(0);
    if (IN(1)) {
        int R[2], C[2]; stage_coords(tid, R, C);
        for (int u = blockIdx.x; u < 256; u += gridDim.x) {
            const int mt = u >> 2, g = u & 3; unsigned offA[2][2], offB[2]; offs_contig(R, C, DM * 2, 256 * 2, offA, offB);
            const char* A = (const char*)(AB + (size_t)mt * 256 * DM + g * 256); const char* B0 = (const char*)(WPOOL + (size_t)g * 256 * 256);
            EpiPool E{P.in[I_X], P.in[I_POOL_SCALE], X1, mt * 256, g * 256};
            gemm_unit(lds, A, offA, B0, B0 + 128 * 256 * 2, offB, 4, E);
        }
        for (int u = blockIdx.x; u < 512; u += gridDim.x) {
            const int l = u >> 8, mt = (u >> 2) & 63, n4 = u & 3; unsigned offA[2][2], offB[2]; offs_contig(R, C, PLE * 2, PLE * 2, offA, offB);
            const char* A = (const char*)(PB + ((size_t)l * T + mt * 256) * PLE); const char* B0 = (const char*)(WPP + ((size_t)l * 1024 + n4 * 256) * PLE);
            EpiBf16 E{PP + (size_t)l * T * DM, DM, mt * 256, n4 * 256};
            gemm_unit(lds, A, offA, B0, B0 + 128 * PLE * 2, offB, 4, E);
        }
    }
    SEAM(1);
#define MOE_PLE_LAYER(L, PH, XIN, XOUT) \
    if (IN(PH)) route_phase(lds, XIN, P.in[I_NORM_FFN] + (L) * DM, P.in[I_ROUTER_W] + (size_t)(L) * DM * NE, P.in[I_ROUTER_B] + (L) * NE, HN, ctl + CW_GCNT + (L) * 32 * 64, LIST, GATE); \
    SEAM(PH); \
    if (IN((PH) + 1)) { moe_setup(lds, ctl + CW_GCNT + (L) * 32 * 64); \
        moe_gemm1_phase(lds, HN, WGU + (size_t)(L) * 32 * 2048 * DM, P.in[I_B_GU] + (size_t)(L) * 32 * 2048, LIST, ACT); } \
    SEAM((PH) + 1); \
    if (IN((PH) + 2)) { moe_setup(lds, ctl + CW_GCNT + (L) * 32 * 64); \
        moe_gemm2_phase(lds, ACT, WDN + (size_t)(L) * 32 * 1024 * DFF, P.in[I_B_DN] + (size_t)(L) * 32 * DM, LIST, GATE, SLOT); } \
    SEAM((PH) + 2); \
    if (IN((PH) + 3)) combine_phase(XIN, SLOT, P.in[I_PLE_NORM] + (L) * DM, X2, AB); \
    SEAM((PH) + 3); \
    if (IN((PH) + 4)) { int R[2], C[2]; stage_coords(tid, R, C); unsigned offA[2][2], offB[2]; offs_contig(R, C, DM * 2, DM * 2, offA, offB); \
        for (int u = blockIdx.x; u < 256; u += gridDim.x) { const int mt = u >> 2, n4 = u & 3; \
            const char* A = (const char*)(AB + (size_t)mt * 256 * DM); const char* B0 = (const char*)(WPG + ((size_t)(L) * 1024 + n4 * 256) * DM); \
            EpiPle E{X2, PP + (size_t)(L) * T * DM, XOUT, mt * 256, n4 * 256}; \
            gemm_unit(lds, A, offA, B0, B0 + 128 * DM * 2, offB, 16, E); } }

    MOE_PLE_LAYER(0, 2, X1, X3)
    SEAM(6);
    if (IN(7)) rmsnorm_phase(X3, P.in[I_NORM_MIX] + DM, AB);
    SEAM(7);
    if (IN(8)) { int R[2], C[2]; stage_coords(tid, R, C); unsigned offA[2][2], offB[2]; offs_contig(R, C, DM * 2, DM * 2, offA, offB);
        for (int u = blockIdx.x; u < 192; u += gridDim.x) { const int mt = u / 3, n3 = u - mt * 3;
            const char* A = (const char*)(AB + (size_t)mt * 256 * DM); const char* B0 = (const char*)(WIN + (size_t)n3 * 256 * DM);
            EpiF32 E{LAT, LATP, mt * 256, n3 * 256};
            gemm_unit(lds, A, offA, B0, B0 + 128 * DM * 2, offB, 16, E); } }
    SEAM(8);
    if (IN(9)) latnorm_phase(LAT, P.in[I_Q_NORM], P.in[I_KV_NORM], QN, KVN);
    SEAM(9);
    if (IN(10)) { int R[2], C[2]; stage_coords(tid, R, C);
        for (int u = blockIdx.x; u < 896; u += gridDim.x) {
            unsigned offA[2][2], offB[2];
            if (u < 384) { const int mt = u / 6, n6 = u - mt * 6; offs_contig(R, C, QL * 2, QL * 2, offA, offB);
                const char* A = (const char*)(QN + (size_t)mt * 256 * QL); const char* B0 = (const char*)(WQB + (size_t)n6 * 256 * QL);
                EpiBf16 E{QF, NH * QKD, mt * 256, n6 * 256};
                gemm_unit(lds, A, offA, B0, B0 + 128 * QL * 2, offB, QL / 64, E);
            } else { const int v = u - 384, mt = v >> 3, n8 = v & 7; offs_contig(R, C, KVL * 2, KVL * 2, offA, offB);
                const char* A = (const char*)(KVN + (size_t)mt * 256 * KVL); const char* B0 = (const char*)(WKVB + (size_t)n8 * 256 * KVL);
                EpiBf16 E{KVF, NH * 256, mt * 256, n8 * 256};
                gemm_unit(lds, A, offA, B0, B0 + 128 * KVL * 2, offB, KVL / 64, E); } } }
    SEAM(10);
    if (IN(11)) qkv_finalize_phase(QF, KVF, LAT, (const int*)P.in[I_POS], P.in[I_QH_NORM], P.in[I_KH_NORM], QB, KB, VB);
    SEAM(11);
    if (IN(12)) attn_phase(lds, QB, KB, VB, AB);
    SEAM(12);
    if (IN(13)) { int R[2], C[2]; stage_coords(tid, R, C); unsigned offA[2][2], offB[2]; offs_contig(R, C, DM * 2, DM * 2, offA, offB);
        for (int u = blockIdx.x; u < 256; u += gridDim.x) { const int mt = u >> 2, n4 = u & 3;
            const char* A = (const char*)(AB + (size_t)mt * 256 * DM); const char* B0 = (const char*)(WO + (size_t)n4 * 256 * DM);
            EpiRes E{X3, X1, mt * 256, n4 * 256};
            gemm_unit(lds, A, offA, B0, B0 + 128 * DM * 2, offB, 16, E); } }
    SEAM(13);
    MOE_PLE_LAYER(1, 14, X1, P.out)
#undef IN
#undef SEAM
}

extern "C" void kernel_launch(void* const* d_in, const int* in_sizes, int n_in, void* d_out, int out_size, void* d_ws, size_t ws_size, hipStream_t stream) {
    static int grid = 0;
    if (grid == 0) {
        if (n_in != N_IN || out_size != T * DM || ws_size < WS_END) { fprintf(stderr, "kernel_launch: shape/workspace mismatch (n_in %d out %d ws %zu need %zu)\n", n_in, out_size, ws_size, (size_t)WS_END); grid = -1; return; }
        int dev = 0, cus = 0, per_cu = 0;
        if (hipGetDevice(&dev) != hipSuccess || hipDeviceGetAttribute(&cus, hipDeviceAttributeMultiprocessorCount, dev) != hipSuccess) { grid = -1; return; }
        if (hipFuncSetAttribute((const void*)mk_fwd, hipFuncAttributeMaxDynamicSharedMemorySize, LDS_BYTES) != hipSuccess) { fprintf(stderr, "kernel_launch: hipFuncSetAttribute failed\n"); grid = -1; return; }
        if (hipOccupancyMaxActiveBlocksPerMultiprocessor(&per_cu, (const void*)mk_fwd, NTHREADS, LDS_BYTES) != hipSuccess || per_cu < 1) { fprintf(stderr, "kernel_launch: occupancy query says %d\n", per_cu); (void)hipGetLastError(); grid = -1; return; }
        grid = cus;
    }
    if (grid < 0) return;
    (void)in_sizes;
    hipMemsetAsync((char*)d_ws + WS_CTL, 0, CTL_BYTES, stream);
    Params p{};
    for (int i = 0; i < N_IN; ++i) p.in[i] = (const float*)d_in[i];
    p.out = (float*)d_out; p.ws = (unsigned char*)d_ws;
#if MK_MULTI
    for (int ph = 0; ph < NPHASE; ++ph) { p.ph_lo = ph; p.ph_hi = ph + 1; hipLaunchKernelGGL(mk_fwd, dim3(grid), dim3(NTHREADS), LDS_BYTES, stream, p); }
#else
    p.ph_lo = 0; p.ph_hi = NPHASE; hipLaunchKernelGGL(mk_fwd, dim3(grid), dim3(NTHREADS), LDS_BYTES, stream, p);
#endif
}
```

```cpp
#include <hip/hip_runtime.h>
#include <cstdio>
#include <cstdint>

#ifndef MK_MULTI
#define MK_MULTI 0
#endif

#define LAS __attribute__((address_space(3)))
typedef unsigned short bf16_t;
typedef short bf16x8 __attribute__((ext_vector_type(8)));
typedef short s16x4 __attribute__((ext_vector_type(4)));
typedef float f32x2 __attribute__((ext_vector_type(2)));
typedef float f32x4 __attribute__((ext_vector_type(4)));
typedef float f32x16 __attribute__((ext_vector_type(16)));
typedef unsigned u32x2 __attribute__((ext_vector_type(2)));
typedef unsigned u32x4 __attribute__((ext_vector_type(4)));

constexpr int T = 16384, DM = 1024, SEQ = 8192, NE = 32, DFF = 1024, PLE = 256;
constexpr int NPAIR = T * 4;
constexpr int QL = 384, KVL = 256, NH = 8, QKD = 192, VD = 128, LATP = 768;
constexpr float EPS = 1e-6f;
constexpr int NTHREADS = 512;
constexpr int LDS_BYTES = 147456;
constexpr int MISC_OFF = 131072;
constexpr int BARW_OFF = LDS_BYTES - 16;
constexpr int NPHASE = 19;

enum { I_X = 0, I_P, I_POS, I_NORM_MIX, I_POOL_W, I_POOL_SCALE, I_W_IN, I_Q_NORM, I_W_QB, I_KV_NORM, I_W_KVB, I_QH_NORM, I_KH_NORM, I_W_O,
       I_NORM_FFN, I_ROUTER_W, I_ROUTER_B, I_W_GU, I_B_GU, I_W_DN, I_B_DN, I_PLE_NORM, I_PLE_GATE_W, I_PLE_PROJ_W, N_IN };

constexpr size_t al256(size_t x) { return (x + 255) & ~(size_t)255; }
constexpr size_t CTL_BYTES = 65536;
constexpr size_t WS_CTL  = 0;
constexpr size_t WS_WGU  = WS_CTL + CTL_BYTES;
constexpr size_t WS_WDN  = WS_WGU + (size_t)2 * 32 * 2048 * 1024 * 2;
constexpr size_t WS_WPG  = WS_WDN + (size_t)2 * 32 * 1024 * 1024 * 2;
constexpr size_t WS_WPP  = WS_WPG + (size_t)2 * 1024 * 1024 * 2;
constexpr size_t WS_WPOOL= WS_WPP + (size_t)2 * 1024 * 256 * 2;
constexpr size_t WS_WIN  = WS_WPOOL + (size_t)4 * 256 * 256 * 2;
constexpr size_t WS_WQB  = WS_WIN + (size_t)768 * 1024 * 2;
constexpr size_t WS_WKVB = WS_WQB + (size_t)1536 * 384 * 2;
constexpr size_t WS_WO   = WS_WKVB + (size_t)2048 * 256 * 2;
constexpr size_t WS_PB   = WS_WO + (size_t)1024 * 1024 * 2;
constexpr size_t WS_PP   = WS_PB + (size_t)2 * T * 256 * 2;
constexpr size_t WS_AB   = WS_PP + (size_t)2 * T * 1024 * 2;
constexpr size_t WS_X1   = WS_AB + (size_t)T * 1024 * 2;
constexpr size_t WS_X2   = WS_X1 + (size_t)T * 1024 * 4;
constexpr size_t WS_X3   = WS_X2 + (size_t)T * 1024 * 4;
constexpr size_t WS_HN   = WS_X3 + (size_t)T * 1024 * 4;
constexpr size_t WS_ACT  = WS_HN + (size_t)T * 1024 * 2;
constexpr size_t WS_SLOT = WS_ACT + (size_t)(NPAIR + 256) * 1024 * 2;
constexpr size_t WS_LIST = WS_SLOT + (size_t)NPAIR * 1024 * 2;
constexpr size_t WS_GATE = WS_LIST + (size_t)32 * T * 4;
constexpr size_t WS_LAT  = WS_GATE + (size_t)NPAIR * 4;
constexpr size_t WS_QN   = WS_LAT + (size_t)T * 768 * 4;
constexpr size_t WS_KVN  = WS_QN + (size_t)T * 384 * 2;
constexpr size_t WS_QF   = WS_KVN + (size_t)T * 256 * 2;
constexpr size_t WS_KVF  = WS_QF + (size_t)T * 1536 * 2;
constexpr size_t WS_Q    = WS_KVF + (size_t)T * 2048 * 2;
constexpr size_t WS_K    = WS_Q + (size_t)T * 8 * 192 * 2;
constexpr size_t WS_V    = WS_K + (size_t)T * 8 * 192 * 2;
constexpr size_t WS_WRG  = WS_V + (size_t)T * 8 * 128 * 2;
constexpr size_t WS_STAT = WS_WRG + (size_t)2 * 1024 * 32 * 4;
constexpr size_t WS_CS   = WS_STAT + (size_t)3 * T * 16 * 4;
constexpr size_t WS_END  = WS_CS + (size_t)T * 32 * 2 * 4;
constexpr int CW_GCNT = 4096;

struct Params { const float* in[N_IN]; float* out; unsigned char* ws; int ph_lo, ph_hi; };

__device__ __forceinline__ unsigned cvt_pk_bf16(float lo, float hi) { unsigned r; asm volatile("v_cvt_pk_bf16_f32 %0, %1, %2" : "=v"(r) : "v"(lo), "v"(hi)); return r; }
__device__ __forceinline__ float bf_lo(unsigned w) { return __uint_as_float(w << 16); }
__device__ __forceinline__ float bf_hi(unsigned w) { return __uint_as_float(w & 0xffff0000u); }
__device__ __forceinline__ float wave_sum(float v) {
#pragma unroll
    for (int o = 32; o > 0; o >>= 1) v += __shfl_xor(v, o);
    return v;
}
__device__ __forceinline__ int ltid() { int t = threadIdx.x; asm volatile("" : "+v"(t)); return t; }
__device__ __forceinline__ f32x4 ld4(const float* p) { return *(const f32x4*)p; }
__device__ __forceinline__ f32x4 ld4bf(const bf16_t* p) { const u32x2 w = *(const u32x2*)p; return (f32x4){bf_lo(w.x), bf_hi(w.x), bf_lo(w.y), bf_hi(w.y)}; }
__device__ __forceinline__ void st4bf(bf16_t* p, f32x4 v) { u32x2 w; w.x = cvt_pk_bf16(v[0], v[1]); w.y = cvt_pk_bf16(v[2], v[3]); *(u32x2*)p = w; }
__device__ __forceinline__ f32x4 dpp_ror8(const f32x4 v) { f32x4 r;
#pragma unroll
    for (int j = 0; j < 4; ++j) r[j] = __uint_as_float((unsigned)__builtin_amdgcn_update_dpp(0, (int)__float_as_uint(v[j]), 0x128, 0xf, 0xf, false));
    return r; }
__device__ __forceinline__ f32x4 sel4(const bool c, const f32x4 a, const f32x4 b) { f32x4 r;
#pragma unroll
    for (int j = 0; j < 4; ++j) r[j] = c ? a[j] : b[j];
    return r; }
__device__ __forceinline__ void ld_rows8_f32(const float* blk16, const size_t ld, const int fr, const int fq, f32x4& x0, f32x4& x1) {
    const bool hi8 = fr >= 8; const float* p = blk16 + (size_t)(fr & 7) * ld + (hi8 ? 16 : 0) + fq * 4;
    const f32x4 L1 = ld4(p), L2 = ld4(p + 8 * ld);
    const f32x4 rv = dpp_ror8(sel4(hi8, L1, L2));
    x0 = sel4(hi8, rv, L1); x1 = sel4(hi8, L2, rv);
}
__device__ __forceinline__ void st_rows8_f32(float* blk16, const size_t ld, const int fr, const int fq, const f32x4 v0, const f32x4 v1) {
    const bool hi8 = fr >= 8; float* p = blk16 + (size_t)(fr & 7) * ld + (hi8 ? 16 : 0) + fq * 4;
    const f32x4 rv = dpp_ror8(sel4(hi8, v0, v1));
    *(f32x4*)p = sel4(hi8, rv, v0); *(f32x4*)(p + 8 * ld) = sel4(hi8, v1, rv);
}
__device__ __forceinline__ void ld_pair_bf16(const bf16_t* blk, const int fq, u32x2& w0, u32x2& w1) {
    const u32x4 w = *(const u32x4*)(blk + (fq & 1) * 16 + (fq >> 1) * 8);
    const auto sx = __builtin_amdgcn_permlane16_swap(w.x, w.z, false, false); const auto sy = __builtin_amdgcn_permlane16_swap(w.y, w.w, false, false);
    w0.x = sx[0]; w0.y = sy[0]; w1.x = sx[1]; w1.y = sy[1];
}
__device__ __forceinline__ void st_pair_bf16(bf16_t* blk, const f32x4 v0, const f32x4 v1, const int fq) {
    const auto sx = __builtin_amdgcn_permlane16_swap(cvt_pk_bf16(v0[0], v0[1]), cvt_pk_bf16(v1[0], v1[1]), false, false);
    const auto sy = __builtin_amdgcn_permlane16_swap(cvt_pk_bf16(v0[2], v0[3]), cvt_pk_bf16(v1[2], v1[3]), false, false);
    u32x4 w; w.x = sx[0]; w.y = sy[0]; w.z = sx[1]; w.w = sy[1];
    *(u32x4*)(blk + (fq & 1) * 16 + (fq >> 1) * 8) = w;
}
__device__ __forceinline__ unsigned pk4_fp8(float a, float b, float c, float d) { int w = __builtin_amdgcn_cvt_pk_fp8_f32(a, b, 0, false); w = __builtin_amdgcn_cvt_pk_fp8_f32(c, d, w, true); return (unsigned)w; }
__device__ __forceinline__ float sigmoidf_(float z) { return __builtin_amdgcn_rcpf(1.0f + __builtin_amdgcn_exp2f(-1.4426950408889634f * z)); }

#define XB_TMO      128
#define XB_XCNT(j)  (256  + 64 * (j))
#define XB_XSUB(j)  (1280 + 64 * (j))
#define XB_XGEN(j)  (2304 + 64 * (j))
#define XB_TOP      3328
#define XB_TOPGEN   3392
#define XCD_BAR_WORDS 3456
#define XB_SPIN_CAP (1u << 24)
__device__ __forceinline__ unsigned xb_ld(unsigned* p)              { return __hip_atomic_load(p, __ATOMIC_RELAXED, __HIP_MEMORY_SCOPE_AGENT); }
__device__ __forceinline__ unsigned xb_add(unsigned* p, unsigned v) { return __hip_atomic_fetch_add(p, v, __ATOMIC_RELAXED, __HIP_MEMORY_SCOPE_AGENT); }
__device__ __forceinline__ unsigned xb_xcc_id() { return (unsigned)__builtin_amdgcn_s_getreg((3 << 11) | 20) & 0xFu; }
#define XB_SPIN(cond, bar) do { unsigned _sp = 0; while (cond) { __builtin_amdgcn_s_sleep(1); \
    if ((++_sp & 255u) == 0u) { if (xb_ld(&(bar)[XB_TMO])) break; if (_sp > XB_SPIN_CAP) { atomicAdd(&(bar)[XB_TMO], 1u); break; } } } } while (0)
struct XcdBarrier { unsigned* bar; unsigned x; volatile LAS unsigned* st; };
__device__ __forceinline__ XcdBarrier xcd_barrier_post(unsigned* bar, volatile LAS unsigned* st) {
    XcdBarrier b; b.bar = bar; b.x = xb_xcc_id(); b.st = st;
    if (threadIdx.x == 0) (void)xb_add(&bar[XB_XCNT(b.x)], 1u);
    return b;
}
__device__ __forceinline__ void xcd_barrier_complete(unsigned* bar, unsigned x, unsigned& nloc, unsigned& nx) {
    const unsigned G = gridDim.x * gridDim.y * gridDim.z;
    unsigned sum, cnt, mine, sp = 0u;
    for (;;) {
        sum = 0u; cnt = 0u; mine = 0u;
#pragma unroll
        for (unsigned j = 0; j < 16; ++j) { const unsigned c = xb_ld(&bar[XB_XCNT(j)]); sum += c; cnt += (c > 0u) ? 1u : 0u; mine = (j == x) ? c : mine; }
        if (sum == G) break;
        __builtin_amdgcn_s_sleep(1);
        if ((++sp & 255u) == 0u) { if (xb_ld(&bar[XB_TMO])) break; if (sp > XB_SPIN_CAP) { atomicAdd(&bar[XB_TMO], 1u); break; } }
    }
    nloc = mine > 0u ? mine : 1u; nx = cnt > 0u ? cnt : 1u;
}
__device__ __forceinline__ void xcd_barrier(const XcdBarrier& b) {
    asm volatile("s_waitcnt vmcnt(0)" ::: "memory");
    __syncthreads();
    if (threadIdx.x == 0) {
        unsigned* bar = b.bar;
        __builtin_amdgcn_s_waitcnt(0);
        unsigned nloc = b.st[0], nx = b.st[1];
        if (nloc == 0u) { xcd_barrier_complete(bar, b.x, nloc, nx); b.st[0] = nloc; b.st[1] = nx; }
        const unsigned old = xb_add(&bar[XB_XSUB(b.x)], 1u);
        const unsigned gen = old / nloc;
        if (old + 1u == (gen + 1u) * nloc) {
            __builtin_amdgcn_fence(__ATOMIC_RELEASE, "agent");
            asm volatile("s_waitcnt vmcnt(0)" ::: "memory");
            const unsigned og = xb_add(&bar[XB_TOP], 1u);
            const unsigned tg = og / nx;
            if (og + 1u == (tg + 1u) * nx) xb_add(&bar[XB_TOPGEN], 1u);
            else XB_SPIN(xb_ld(&bar[XB_TOPGEN]) == tg, bar);
            __builtin_amdgcn_fence(__ATOMIC_ACQUIRE, "agent");
            xb_add(&bar[XB_XGEN(b.x)], 1u);
            asm volatile("s_waitcnt vmcnt(0)" ::: "memory");
        } else {
            XB_SPIN(xb_ld(&bar[XB_XGEN(b.x)]) == gen, bar);
            __builtin_amdgcn_fence(__ATOMIC_ACQUIRE, "agent");
            asm volatile("s_waitcnt vmcnt(0)" ::: "memory");
        }
    }
    __syncthreads();
}

constexpr int HTB = 16384;
__device__ __forceinline__ int lds_byte(int r, int c) { const int st = (r >> 4) * 2 + (c >> 5), rr = r & 15, cc = c & 31, ob = rr * 64 + cc * 2; return st * 1024 + (ob ^ (((ob >> 9) & 1) << 5)); }
__device__ __forceinline__ void stage_rc(int b, int& R, int& C) { const int st = b / 1024, sb = b % 1024, swz = sb ^ (((sb >> 9) & 1) << 5); R = (st >> 1) * 16 + swz / 64; C = (st & 1) * 32 + (swz % 64) / 2; }
#define SA_(b, h) (((b) * 2 + (h)) * HTB)
#define SB_(b, h) ((4 + (b) * 2 + (h)) * HTB)
#define G_STAGE(bufoff, sbase, voff) do { _Pragma("unroll") for (int _i = 0; _i < 2; ++_i) \
    __builtin_amdgcn_raw_ptr_buffer_load_lds(srd, (LAS unsigned*)(lds + (bufoff) + ldsw + _i * 8192), 16, (int)(voff)[_i], (int)(sbase), 0, 0); } while (0)
#define G_LDA(dst, b, h) do { _Pragma("unroll") for (int m = 0; m < 4; ++m) _Pragma("unroll") for (int k = 0; k < 2; ++k) dst[m][k] = *(const LAS bf16x8*)(lds + SA_(b, h) + aoff + m * 2048 + k * 1024); } while (0)
#define G_LDB(dst, b, h) do { _Pragma("unroll") for (int n = 0; n < 2; ++n) _Pragma("unroll") for (int k = 0; k < 2; ++k) dst[n][k] = *(const LAS bf16x8*)(lds + SB_(b, h) + boff + n * 2048 + k * 1024); } while (0)
#define G_MMA(ai, bj, At, Bt) do { __builtin_amdgcn_s_setprio(1); _Pragma("unroll") for (int m = 0; m < 4; ++m) _Pragma("unroll") for (int n = 0; n < 2; ++n) _Pragma("unroll") for (int k = 0; k < 2; ++k) \
    acc[ai][bj][m][n] = __builtin_amdgcn_mfma_f32_16x16x32_bf16(Bt[n][k], At[m][k], acc[ai][bj][m][n], 0, 0, 0); __builtin_amdgcn_s_setprio(0); } while (0)
#define WAIT_V(n) asm volatile("s_waitcnt vmcnt(" #n ")" ::: "memory")
#define WAIT_L(n) asm volatile("s_waitcnt lgkmcnt(" #n ")" ::: "memory")
#define BAR __builtin_amdgcn_s_barrier()
#define SCHED __builtin_amdgcn_sched_barrier(0)

__device__ __forceinline__ void stage_coords(int tid, int (&R)[2], int (&C)[2]) { stage_rc(tid * 16, R[0], C[0]); stage_rc(tid * 16 + 8192, R[1], C[1]); }

template <class Prov>
__device__ __forceinline__ void gemm_stream(LAS unsigned char* lds, const __amdgpu_buffer_rsrc_t srd, const Prov& P) {
    const int tid = ltid(), wid = __builtin_amdgcn_readfirstlane(tid >> 6), lane = tid & 63, wr = wid >> 2, wc = wid & 3, fr = lane & 15, fq = lane >> 4;
    const unsigned ldsw = (unsigned)wid * 1024u;
    const int aoff = lds_byte(wr * 64 + fr, fq * 8), boff = lds_byte(wc * 32 + fr, fq * 8);
    typename Prov::Unit cur, nxt;
    if (!P.next(0, cur)) return;
    unsigned oA[2][2]; P.offs(cur, oA);
    const unsigned oB[2] = {P.offB[0], P.offB[1]};
    const int nt = P.nt;
    f32x4 acc[2][2][4][2];
#pragma unroll
    for (int a = 0; a < 2; ++a)
#pragma unroll
        for (int b = 0; b < 2; ++b)
#pragma unroll
            for (int m = 0; m < 4; ++m)
#pragma unroll
                for (int n = 0; n < 2; ++n) acc[a][b][m][n] = (f32x4){0.f, 0.f, 0.f, 0.f};
    bf16x8 At[4][2], B0[2][2], B1[2][2];
    unsigned cA = cur.A, cB0 = cur.B0, cB1 = cur.B1;
    G_STAGE(SB_(0, 0), cB0, oB); G_STAGE(SA_(0, 0), cA, oA[0]); G_STAGE(SB_(0, 1), cB1, oB); G_STAGE(SA_(0, 1), cA, oA[1]);
    if (wr == 1) BAR;
    WAIT_V(4); BAR;
    G_STAGE(SB_(1, 0), cB0 + 128, oB); G_STAGE(SA_(1, 0), cA + 128, oA[0]); G_STAGE(SB_(1, 1), cB1 + 128, oB);
    WAIT_V(6); BAR;
    int ui = 0;
    for (;;) {
        const bool has_next = P.next(ui + 1, nxt);
        const unsigned nA = has_next ? nxt.A : cA, nB0 = has_next ? nxt.B0 : cB0, nB1 = has_next ? nxt.B1 : cB1;
        for (int t = 0; t < nt; t += 2) {
            const bool last = (t == nt - 2);
            const unsigned a1 = cA + (t + 1) * 128;
            G_LDB(B0, 0, 0); SCHED; G_LDA(At, 0, 0); G_STAGE(SA_(1, 1), a1, oA[1]);
            WAIT_L(8); BAR; WAIT_L(0); G_MMA(0, 0, At, B0); BAR; SCHED;
            if (last && has_next) P.offs(nxt, oA);
            const unsigned a2 = last ? nA : cA + (t + 2) * 128, p0 = last ? nB0 : cB0 + (t + 2) * 128, p1 = last ? nB1 : cB1 + (t + 2) * 128;
            G_LDB(B1, 0, 1); G_STAGE(SB_(0, 0), p0, oB);
            BAR; WAIT_L(0); G_MMA(0, 1, At, B1); BAR;
            G_LDA(At, 0, 1); G_STAGE(SA_(0, 0), a2, oA[0]);
            BAR; WAIT_L(0); G_MMA(1, 0, At, B0); BAR; SCHED;
            G_STAGE(SB_(0, 1), p1, oB);
            WAIT_V(6); BAR; G_MMA(1, 1, At, B1); BAR;
            G_LDB(B0, 1, 0); SCHED; G_LDA(At, 1, 0); G_STAGE(SA_(0, 1), a2, oA[1]);
            WAIT_L(8); BAR; WAIT_L(0); G_MMA(0, 0, At, B0); BAR; SCHED;
            G_LDB(B1, 1, 1); G_STAGE(SB_(1, 0), p0 + 128, oB);
            BAR; WAIT_L(0); G_MMA(0, 1, At, B1); BAR;
            G_LDA(At, 1, 1); G_STAGE(SA_(1, 0), a2 + 128, oA[0]);
            BAR; WAIT_L(0); G_MMA(1, 0, At, B0); BAR; SCHED;
            G_STAGE(SB_(1, 1), p1 + 128, oB);
            WAIT_V(6); BAR; G_MMA(1, 1, At, B1); BAR;
        }
        { int tz = threadIdx.x; asm volatile("" : "+v"(tz)); const int wz = __builtin_amdgcn_readfirstlane(tz >> 6), lz = tz & 63; P.epi(acc, cur, wz >> 2, wz & 3, lz & 15, lz >> 4); }
        if (!has_next) break;
#pragma unroll
        for (int a = 0; a < 2; ++a)
#pragma unroll
            for (int b = 0; b < 2; ++b)
#pragma unroll
                for (int m = 0; m < 4; ++m)
#pragma unroll
                    for (int n = 0; n < 2; ++n) acc[a][b][m][n] = (f32x4){0.f, 0.f, 0.f, 0.f};
        cur = nxt; cA = nA; cB0 = nB0; cB1 = nB1; ++ui;
    }
    WAIT_V(0);
    if (wr == 0) BAR;
    BAR;
    __syncthreads();
}

typedef int v8i32 __attribute__((ext_vector_type(8)));
#define F8_LDA(dst, b, h) do { _Pragma("unroll") for (int m = 0; m < 4; ++m) { const u32x4 _lo = *(const LAS u32x4*)(lds + SA_(b, h) + aoff + m * 2048), _hi = *(const LAS u32x4*)(lds + SA_(b, h) + aoff + m * 2048 + 16); \
    dst[m] = (v8i32){(int)_lo.x, (int)_lo.y, (int)_lo.z, (int)_lo.w, (int)_hi.x, (int)_hi.y, (int)_hi.z, (int)_hi.w}; } } while (0)
#define F8_LDB(dst, b, h) do { _Pragma("unroll") for (int n = 0; n < 2; ++n) { const u32x4 _lo = *(const LAS u32x4*)(lds + SB_(b, h) + boff + n * 2048), _hi = *(const LAS u32x4*)(lds + SB_(b, h) + boff + n * 2048 + 16); \
    dst[n] = (v8i32){(int)_lo.x, (int)_lo.y, (int)_lo.z, (int)_lo.w, (int)_hi.x, (int)_hi.y, (int)_hi.z, (int)_hi.w}; } } while (0)
#define F8_MMA(ai, bj, At, Bt) do { __builtin_amdgcn_s_setprio(1); _Pragma("unroll") for (int m = 0; m < 4; ++m) _Pragma("unroll") for (int n = 0; n < 2; ++n) \
    acc[ai][bj][m][n] = __builtin_amdgcn_mfma_scale_f32_16x16x128_f8f6f4(Bt[n], At[m], acc[ai][bj][m][n], 0, 0, 0, 0x7a7a7a7a  , 0, 0x7f7f7f7f  ); __builtin_amdgcn_s_setprio(0); } while (0)
template <class Prov>
__device__ __forceinline__ void gemm_stream_f8(LAS unsigned char* lds, const __amdgpu_buffer_rsrc_t srd, const Prov& P) {
    const int tid = ltid(), wid = __builtin_amdgcn_readfirstlane(tid >> 6), lane = tid & 63, wr = wid >> 2, wc = wid & 3, fr = lane & 15, fq = lane >> 4;
    const unsigned ldsw = (unsigned)wid * 1024u;
    const int aoff = lds_byte(wr * 64 + fr, fq * 16), boff = lds_byte(wc * 32 + fr, fq * 16);
    typename Prov::Unit cur, nxt;
    if (!P.next(0, cur)) return;
    unsigned oA[2][2]; P.offs(cur, oA);
    const unsigned oB[2] = {P.offB[0], P.offB[1]};
    const int nt = P.nt;
    f32x4 acc[2][2][4][2];
#pragma unroll
    for (int a = 0; a < 2; ++a)
#pragma unroll
        for (int b = 0; b < 2; ++b)
#pragma unroll
            for (int m = 0; m < 4; ++m)
#pragma unroll
                for (int n = 0; n < 2; ++n) acc[a][b][m][n] = (f32x4){0.f, 0.f, 0.f, 0.f};
    v8i32 At[4], B0[2], B1[2];
    unsigned cA = cur.A, cB0 = cur.B0, cB1 = cur.B1;
    G_STAGE(SB_(0, 0), cB0, oB); G_STAGE(SA_(0, 0), cA, oA[0]); G_STAGE(SB_(0, 1), cB1, oB); G_STAGE(SA_(0, 1), cA, oA[1]);
    if (wr == 1) BAR;
    WAIT_V(4); BAR;
    G_STAGE(SB_(1, 0), cB0 + 128, oB); G_STAGE(SA_(1, 0), cA + 128, oA[0]); G_STAGE(SB_(1, 1), cB1 + 128, oB);
    WAIT_V(6); BAR;
    int ui = 0;
    for (;;) {
        const bool has_next = P.next(ui + 1, nxt);
        const unsigned nA = has_next ? nxt.A : cA, nB0 = has_next ? nxt.B0 : cB0, nB1 = has_next ? nxt.B1 : cB1;
        for (int t = 0; t < nt; t += 2) {
            const bool last = (t == nt - 2);
            const unsigned a1 = cA + (t + 1) * 128;
            F8_LDB(B0, 0, 0); SCHED; F8_LDA(At, 0, 0); G_STAGE(SA_(1, 1), a1, oA[1]);
            WAIT_L(8); BAR; WAIT_L(0); F8_MMA(0, 0, At, B0); BAR; SCHED;
            if (last && has_next) P.offs(nxt, oA);
            const unsigned a2 = last ? nA : cA + (t + 2) * 128, p0 = last ? nB0 : cB0 + (t + 2) * 128, p1 = last ? nB1 : cB1 + (t + 2) * 128;
            F8_LDB(B1, 0, 1); G_STAGE(SB_(0, 0), p0, oB);
            BAR; WAIT_L(0); F8_MMA(0, 1, At, B1); BAR;
            F8_LDA(At, 0, 1); G_STAGE(SA_(0, 0), a2, oA[0]);
            BAR; WAIT_L(0); F8_MMA(1, 0, At, B0); BAR; SCHED;
            G_STAGE(SB_(0, 1), p1, oB);
            WAIT_V(6); BAR; F8_MMA(1, 1, At, B1); BAR;
            F8_LDB(B0, 1, 0); SCHED; F8_LDA(At, 1, 0); G_STAGE(SA_(0, 1), a2, oA[1]);
            WAIT_L(8); BAR; WAIT_L(0); F8_MMA(0, 0, At, B0); BAR; SCHED;
            F8_LDB(B1, 1, 1); G_STAGE(SB_(1, 0), p0 + 128, oB);
            BAR; WAIT_L(0); F8_MMA(0, 1, At, B1); BAR;
            F8_LDA(At, 1, 1); G_STAGE(SA_(1, 0), a2 + 128, oA[0]);
            BAR; WAIT_L(0); F8_MMA(1, 0, At, B0); BAR; SCHED;
            G_STAGE(SB_(1, 1), p1 + 128, oB);
            WAIT_V(6); BAR; F8_MMA(1, 1, At, B1); BAR;
        }
        { int tz = threadIdx.x; asm volatile("" : "+v"(tz)); const int wz = __builtin_amdgcn_readfirstlane(tz >> 6), lz = tz & 63; P.epi(acc, cur, wz >> 2, wz & 3, lz & 15, lz >> 4); }
        if (!has_next) break;
#pragma unroll
        for (int a = 0; a < 2; ++a)
#pragma unroll
            for (int b = 0; b < 2; ++b)
#pragma unroll
                for (int m = 0; m < 4; ++m)
#pragma unroll
                    for (int n = 0; n < 2; ++n) acc[a][b][m][n] = (f32x4){0.f, 0.f, 0.f, 0.f};
        cur = nxt; cA = nA; cB0 = nB0; cB1 = nB1; ++ui;
    }
    WAIT_V(0);
    if (wr == 0) BAR;
    BAR;
    __syncthreads();
}

#define EPI_ROWS(ai, m) (ai * 128 + wr * 64 + m * 16 + fr)
#define EPI_COLS(bj, n) (bj * 128 + wc * 32 + n * 16 + fq * 4)
#define EPI_ROW16(ai, m) (ai * 128 + wr * 64 + m * 16)
typedef const f32x4 (&AccRef)[2][2][4][2];

struct EpiPool {
    const float* x; const float* scale; float* o; int row0, col0;
    __device__ __forceinline__ void operator()(AccRef acc, int wr, int wc, int fr, int fq) const {
#pragma unroll
        for (int ai = 0; ai < 2; ++ai)
#pragma unroll
            for (int m = 0; m < 4; ++m) { const size_t rb = (size_t)(row0 + EPI_ROW16(ai, m)) * DM;
#pragma unroll
                for (int bj = 0; bj < 2; ++bj) { const int cb = col0 + bj * 128 + wc * 32; f32x4 x0, x1; ld_rows8_f32(x + rb + cb, DM, fr, fq, x0, x1);
                    const f32x4 s0 = ld4(scale + cb + fq * 4), s1 = ld4(scale + cb + 16 + fq * 4);
                    st_rows8_f32(o + rb + cb, DM, fr, fq, x0 + s0 * acc[ai][bj][m][0], x1 + s1 * acc[ai][bj][m][1]); }
                if (m == 3) asm volatile("" ::: "memory"); }
    }
};
struct EpiRes {
    const bf16_t* base; bf16_t* o; int row0, col0;
    __device__ __forceinline__ void operator()(AccRef acc, int wr, int wc, int fr, int fq) const {
#pragma unroll
        for (int ai = 0; ai < 2; ++ai)
#pragma unroll
            for (int m = 0; m < 4; ++m) { const size_t rb = (size_t)(row0 + EPI_ROW16(ai, m)) * DM;
#pragma unroll
                for (int bj = 0; bj < 2; ++bj) { const int cb = col0 + bj * 128 + wc * 32; u32x2 w0, w1; ld_pair_bf16(base + (size_t)(row0 + EPI_ROWS(ai, m)) * DM + cb, fq, w0, w1);
                    const f32x4 x0 = (f32x4){bf_lo(w0.x), bf_hi(w0.x), bf_lo(w0.y), bf_hi(w0.y)}, x1 = (f32x4){bf_lo(w1.x), bf_hi(w1.x), bf_lo(w1.y), bf_hi(w1.y)};
                    st_pair_bf16(o + (size_t)(row0 + EPI_ROWS(ai, m)) * DM + cb, x0 + acc[ai][bj][m][0], x1 + acc[ai][bj][m][1], fq); }
                if (m == 3) asm volatile("" ::: "memory"); }
    }
};
struct EpiBf16 {
    bf16_t* o; int ld, row0, col0;
    __device__ __forceinline__ void operator()(AccRef acc, int wr, int wc, int fr, int fq) const {
#pragma unroll
        for (int ai = 0; ai < 2; ++ai)
#pragma unroll
            for (int m = 0; m < 4; ++m) { const size_t ro = (size_t)(row0 + EPI_ROWS(ai, m)) * ld;
#pragma unroll
                for (int bj = 0; bj < 2; ++bj) st_pair_bf16(o + ro + col0 + bj * 128 + wc * 32, acc[ai][bj][m][0], acc[ai][bj][m][1], fq); }
    }
};
template <bool STATS>
struct EpiPle {
    const bf16_t* x2; const float* rs2; const bf16_t* pp; float* o; bf16_t* xb; float* ss; int row0, col0;
    __device__ __forceinline__ void operator()(AccRef acc, int wr, int wc, int fr, int fq) const {
#pragma unroll
        for (int ai = 0; ai < 2; ++ai)
#pragma unroll
            for (int m = 0; m < 4; ++m) { const int row = row0 + EPI_ROWS(ai, m); const size_t ro = (size_t)row * DM; float sq = 0.f; const float rs = rs2[row];
#pragma unroll
                for (int bj = 0; bj < 2; ++bj) { f32x4 rr[2]; u32x2 pwv[2], xwv[2]; const int cb = col0 + bj * 128 + wc * 32; const size_t rb = (size_t)(row0 + EPI_ROW16(ai, m)) * DM;
                    ld_pair_bf16(x2 + ro + cb, fq, xwv[0], xwv[1]); ld_pair_bf16(pp + ro + cb, fq, pwv[0], pwv[1]);
#pragma unroll
                    for (int n = 0; n < 2; ++n) { const f32x4 a = acc[ai][bj][m][n]; const u32x2 pw = pwv[n], xw = xwv[n];
                        f32x4 r; r[0] = bf_lo(xw.x) + sigmoidf_(a[0] * rs) * bf_lo(pw.x); r[1] = bf_hi(xw.x) + sigmoidf_(a[1] * rs) * bf_hi(pw.x);
                        r[2] = bf_lo(xw.y) + sigmoidf_(a[2] * rs) * bf_lo(pw.y); r[3] = bf_hi(xw.y) + sigmoidf_(a[3] * rs) * bf_hi(pw.y);
                        rr[n] = r;
                        if (STATS) sq += r[0] * r[0] + r[1] * r[1] + r[2] * r[2] + r[3] * r[3]; }
                    if (STATS) st_pair_bf16(xb + ro + cb, rr[0], rr[1], fq);
                    else st_rows8_f32(o + rb + cb, DM, fr, fq, rr[0], rr[1]); }
                if (STATS) { sq += __shfl_xor(sq, 16); sq += __shfl_xor(sq, 32); if (fq == 0) ss[(size_t)row * 16 + (col0 >> 8) * 4 + wc] = sq; }
                if (m == 3) asm volatile("" ::: "memory"); }
    }
};
__device__ __forceinline__ float sum16(const float* p, int n4) { float t = 0.f; for (int i = 0; i < n4; ++i) { const f32x4 v = ld4(p + 4 * i); t += (v[0] + v[1]) + (v[2] + v[3]); } return t; }
struct EpiLat {
    const float* ss3; bf16_t* o; float* ssq; float* sskv; int row0, col0;
    __device__ __forceinline__ void operator()(AccRef acc, int wr, int wc, int fr, int fq) const {
#pragma unroll
        for (int ai = 0; ai < 2; ++ai)
#pragma unroll
            for (int m = 0; m < 4; ++m) { const int row = row0 + EPI_ROWS(ai, m); const float rs = rsqrtf(sum16(ss3 + (size_t)row * 16, 4) * (1.0f / DM) + EPS); float sq[2];
#pragma unroll
                for (int bj = 0; bj < 2; ++bj) { sq[bj] = 0.f;
#pragma unroll
                    for (int n = 0; n < 2; ++n) { const f32x4 v = acc[ai][bj][m][n] * rs; sq[bj] += v[0] * v[0] + v[1] * v[1] + v[2] * v[2] + v[3] * v[3]; }
                    st_pair_bf16(o + (size_t)row * LATP + col0 + bj * 128 + wc * 32, acc[ai][bj][m][0] * rs, acc[ai][bj][m][1] * rs, fq);
                    sq[bj] += __shfl_xor(sq[bj], 16); sq[bj] += __shfl_xor(sq[bj], 32); }
                if (fq == 0) {
                    const int h0 = col0 >> 7;
#pragma unroll
                    for (int bj = 0; bj < 2; ++bj) { const int h = h0 + bj; if (h < 3) ssq[(size_t)row * 16 + 4 * h + wc] = sq[bj]; else if (h < 5) sskv[(size_t)row * 16 + 4 * (h - 3) + wc] = sq[bj]; } } }
    }
};
struct EpiBf16S {
    bf16_t* o; int ld; const float* ss; int np4; float inv_k; int row0, col0;
    __device__ __forceinline__ void operator()(AccRef acc, int wr, int wc, int fr, int fq) const {
#pragma unroll
        for (int ai = 0; ai < 2; ++ai)
#pragma unroll
            for (int m = 0; m < 4; ++m) { const int row = row0 + EPI_ROWS(ai, m); const float rs = rsqrtf(sum16(ss + (size_t)row * 16, np4) * inv_k + EPS); const size_t ro = (size_t)row * ld;
#pragma unroll
                for (int bj = 0; bj < 2; ++bj) st_pair_bf16(o + ro + col0 + bj * 128 + wc * 32, acc[ai][bj][m][0] * rs, acc[ai][bj][m][1] * rs, fq); }
    }
};
struct EpiMoe1 {
    const float* bg; const float* bu; unsigned char* act; int nv;
    __device__ __forceinline__ void operator()(AccRef acc, int wr, int wc, int fr, int fq) const {
        f32x4 bgv[2], buv[2];
#pragma unroll
        for (int n = 0; n < 2; ++n) { const int c = wc * 32 + n * 16 + fq * 4; bgv[n] = ld4(bg + c); buv[n] = ld4(bu + c); }
#pragma unroll
        for (int ai = 0; ai < 2; ++ai)
#pragma unroll
            for (int m = 0; m < 4; ++m) { const int r = EPI_ROWS(ai, m);
                unsigned dw[2];
#pragma unroll
                for (int n = 0; n < 2; ++n) {
                    const f32x4 g4 = acc[ai][0][m][n] + bgv[n], u4 = acc[ai][1][m][n] + buv[n]; float a[4];
#pragma unroll
                    for (int j = 0; j < 4; j += 2) {
                        const f32x2 g = (f32x2){fminf(g4[j], 7.0f), fminf(g4[j + 1], 7.0f)}, u = (f32x2){fminf(fmaxf(u4[j], -7.0f), 7.0f), fminf(fmaxf(u4[j + 1], -7.0f), 7.0f)};
                        const f32x2 t = g * (f32x2){-1.702f * 1.4426950408889634f, -1.702f * 1.4426950408889634f};
                        const f32x2 d = (f32x2){__builtin_amdgcn_exp2f(t.x), __builtin_amdgcn_exp2f(t.y)} + (f32x2){1.0f, 1.0f};
                        const f32x2 q = (u + (f32x2){1.0f, 1.0f}) * g * (f32x2){__builtin_amdgcn_rcpf(d.x), __builtin_amdgcn_rcpf(d.y)};
                        a[j] = q.x; a[j + 1] = q.y; }
                    dw[n] = pk4_fp8(a[0], a[1], a[2], a[3]); }
                const auto sw = __builtin_amdgcn_permlane16_swap(dw[0], dw[1], false, false);
                u32x2 w; w.x = sw[0]; w.y = sw[1];
                if (r < nv) *(u32x2*)(act + (size_t)r * DFF + wc * 32 + (fq & 1) * 16 + (fq >> 1) * 8) = w; }
    }
};
constexpr float SLOT_SCALE = 8.0f;
struct EpiMoe2 {
    const float* bd; LAS const int* lpair; LAS const float* lgate; bf16_t* slot; int nv, col0;
    __device__ __forceinline__ void operator()(AccRef acc, int wr, int wc, int fr, int fq) const {
        f32x4 bv[2][2];
#pragma unroll
        for (int bj = 0; bj < 2; ++bj)
#pragma unroll
            for (int n = 0; n < 2; ++n) bv[bj][n] = ld4(bd + col0 + EPI_COLS(bj, n));
#pragma unroll
        for (int ai = 0; ai < 2; ++ai)
#pragma unroll
            for (int m = 0; m < 4; ++m) { const int r = EPI_ROWS(ai, m); const int pair = lpair[r]; const float g = lgate[r] * SLOT_SCALE; unsigned char* orow = (unsigned char*)slot + (size_t)pair * DM + col0;
#pragma unroll
                for (int bj = 0; bj < 2; ++bj) {
                    unsigned dq[2];
#pragma unroll
                    for (int n = 0; n < 2; ++n) { f32x4 v = (acc[ai][bj][m][n] + bv[bj][n]) * g;
#pragma unroll
                        for (int j = 0; j < 4; ++j) v[j] = __builtin_amdgcn_fmed3f(v[j], -440.0f, 440.0f);
                        dq[n] = pk4_fp8(v[0], v[1], v[2], v[3]); }
                    const auto sw = __builtin_amdgcn_permlane16_swap(dq[0], dq[1], false, false);
                    u32x2 w; w.x = sw[0]; w.y = sw[1];
                    if (r < nv) *(u32x2*)(orow + bj * 128 + wc * 32 + (fq & 1) * 16 + (fq >> 1) * 8) = w;
                    asm volatile("" ::: "memory"); } }
    }
};

__device__ __forceinline__ void offs_contig(const int (&R)[2], const int (&C)[2], unsigned ldaB, unsigned ldbB, unsigned (&offA)[2][2], unsigned (&offB)[2]) {
#pragma unroll
    for (int i = 0; i < 2; ++i) { offA[0][i] = (unsigned)R[i] * ldaB + C[i] * 2; offA[1][i] = (unsigned)(R[i] + 128) * ldaB + C[i] * 2; offB[i] = (unsigned)R[i] * ldbB + C[i] * 2; }
}

template <int N, int K>
__device__ __forceinline__ void tr_load(const float* __restrict__ src, const float* __restrict__ ksc, int u, int r, int c4, f32x4 (&v)[8]) {
    constexpr int TN = (N + 255) / 256, TK = K / 64, PTM = TN * TK;
    const int mat = u / PTM, rem = u - mat * PTM, tn = rem / TK, tk = rem - tn * TK;
    const bool ok = (N % 256 == 0) || (tn * 256 + c4 < N);
    const float* s = src + (size_t)mat * K * N + (size_t)(tk * 64 + r) * N + (ok ? tn * 256 + c4 : 0);
#pragma unroll
    for (int p = 0; p < 8; ++p) { f32x4 t = ld4(s + (size_t)p * 8 * N); if (N % 256 != 0) { if (!ok) t = (f32x4){0.f, 0.f, 0.f, 0.f}; } if (ksc) t = t * ksc[tk * 64 + p * 8 + r]; v[p] = t; }
}
template <int N, int K>
__device__ __forceinline__ void transpose_seg(LAS unsigned char* lds, const float* __restrict__ src, bf16_t* __restrict__ dst, int nmat, int& rot, const float* __restrict__ ksc = nullptr) {
    constexpr int TN = (N + 255) / 256, TK = K / 64, PTM = TN * TK;
    const int G = gridDim.x, tid = threadIdx.x, total = nmat * PTM;
    LAS float* tile = (LAS float*)lds;
    const int r = tid >> 6, c4 = (tid & 63) * 4, nl = tid >> 1, kh = (tid & 1) * 32;
    int u = (int)blockIdx.x - rot; if (u < 0) u += G;
    f32x4 v[8];
    if (u < total) tr_load<N, K>(src, ksc, u, r, c4, v);
    while (u < total) {
#pragma unroll
        for (int p = 0; p < 8; ++p) *(LAS f32x4*)(tile + (p * 8 + r) * 260 + c4) = v[p];
        __syncthreads();
        const int mat = u / PTM, rem = u - mat * PTM, tn = rem / TK, tk = rem - tn * TK;
        const int un = u + G;
        if (un < total) tr_load<N, K>(src, ksc, un, r, c4, v);
        float w[32];
#pragma unroll
        for (int j = 0; j < 32; ++j) w[j] = tile[(kh + j) * 260 + nl];
        bf16_t* d = dst + ((size_t)mat * TN * 256 + tn * 256 + nl) * K + tk * 64 + kh;
#pragma unroll
        for (int q = 0; q < 4; ++q) { u32x4 o; o.x = cvt_pk_bf16(w[q * 8 + 0], w[q * 8 + 1]); o.y = cvt_pk_bf16(w[q * 8 + 2], w[q * 8 + 3]);
            o.z = cvt_pk_bf16(w[q * 8 + 4], w[q * 8 + 5]); o.w = cvt_pk_bf16(w[q * 8 + 6], w[q * 8 + 7]); *(u32x4*)(d + q * 8) = o; }
        __syncthreads();
        u = un;
    }
    rot = (rot + total) % G;
}
template <int N, int K>
__device__ __forceinline__ void transpose_seg_f8(LAS unsigned char* lds, const float* __restrict__ src, unsigned char* __restrict__ dst, int nmat, int& rot, const float* __restrict__ ksc = nullptr) {
    constexpr int TN = (N + 255) / 256, TK = K / 64, PTM = TN * TK;
    const int G = gridDim.x, tid = threadIdx.x, total = nmat * PTM;
    LAS float* tile = (LAS float*)lds;
    const int r = tid >> 6, c4 = (tid & 63) * 4, nl = tid >> 1, kh = (tid & 1) * 32;
    int u = (int)blockIdx.x - rot; if (u < 0) u += G;
    f32x4 v[8];
    if (u < total) tr_load<N, K>(src, ksc, u, r, c4, v);
    while (u < total) {
#pragma unroll
        for (int p = 0; p < 8; ++p) *(LAS f32x4*)(tile + (p * 8 + r) * 260 + c4) = v[p];
        __syncthreads();
        const int mat = u / PTM, rem = u - mat * PTM, tn = rem / TK, tk = rem - tn * TK;
        const int un = u + G;
        if (un < total) tr_load<N, K>(src, ksc, un, r, c4, v);
        float w[32];
#pragma unroll
        for (int j = 0; j < 32; ++j) w[j] = tile[(kh + j) * 260 + nl] * 32.0f;
        unsigned char* d = dst + ((size_t)mat * TN * 256 + tn * 256 + nl) * K + tk * 64 + kh;
#pragma unroll
        for (int q = 0; q < 2; ++q) { u32x4 o; o.x = pk4_fp8(w[q * 16 + 0], w[q * 16 + 1], w[q * 16 + 2], w[q * 16 + 3]); o.y = pk4_fp8(w[q * 16 + 4], w[q * 16 + 5], w[q * 16 + 6], w[q * 16 + 7]);
            o.z = pk4_fp8(w[q * 16 + 8], w[q * 16 + 9], w[q * 16 + 10], w[q * 16 + 11]); o.w = pk4_fp8(w[q * 16 + 12], w[q * 16 + 13], w[q * 16 + 14], w[q * 16 + 15]); *(u32x4*)(d + q * 16) = o; }
        __syncthreads();
        u = un;
    }
    rot = (rot + total) % G;
}
__device__ __forceinline__ void rope_table_phase(const int* __restrict__ pos, float* __restrict__ cs) {
    for (int idx = blockIdx.x * NTHREADS + threadIdx.x; idx < T * 32; idx += gridDim.x * NTHREADS) { const int tok = idx >> 5, i = idx & 31;
        const float ang = (float)pos[tok] * exp2f(-(float)i * (13.287712379549449f / 32.0f));
        double tr = (double)ang * 0.15915494309189535; tr -= __builtin_rint(tr); const float frv = (float)tr;
        *(f32x2*)(cs + (size_t)idx * 2) = (f32x2){__builtin_amdgcn_cosf(frv), __builtin_amdgcn_sinf(frv)}; }
}
__device__ __forceinline__ void cvt_p_phase(const float* __restrict__ p, bf16_t* __restrict__ pb) {
    const size_t n8 = (size_t)2 * T * PLE / 8, stride = (size_t)gridDim.x * NTHREADS;
    size_t i = (size_t)blockIdx.x * NTHREADS + threadIdx.x;
    for (; i + 3 * stride < n8; i += 4 * stride) { f32x4 a[4], b[4];
#pragma unroll
        for (int k = 0; k < 4; ++k) { a[k] = ld4(p + (i + k * stride) * 8); b[k] = ld4(p + (i + k * stride) * 8 + 4); }
#pragma unroll
        for (int k = 0; k < 4; ++k) { u32x4 o; o.x = cvt_pk_bf16(a[k][0], a[k][1]); o.y = cvt_pk_bf16(a[k][2], a[k][3]); o.z = cvt_pk_bf16(b[k][0], b[k][1]); o.w = cvt_pk_bf16(b[k][2], b[k][3]);
            *(u32x4*)(pb + (i + k * stride) * 8) = o; } }
    for (; i < n8; i += stride) { const f32x4 a = ld4(p + i * 8), b = ld4(p + i * 8 + 4);
        u32x4 o; o.x = cvt_pk_bf16(a[0], a[1]); o.y = cvt_pk_bf16(a[2], a[3]); o.z = cvt_pk_bf16(b[0], b[1]); o.w = cvt_pk_bf16(b[2], b[3]);
        *(u32x4*)(pb + i * 8) = o; }
}
template <int WIN>
__device__ __forceinline__ void pool_diff_cols(const float* __restrict__ x, LAS const float* rs, const f32x2 gv, bf16_t* __restrict__ diff, int t0, int s0, int c) {
    constexpr int NR = 32 + WIN - 1;
    f32x2 h[NR];
#pragma unroll
    for (int j = 0; j < NR; ++j) { const int row = t0 - (WIN - 1) + j; const bool ok = (s0 - (WIN - 1) + j) >= 0;
        h[j] = *(const f32x2*)(x + (size_t)(ok ? row : t0) * DM + c); }
#pragma unroll
    for (int j = 0; j < NR; ++j) { const int ri = 15 - (WIN - 1) + j; const bool ok = (s0 - (WIN - 1) + j) >= 0; h[j] = ok ? h[j] * rs[ri] * gv : (f32x2){0.f, 0.f}; }
    f32x2 W = (f32x2){0.f, 0.f};
#pragma unroll
    for (int j = 0; j < WIN - 1; ++j) W += h[j];
#pragma unroll
    for (int i = 0; i < 32; ++i) {
        W += h[i + WIN - 1];
        const int s = s0 + i; const int cnt = (s + 1 < WIN) ? s + 1 : WIN;
        const f32x2 d = W * (1.0f / (float)cnt) - h[i + WIN - 1];
        *(unsigned*)(diff + (size_t)(t0 + i) * DM + c) = cvt_pk_bf16(d.x, d.y);
        W -= h[i];
    }
}
__device__ __forceinline__ void pool_diff_phase(LAS unsigned char* lds, const float* __restrict__ x, const float* __restrict__ g, bf16_t* __restrict__ diff) {
    LAS float* rs = (LAS float*)lds;
    const int tid = threadIdx.x, wid = tid >> 6, lane = tid & 63;
    const int c = tid * 2, grp = __builtin_amdgcn_readfirstlane(c >> 8);
    const f32x2 gv = *(const f32x2*)(g + c);
    for (int run = blockIdx.x; run < T / 32; run += gridDim.x) {
        const int t0 = run * 32, s0 = t0 % SEQ, back = s0 < 15 ? s0 : 15;
        __syncthreads();
        { f32x4 v[6][4]; const int r0 = 15 - back + wid;
#pragma unroll
          for (int k = 0; k < 6; ++k) { const int r = r0 + 8 * k; const float* xr = x + (size_t)(t0 - 15 + (r < 47 ? r : 46)) * DM;
#pragma unroll
              for (int q = 0; q < 4; ++q) v[k][q] = ld4(xr + q * 256 + lane * 4); }
#pragma unroll
          for (int k = 0; k < 6; ++k) { const int r = r0 + 8 * k; float ss = 0.f;
#pragma unroll
              for (int q = 0; q < 4; ++q) ss += v[k][q][0] * v[k][q][0] + v[k][q][1] * v[k][q][1] + v[k][q][2] * v[k][q][2] + v[k][q][3] * v[k][q][3];
              ss = wave_sum(ss);
              if (lane == 0 && r < 47) rs[r] = rsqrtf(ss * (1.0f / DM) + EPS); } }
        __syncthreads();
        if (grp == 0) pool_diff_cols<2>(x, rs, gv, diff, t0, s0, c);
        else if (grp == 1) pool_diff_cols<4>(x, rs, gv, diff, t0, s0, c);
        else if (grp == 2) pool_diff_cols<8>(x, rs, gv, diff, t0, s0, c);
        else pool_diff_cols<16>(x, rs, gv, diff, t0, s0, c);
    }
}

template <bool XBF> __device__ __forceinline__ void combine_phase(const float* __restrict__ x1, const bf16_t* __restrict__ slot, bf16_t* __restrict__ x2, unsigned char* __restrict__ x2q, float* __restrict__ rs2) {
    const int tid = threadIdx.x, wid = tid >> 6, lane = tid & 63;
    for (int row0 = blockIdx.x * 8 + wid; row0 < T; row0 += gridDim.x * 16) {
        const int row1 = row0 + gridDim.x * 8; const bool has1 = row1 < T;
        f32x4 xa[2][4]; unsigned sw[2][4][4];
#pragma unroll
        for (int t = 0; t < 2; ++t) { const int row = (t && has1) ? row1 : row0;
#pragma unroll
            for (int q = 0; q < 4; ++q) { const int col = q * 256 + lane * 4;
                if (XBF) { const u32x2 w = *(const u32x2*)((const bf16_t*)x1 + (size_t)row * DM + col); xa[t][q] = (f32x4){bf_lo(w.x), bf_hi(w.x), bf_lo(w.y), bf_hi(w.y)}; } else xa[t][q] = ld4(x1 + (size_t)row * DM + col);
#pragma unroll
                for (int k = 0; k < 4; ++k) sw[t][q][k] = *(const unsigned*)((const unsigned char*)slot + ((size_t)row * 4 + k) * DM + col); } }
#pragma unroll
        for (int t = 0; t < 2; ++t) { if (t == 1 && !has1) break; const int row = t ? row1 : row0; float ss = 0.f;
#pragma unroll
            for (int q = 0; q < 4; ++q) { const int col = q * 256 + lane * 4; f32x4 a = xa[t][q];
                { f32x2 s01 = (f32x2){0.f, 0.f}, s23 = (f32x2){0.f, 0.f};
#pragma unroll
                  for (int k = 0; k < 4; ++k) { const int w = (int)sw[t][q][k]; s01 += __builtin_amdgcn_cvt_pk_f32_fp8(w, false); s23 += __builtin_amdgcn_cvt_pk_f32_fp8(w, true); }
                  a[0] += s01.x * (1.0f / SLOT_SCALE); a[1] += s01.y * (1.0f / SLOT_SCALE); a[2] += s23.x * (1.0f / SLOT_SCALE); a[3] += s23.y * (1.0f / SLOT_SCALE); }
                xa[t][q] = a; st4bf(x2 + (size_t)row * DM + col, a); *(unsigned*)(x2q + (size_t)row * DM + col) = pk4_fp8(a[0], a[1], a[2], a[3]); ss += a[0] * a[0] + a[1] * a[1] + a[2] * a[2] + a[3] * a[3]; }
            ss = wave_sum(ss); if (lane == 0) rs2[row] = rsqrtf(ss * (1.0f / DM) + EPS); }
    }
}
__device__ __forceinline__ void k_finalize_phase(const bf16_t* __restrict__ kvf, const bf16_t* __restrict__ lat, const float* __restrict__ cst, const float* __restrict__ khn, bf16_t* __restrict__ K) {
    const int tid = ltid(), wid = tid >> 6, lane = tid & 63, h = lane >> 3, j = lane & 7;
    const bool x2h = j >= 4;
    f32x4 gn[4], gr[2];
#pragma unroll
    for (int q = 0; q < 4; ++q) gn[q] = ld4(khn + j * 16 + q * 4);
#pragma unroll
    for (int q = 0; q < 2; ++q) gr[q] = ld4(khn + 128 + j * 8 + q * 4);
    const int nb = (j >> 2) * 64 + (j & 3) * 8, rbyte = 128 + (j & 1) * 32 + (j >> 1) * 8;
    constexpr int KT = 2;
    for (int tok0 = blockIdx.x * 8 + wid; tok0 < T; tok0 += gridDim.x * 8 * KT) {
        u32x4 n0[KT], n1[KT], rp[KT]; f32x4 cs[KT][4];
#pragma unroll
        for (int t = 0; t < KT; ++t) { const int tk = tok0 + t * (int)gridDim.x * 8; const int tok = tk < T ? tk : tok0;
            const bf16_t* kp = kvf + (size_t)tok * (NH * 256) + h * 256 + j * 16; n0[t] = *(const u32x4*)kp; n1[t] = *(const u32x4*)(kp + 8);
            rp[t] = *(const u32x4*)(lat + (size_t)tok * LATP + QL + KVL + j * 8);
#pragma unroll
            for (int q = 0; q < 4; ++q) cs[t][q] = ld4(cst + (size_t)tok * 64 + (j & 3) * 16 + q * 4); }
#pragma unroll
        for (int t = 0; t < KT; ++t) { const int tok = tok0 + t * (int)gridDim.x * 8; if (tok >= T) break;
            const int b = tok / SEQ, sq = tok % SEQ;
            float v[16], r[8];
#define UNP8(dst, o_, w_) { dst[o_ + 0] = bf_lo(w_.x); dst[o_ + 1] = bf_hi(w_.x); dst[o_ + 2] = bf_lo(w_.y); dst[o_ + 3] = bf_hi(w_.y); dst[o_ + 4] = bf_lo(w_.z); dst[o_ + 5] = bf_hi(w_.z); dst[o_ + 6] = bf_lo(w_.w); dst[o_ + 7] = bf_hi(w_.w); }
            UNP8(v, 0, n0[t]) UNP8(v, 8, n1[t]) UNP8(r, 0, rp[t])
#undef UNP8
            float ss = 0.f;
#pragma unroll
            for (int i = 0; i < 16; ++i) ss += v[i] * v[i];
#pragma unroll
            for (int i = 0; i < 8; ++i) ss += r[i] * r[i];
            ss += __shfl_xor(ss, 1); ss += __shfl_xor(ss, 2); ss += __shfl_xor(ss, 4);
            const float rstd = rsqrtf(ss * (1.0f / QKD) + EPS);
#pragma unroll
            for (int i = 0; i < 16; ++i) v[i] *= rstd * gn[i >> 2][i & 3];
#pragma unroll
            for (int i = 0; i < 8; ++i) r[i] *= rstd * gr[i >> 2][i & 3];
            float ro[8];
#pragma unroll
            for (int i = 0; i < 8; ++i) { const float o = __shfl_xor(r[i], 4); const float c = cs[t][i >> 1][(i & 1) * 2], sn = cs[t][i >> 1][(i & 1) * 2 + 1];
                ro[i] = x2h ? (r[i] * c + o * sn) : (r[i] * c - o * sn); }
            unsigned char* kr = (unsigned char*)K + ((size_t)(b * NH + h) * SEQ + sq) * QKD;
            u32x2 w;
            w.x = pk4_fp8(v[0], v[1], v[2], v[3]); w.y = pk4_fp8(v[4], v[5], v[6], v[7]); *(u32x2*)(kr + nb) = w;
            w.x = pk4_fp8(v[8], v[9], v[10], v[11]); w.y = pk4_fp8(v[12], v[13], v[14], v[15]); *(u32x2*)(kr + nb + 32) = w;
            w.x = pk4_fp8(ro[0], ro[1], ro[2], ro[3]); w.y = pk4_fp8(ro[4], ro[5], ro[6], ro[7]); *(u32x2*)(kr + rbyte) = w;
        }
    }
}

__device__ __forceinline__ void v_transpose_phase(const bf16_t* __restrict__ kvf, unsigned char* __restrict__ VT) {
    const int tid = ltid(), wid = tid >> 6, lane = tid & 63;
    for (int item = blockIdx.x * 8 + wid; item < (T / 64) * NH; item += gridDim.x * 8) {
        const int h = item & 7, tt = item >> 3, b = tt / (SEQ / 64), kt = tt % (SEQ / 64);
        const bf16_t* src = kvf + (size_t)tt * 64 * (NH * 256) + h * 256 + 128 + 2 * lane;
        unsigned v[64];
#pragma unroll
        for (int k = 0; k < 64; ++k) v[k] = *(const unsigned*)(src + (size_t)k * (NH * 256));
        unsigned char* dst = VT + ((size_t)(b * NH + h) * (SEQ / 64) + kt) * 8192 + lane * 128;
#pragma unroll
        for (int half = 0; half < 2; ++half)
#pragma unroll
            for (int w4 = 0; w4 < 4; ++w4) { u32x4 o;
#pragma unroll
                for (int e = 0; e < 4; ++e) { const int w = w4 * 4 + e, kb = 32 * ((w >> 2) & 1) + 8 * (w & 3) + 4 * (w >> 3);
                    const unsigned q = half ? pk4_fp8(bf_hi(v[kb]), bf_hi(v[kb + 1]), bf_hi(v[kb + 2]), bf_hi(v[kb + 3])) : pk4_fp8(bf_lo(v[kb]), bf_lo(v[kb + 1]), bf_lo(v[kb + 2]), bf_lo(v[kb + 3]));
                    if (e == 0) o.x = q; else if (e == 1) o.y = q; else if (e == 2) o.z = q; else o.w = q; }
                *(u32x4*)(dst + half * 64 + w4 * 16) = o; }
    }
}

constexpr int RT_PART = 0, RT_SSX = 32768, RT_RSTD = RT_SSX + 2048, RT_HIST = RT_RSTD + 256, RT_BASE = RT_HIST + 128, RT_PE = RT_BASE + 128, RT_PRANK = RT_PE + 1024, RT_PGATE = RT_PRANK + 1024;
static_assert(RT_PGATE + 1024 <= BARW_OFF, "router LDS map");
static_assert(WS_END < 0x7ffffff0ull, "workspace must fit one 2 GiB buffer descriptor");
__device__ __forceinline__ void wrg_phase(const float* __restrict__ g, const float* __restrict__ rw, float* __restrict__ wrg) {
    for (int i = blockIdx.x * NTHREADS + threadIdx.x; i < 2 * DM * NE / 4; i += gridDim.x * NTHREADS) { const f32x4 w = ld4(rw + (size_t)i * 4); *(f32x4*)(wrg + (size_t)i * 4) = w * g[i >> 3]; }
}
template <bool XBF>   __device__ __forceinline__ void route_phase(LAS unsigned char* lds, const float* __restrict__ x1, const float* __restrict__ g, const float* __restrict__ wrg, const float* __restrict__ rb,
                                            bf16_t* __restrict__ hn, unsigned* gcnt, int* __restrict__ list, float* __restrict__ gate) {
    const int tid = ltid(), wid = __builtin_amdgcn_readfirstlane(tid >> 6), lane = tid & 63, i32 = lane & 31, kk = lane >> 5, tg = wid >> 2, kq = wid & 3;
    LAS float* part = (LAS float*)(lds + RT_PART); LAS float* ssx = (LAS float*)(lds + RT_SSX); LAS float* rstd_l = (LAS float*)(lds + RT_RSTD);
    LAS int* hist = (LAS int*)(lds + RT_HIST); LAS int* sbase = (LAS int*)(lds + RT_BASE);
    LAS int* pe = (LAS int*)(lds + RT_PE); LAS int* prank = (LAS int*)(lds + RT_PRANK); LAS float* pgate = (LAS float*)(lds + RT_PGATE);
    const float bias = rb[lane & 31];
    const int kbase = kq * 256 + kk * 128;
    for (int blk = blockIdx.x; blk < T / 64; blk += gridDim.x) {
        __syncthreads();
        if (tid < 32) hist[tid] = 0;
        const int tok = blk * 64 + tg * 32 + i32;
        f32x4 xr[32]; float ss = 0.f;
        if (XBF) { const bf16_t* xp = (const bf16_t*)x1 + (size_t)tok * DM + kbase; u32x4 xw[16];
#pragma unroll
            for (int q = 0; q < 16; ++q) xw[q] = *(const u32x4*)(xp + q * 8);
#pragma unroll
            for (int q = 0; q < 16; ++q) { xr[2 * q] = (f32x4){bf_lo(xw[q].x), bf_hi(xw[q].x), bf_lo(xw[q].y), bf_hi(xw[q].y)}; xr[2 * q + 1] = (f32x4){bf_lo(xw[q].z), bf_hi(xw[q].z), bf_lo(xw[q].w), bf_hi(xw[q].w)}; } }
        else { const float* xp = x1 + (size_t)tok * DM + kbase;
#pragma unroll
            for (int q = 0; q < 32; ++q) xr[q] = ld4(xp + q * 4); }
#pragma unroll
        for (int q = 0; q < 32; ++q) ss += xr[q][0] * xr[q][0] + xr[q][1] * xr[q][1] + xr[q][2] * xr[q][2] + xr[q][3] * xr[q][3];
        ssx[(tg * 32 + i32) * 8 + kq * 2 + kk] = ss;
        f32x16 D;
#pragma unroll
        for (int r = 0; r < 16; ++r) D[r] = 0.f;
        const float* wp = wrg + (size_t)kbase * NE + i32; asm volatile("" : "+v"(wp));
        float bA[16], bB[16];
#define RT_LDB(dst, c) _Pragma("unroll") for (int j = 0; j < 16; ++j) dst[j] = wp[((c) * 16 + j) * NE];
#define RT_MMA(src, c) _Pragma("unroll") for (int j = 0; j < 16; ++j) D = __builtin_amdgcn_mfma_f32_32x32x2f32(xr[(c) * 4 + (j >> 2)][j & 3], src[j], D, 0, 0, 0);
        RT_LDB(bA, 0)
        RT_LDB(bB, 1) asm volatile("" ::: "memory"); RT_MMA(bA, 0)
        RT_LDB(bA, 2) asm volatile("" ::: "memory"); RT_MMA(bB, 1)
        RT_LDB(bB, 3) asm volatile("" ::: "memory"); RT_MMA(bA, 2)
        RT_LDB(bA, 4) asm volatile("" ::: "memory"); RT_MMA(bB, 3)
        RT_LDB(bB, 5) asm volatile("" ::: "memory"); RT_MMA(bA, 4)
        RT_LDB(bA, 6) asm volatile("" ::: "memory"); RT_MMA(bB, 5)
        RT_LDB(bB, 7) asm volatile("" ::: "memory"); RT_MMA(bA, 6)
        RT_MMA(bB, 7)
#undef RT_LDB
#undef RT_MMA
#pragma unroll
        for (int r = 0; r < 16; ++r) part[(kq * 64 + tg * 32 + (r & 3) + 8 * (r >> 2) + 4 * kk) * 32 + i32] = D[r];
        __syncthreads();
        if (tid < 64) { float t = 0.f;
#pragma unroll
            for (int j = 0; j < 8; ++j) t += ssx[tid * 8 + j];
            rstd_l[tid] = rsqrtf(t * (1.0f / DM) + EPS); }
        __syncthreads();
        { const float rs = rstd_l[tg * 32 + i32]; unsigned char* hp = (unsigned char*)hn + (size_t)tok * DM + kbase; const float* gp = g + kbase; asm volatile("" : "+v"(gp));
#pragma unroll
          for (int q = 0; q < 8; ++q) { u32x4 o; unsigned ow[4];
#pragma unroll
              for (int t = 0; t < 4; ++t) { const f32x4 gq = ld4(gp + q * 16 + t * 4); const f32x4 a = xr[4 * q + t] * rs * gq; ow[t] = pk4_fp8(a[0], a[1], a[2], a[3]); }
              o.x = ow[0]; o.y = ow[1]; o.z = ow[2]; o.w = ow[3]; *(u32x4*)(hp + q * 16) = o; } }
        const int me = lane & 31;
#pragma unroll
        for (int i = 0; i < 8; ++i) {
            const int tl = wid * 8 + i;
            float logit = ((part[(0 * 64 + tl) * 32 + me] + part[(1 * 64 + tl) * 32 + me]) + (part[(2 * 64 + tl) * 32 + me] + part[(3 * 64 + tl) * 32 + me])) * rstd_l[tl] + bias;
            float tv[4]; int ti[4];
#pragma unroll
            for (int r = 0; r < 4; ++r) { float bv = logit; int bi = me;
#pragma unroll
                for (int msk = 1; msk < 32; msk <<= 1) { const float ov = __shfl_xor(bv, msk); const int oi = __shfl_xor(bi, msk); if (ov > bv || (ov == bv && oi < bi)) { bv = ov; bi = oi; } }
                tv[r] = bv; ti[r] = bi; if (me == bi) logit = -3.0e38f; }
            const float e1 = __expf(tv[1] - tv[0]), e2 = __expf(tv[2] - tv[0]), e3 = __expf(tv[3] - tv[0]); const float isum = 1.0f / (1.0f + e1 + e2 + e3);
            if (lane < 4) { const int e = lane == 0 ? ti[0] : lane == 1 ? ti[1] : lane == 2 ? ti[2] : ti[3];
                const float gt = (lane == 0 ? 1.0f : lane == 1 ? e1 : lane == 2 ? e2 : e3) * isum;
                const int rank = __hip_atomic_fetch_add(hist + e, 1, __ATOMIC_RELAXED, __HIP_MEMORY_SCOPE_WORKGROUP);
                const int pl = tl * 4 + lane; pe[pl] = e; prank[pl] = rank; pgate[pl] = gt; }
        }
        __syncthreads();
        if (tid < 32) sbase[tid] = (int)__hip_atomic_fetch_add(gcnt + tid * 64, (unsigned)hist[tid], __ATOMIC_RELAXED, __HIP_MEMORY_SCOPE_AGENT);
        __syncthreads();
        if (tid < 256) { const int e = pe[tid], slot = sbase[e] + prank[tid], pair = (blk * 64 + (tid >> 2)) * 4 + (tid & 3); list[(size_t)e * T + slot] = pair; gate[pair] = pgate[tid]; }
    }
}

__device__ __forceinline__ bool xcd_deal(int i, int nsplit_log2, int MT, int& gt, int& nj) {
    const int c = (int)blockIdx.x;
    if (gridDim.x == 256) { const int xcd = c & 7, sl = c >> 3; gt = ((i * 8 + xcd) << (5 - nsplit_log2)) + (sl >> nsplit_log2); nj = sl & ((1 << nsplit_log2) - 1); }
    else { const int idx = c + i * (int)gridDim.x; gt = idx >> nsplit_log2; nj = idx & ((1 << nsplit_log2) - 1); }
    return gt < MT;
}
struct UnitC { unsigned A, B0, B1; int row0, col0; };
template <class EpiT>
struct ProvDense {
    typedef UnitC Unit;
    int nt; unsigned offB[2]; unsigned oA0[2][2];
    unsigned A, B; unsigned ldaB, ldbB; int nN, nunits; int a_col_step;
    unsigned b_tile_step;
    int deal_first, deal_stride;
    int mt_per_grp; unsigned b_grp_step;
    EpiT E;
    __device__ __forceinline__ void init(int tid, size_t A_, unsigned ldaB_, size_t B_, unsigned K, int nN_, int nunits_, int a_col_step_, const EpiT& E_, int mt_per_grp_ = 1 << 30, unsigned b_grp_step_ = 0) {
        mt_per_grp = mt_per_grp_; b_grp_step = b_grp_step_; deal_first = 0; deal_stride = 0;
        int R[2], C[2]; stage_coords(tid, R, C); A = (unsigned)A_; B = (unsigned)B_; ldaB = ldaB_; ldbB = K * 2; nN = nN_; nunits = nunits_; a_col_step = a_col_step_; nt = (int)K / 64; b_tile_step = 256u * K * 2u; E = E_;
#pragma unroll
        for (int i = 0; i < 2; ++i) { oA0[0][i] = (unsigned)R[i] * ldaB + C[i] * 2; oA0[1][i] = (unsigned)(R[i] + 128) * ldaB + C[i] * 2; offB[i] = (unsigned)R[i] * ldbB + C[i] * 2; }
    }
    __device__ __forceinline__ bool next(int i, Unit& u) const {
        int mt, nj;
        if (deal_stride > 0) { const int idx = deal_first + i * deal_stride; if (deal_first < 0 || idx >= nunits) return false; mt = idx / nN; nj = idx - mt * nN; }
        else if (nN == 4) { if (!xcd_deal(i, 2, nunits >> 2, mt, nj)) return false; }
        else if (nN == 8) { if (!xcd_deal(i, 3, nunits >> 3, mt, nj)) return false; }
        else { const int idx = (int)blockIdx.x + i * (int)gridDim.x; if (idx >= nunits) return false; mt = idx / nN; nj = idx - mt * nN; }
        u.A = A + (unsigned)mt * 256u * ldaB + (unsigned)nj * (unsigned)a_col_step; u.B0 = B + (unsigned)(mt / mt_per_grp) * b_grp_step + (unsigned)nj * b_tile_step; u.B1 = u.B0 + 128u * ldbB; u.row0 = mt * 256; u.col0 = nj * 256; return true;
    }
    __device__ __forceinline__ void offs(const Unit&, unsigned (&oA)[2][2]) const { oA[0][0] = oA0[0][0]; oA[0][1] = oA0[0][1]; oA[1][0] = oA0[1][0]; oA[1][1] = oA0[1][1]; }
    __device__ __forceinline__ void epi(AccRef acc, const Unit& u, int wr, int wc, int fr, int fq) const { EpiT e = E; e.row0 = u.row0; e.col0 = u.col0; e(acc, wr, wc, fr, fq); }
};

constexpr int MO_CNT = MISC_OFF, MO_OFF = MISC_OFF + 128, MO_TP = MISC_OFF + 256, MO_TE = MISC_OFF + 512;
constexpr int MO_MAXT = 320;
constexpr int MO_DESC = MISC_OFF + 2048;
constexpr int MO_IDX = MISC_OFF + 2560;
constexpr int MO_MAXU = 12;
static_assert(MO_IDX + MO_MAXU * 1024 <= BARW_OFF, "MoE LDS map");
__device__ __forceinline__ void moe_setup(LAS unsigned char* lds, unsigned* gcnt) {
    LAS int* cnt = (LAS int*)(lds + MO_CNT); LAS int* off = (LAS int*)(lds + MO_OFF); LAS int* tp = (LAS int*)(lds + MO_TP); LAS int* te = (LAS int*)(lds + MO_TE);
    const int tid = threadIdx.x;
    __syncthreads();
    if (tid < 64) {
        const int e = tid & 31; const int c = (int)__hip_atomic_load(gcnt + e * 64, __ATOMIC_RELAXED, __HIP_MEMORY_SCOPE_AGENT); const int nt_ = (c + 255) >> 8;
        int so = c, st = nt_;
#pragma unroll
        for (int d = 1; d < 32; d <<= 1) { const int a = __shfl_up(so, d), b = __shfl_up(st, d); if ((tid & 31) >= d) { so += a; st += b; } }
        if (tid < 32) { cnt[e] = c; off[e] = so - c; tp[e] = st - nt_; if (e == 31) tp[32] = st;
            for (int m = 0; m < nt_; ++m) te[st - nt_ + m] = e; }
    }
    __syncthreads();
}
__device__ __forceinline__ void moe_descs(LAS unsigned char* lds, int nsplit_log2) {
    LAS int* cnt = (LAS int*)(lds + MO_CNT); LAS int* off = (LAS int*)(lds + MO_OFF); LAS int* tp = (LAS int*)(lds + MO_TP); LAS int* te = (LAS int*)(lds + MO_TE);
    LAS int* desc = (LAS int*)(lds + MO_DESC);
    const int tid = threadIdx.x;
    if (tid < 16) { int gt, nj;
        if (xcd_deal(tid, nsplit_log2, tp[32], gt, nj)) { const int e = te[gt], mt = gt - tp[e]; int nv = cnt[e] - mt * 256; nv = nv > 256 ? 256 : nv;
            desc[tid * 4 + 0] = e; desc[tid * 4 + 1] = mt; desc[tid * 4 + 2] = nv; desc[tid * 4 + 3] = off[e] + mt * 256; }
        else desc[tid * 4 + 0] = -1; }
    __syncthreads();
}
struct UnitM1 { unsigned A, B0, B1; const float* bg; unsigned char* act; int nv, ul; };
struct ProvMoe1 {
    typedef UnitM1 Unit;
    int nt; unsigned offB[2]; int R0, R1, C0, C1;
    LAS unsigned char* lds; unsigned hn, wgu; const float* bgu; unsigned char* actb; int nunits;
    __device__ __forceinline__ bool next(int i, Unit& u) const {
        int gt, n8; if (i >= MO_MAXU || !xcd_deal(i, 3, nunits >> 3, gt, n8)) return false;
        LAS const int* d = (LAS const int*)(lds + MO_DESC) + i * 4;
        const int e = __builtin_amdgcn_readfirstlane(d[0]), nv = __builtin_amdgcn_readfirstlane(d[2]), p0 = __builtin_amdgcn_readfirstlane(d[3]);
        u.A = hn; u.B0 = wgu + (unsigned)(e * 2048 + n8 * 128) * (unsigned)DM; u.B1 = u.B0 + 1024u * DM;
        u.bg = bgu + e * 2048 + n8 * 128; u.act = actb + (size_t)p0 * DFF + n8 * 128; u.nv = nv; u.ul = i; return true;
    }
    __device__ __forceinline__ void offs(const Unit& u, unsigned (&oA)[2][2]) const {
        LAS const unsigned* ix = (LAS const unsigned*)(lds + MO_IDX) + u.ul * 256;
        oA[0][0] = ix[R0] + C0 * 2; oA[0][1] = ix[R1] + C1 * 2; oA[1][0] = ix[128 + R0] + C0 * 2; oA[1][1] = ix[128 + R1] + C1 * 2;
    }
    __device__ __forceinline__ void epi(AccRef acc, const Unit& u, int wr, int wc, int fr, int fq) const { EpiMoe1 e{u.bg, u.bg + 1024, u.act, u.nv}; e(acc, wr, wc, fr, fq); }
};
__device__ __forceinline__ void moe_gemm1_phase(LAS unsigned char* lds, const __amdgpu_buffer_rsrc_t srd, unsigned hn, unsigned wgu, const float* __restrict__ bgu, const int* __restrict__ list, unsigned char* __restrict__ actb) {
    LAS int* tp = (LAS int*)(lds + MO_TP); LAS int* desc = (LAS int*)(lds + MO_DESC); LAS unsigned* ix = (LAS unsigned*)(lds + MO_IDX);
    const int tid = ltid();
    moe_descs(lds, 3);
    { int pr[MO_MAXU / 2];
#pragma unroll
      for (int k = 0; k < MO_MAXU / 2; ++k) { const int ul = 2 * k + (tid >> 8); const int e = desc[ul * 4 + 0], mt = desc[ul * 4 + 1], nv = desc[ul * 4 + 2]; const int row = tid & 255;
          pr[k] = (e >= 0) ? list[(size_t)e * T + mt * 256 + (row < nv ? row : 0)] : 0; }
#pragma unroll
      for (int k = 0; k < MO_MAXU / 2; ++k) { const int ul = 2 * k + (tid >> 8); ix[ul * 256 + (tid & 255)] = (unsigned)(pr[k] >> 2) * (unsigned)DM; } }
    __syncthreads();
    ProvMoe1 P; int R[2], C[2]; stage_coords(tid, R, C); P.R0 = R[0]; P.R1 = R[1]; P.C0 = C[0]; P.C1 = C[1];
    P.nt = DM / 128; P.offB[0] = (unsigned)R[0] * (unsigned)DM + C[0] * 2; P.offB[1] = (unsigned)R[1] * (unsigned)DM + C[1] * 2;
    P.lds = lds; P.hn = hn; P.wgu = wgu; P.bgu = bgu; P.actb = actb; P.nunits = tp[32] * 8;
    gemm_stream_f8(lds, srd, P);
}
struct UnitM2 { unsigned A, B0, B1; const float* bd; int nv, col0, ul; };
struct ProvMoe2 {
    typedef UnitM2 Unit;
    int nt; unsigned offB[2]; unsigned oA0[2][2];
    LAS unsigned char* lds; unsigned actb, wdn; const float* bdn; const int* list; const float* gate; bf16_t* slot; int nunits;
    __device__ __forceinline__ bool next(int i, Unit& u) const {
        int gt, n4; if (i >= 6 || !xcd_deal(i, 2, nunits >> 2, gt, n4)) return false;
        LAS const int* d = (LAS const int*)(lds + MO_DESC) + i * 4;
        const int e = __builtin_amdgcn_readfirstlane(d[0]), mt = __builtin_amdgcn_readfirstlane(d[1]), nv = __builtin_amdgcn_readfirstlane(d[2]), p0 = __builtin_amdgcn_readfirstlane(d[3]);
        u.A = actb + (unsigned)p0 * (unsigned)DFF; u.B0 = wdn + (unsigned)(e * 1024 + n4 * 256) * (unsigned)DFF; u.B1 = u.B0 + 128u * DFF;
        u.bd = bdn + e * DM; u.nv = nv; u.col0 = n4 * 256; u.ul = i; return true;
    }
    __device__ __forceinline__ void offs(const Unit&, unsigned (&oA)[2][2]) const { oA[0][0] = oA0[0][0]; oA[0][1] = oA0[0][1]; oA[1][0] = oA0[1][0]; oA[1][1] = oA0[1][1]; }
    __device__ __forceinline__ void epi(AccRef acc, const Unit& u, int wr, int wc, int fr, int fq) const { EpiMoe2 e{u.bd, (LAS const int*)(lds + MO_IDX) + u.ul * 512, (LAS const float*)(lds + MO_IDX) + u.ul * 512 + 256, slot, u.nv, u.col0}; e(acc, wr, wc, fr, fq); }
};
__device__ __forceinline__ void moe_gemm2_phase(LAS unsigned char* lds, const __amdgpu_buffer_rsrc_t srd, unsigned actb, unsigned wdn, const float* __restrict__ bdn, const int* __restrict__ list,
                                                const float* __restrict__ gate, bf16_t* __restrict__ slot, int layer, bf16_t* pp_out) {
    LAS int* tp = (LAS int*)(lds + MO_TP);
    const int tid = ltid();
    moe_descs(lds, 2);
    { LAS int* desc = (LAS int*)(lds + MO_DESC); LAS int* lp = (LAS int*)(lds + MO_IDX); LAS float* lg = (LAS float*)(lds + MO_IDX);
      int pr[3]; float gv[3];
#pragma unroll
      for (int k = 0; k < 3; ++k) { const int ul = 2 * k + (tid >> 8); const int e = desc[ul * 4 + 0], mt = desc[ul * 4 + 1], nv = desc[ul * 4 + 2]; const int row = tid & 255;
          pr[k] = (e >= 0) ? list[(size_t)e * T + mt * 256 + (row < nv ? row : 0)] : 0; }
#pragma unroll
      for (int k = 0; k < 3; ++k) gv[k] = gate[pr[k]];
#pragma unroll
      for (int k = 0; k < 3; ++k) { const int ul = 2 * k + (tid >> 8); lp[ul * 512 + (tid & 255)] = pr[k]; lg[ul * 512 + 256 + (tid & 255)] = gv[k]; }
      __syncthreads(); }
    ProvMoe2 P; int R[2], C[2]; stage_coords(tid, R, C); unsigned oB[2]; offs_contig(R, C, DFF, DFF, P.oA0, oB); P.offB[0] = oB[0]; P.offB[1] = oB[1];
    P.nt = DFF / 128; P.lds = lds; P.actb = actb; P.wdn = wdn; P.bdn = bdn; P.list = list; P.gate = gate; P.slot = slot; P.nunits = tp[32] * 4;
    gemm_stream_f8(lds, srd, P);
    {
        const int MT = tp[32], c = (int)blockIdx.x; int first, stride;
        if (gridDim.x == 256) { const int maxr = (MT + 63) >> 6, rem = MT - 64 * (maxr - 1), v = 8 * (c & 7) + (c >> 5);
            if (rem >= 64) { first = c; stride = 256; } else { stride = (64 - rem) * 4; first = v >= rem ? (v - rem) * 4 + ((c >> 3) & 3) : -1; } }
        else { first = c; stride = (int)gridDim.x; }
        ProvDense<EpiBf16> Pv; Pv.init(ltid(), WS_PB + (size_t)layer * T * PLE * 2, PLE * 2, WS_WPP + (size_t)layer * 1024 * PLE * 2, PLE, 4, 256, 0, EpiBf16{pp_out, DM, 0, 0}); Pv.deal_first = first; Pv.deal_stride = stride;
        gemm_stream(lds, srd, Pv);
    }
}

constexpr int AT_VB = 128 * 64, AT_KB = 64 * 192, AT_V0 = 0, AT_K0 = 2 * AT_VB, AT_WS = AT_K0 + 2 * AT_KB;
constexpr float AT_SCALE = 0.07216878364870322f;
constexpr float AT_THR = 3.0f, AT_PSH = 4.0f;
__device__ __forceinline__ int kswz(int row, int cb) { return row * 384 + (cb ^ (((row >> 1) & 7) << 4)); }
__device__ __forceinline__ int crow(int r, int hi) { return (r & 3) + 8 * (r >> 2) + 4 * hi; }
__device__ __forceinline__ int v_st(int k, int c) { const int kk = (k & ~0xC) | ((k & 4) << 1) | ((k & 8) >> 1); return ((kk >> 3) * 4 + (c >> 5)) * 512 + ((kk & 7) * 32 + (c & 31)) * 2; }
__device__ __forceinline__ int v_rd_base(int lane) { return ((lane & 3) << 3) | (((lane >> 2) & 3) << 6) | (((lane >> 4) & 1) << 5) | (((lane >> 5) & 1) << 8); }
constexpr int v_rd_off(int d0, int ks, int half) { return d0 * 512 + ks * 4096 + half * 2048; }
template <int OFF> __device__ __forceinline__ s16x4 tr_read(int vb) { s16x4 r; asm volatile("ds_read_b64_tr_b16 %0, %1 offset:%2" : "=&v"(r) : "v"(vb), "i"(OFF) : "memory"); return r; }
#define SBAR() __builtin_amdgcn_sched_barrier(0)

__device__ __forceinline__ void at_partialSM(f32x16& p0, f32x16& p1, float& m_reg, float& mn, float& alpha) {
    constexpr float C = AT_SCALE * 1.4426950408889634f;
    float pmax = p0[0];
#pragma unroll
    for (int r = 1; r < 16; ++r) pmax = fmaxf(pmax, p0[r]);
#pragma unroll
    for (int r = 0; r < 16; ++r) pmax = fmaxf(pmax, p1[r]);
    { auto rr = __builtin_amdgcn_permlane32_swap(__float_as_uint(pmax), __float_as_uint(pmax), false, false); pmax = fmaxf(__uint_as_float(rr[0]), __uint_as_float(rr[1])); }
    if (__builtin_expect(__all(pmax - m_reg <= AT_THR / AT_SCALE), 1)) { mn = m_reg; alpha = 1.f; }
    else { mn = fmaxf(m_reg, pmax); alpha = __builtin_amdgcn_exp2f((m_reg - mn) * C); m_reg = mn; }
    const float mnC = AT_PSH - mn * C;
    const f32x2 C2 = (f32x2){C, C}, M2 = (f32x2){mnC, mnC};
#pragma unroll
    for (int r = 0; r < 16; r += 2) { const f32x2 t = __builtin_elementwise_fma((f32x2){p0[r], p0[r + 1]}, C2, M2); p0[r] = t.x; p0[r + 1] = t.y; }
#pragma unroll
    for (int r = 0; r < 16; r += 2) { const f32x2 t = __builtin_elementwise_fma((f32x2){p1[r], p1[r + 1]}, C2, M2); p1[r] = t.x; p1[r + 1] = t.y; }
#pragma unroll
    for (int r = 0; r < 16; ++r) p0[r] = __builtin_amdgcn_exp2f(p0[r]);
}
__device__ __forceinline__ void at_qkt(f32x16& p0, f32x16& p1, const LAS unsigned char* Ks, const v8i32 (&q8)[3], const int kb0, const int kb1, bool masked) {
    if (masked) {
#pragma unroll
        for (int r = 0; r < 16; ++r) { p0[r] = -1.0e30f; p1[r] = -1.0e30f; }
        return;
    }
#pragma unroll
    for (int r = 0; r < 16; ++r) { p0[r] = 0.f; p1[r] = 0.f; }
#pragma unroll
    for (int d = 0; d < 3; ++d) {
        const u32x4 a0 = *(const LAS u32x4*)(Ks + kb0 + d * 64), a1 = *(const LAS u32x4*)(Ks + kb1 + d * 64);
        const u32x4 c0 = *(const LAS u32x4*)(Ks + kb0 + d * 64 + 32 * 192), c1 = *(const LAS u32x4*)(Ks + kb1 + d * 64 + 32 * 192);
        const v8i32 b0 = (v8i32){(int)a0.x, (int)a0.y, (int)a0.z, (int)a0.w, (int)a1.x, (int)a1.y, (int)a1.z, (int)a1.w};
        const v8i32 b1 = (v8i32){(int)c0.x, (int)c0.y, (int)c0.z, (int)c0.w, (int)c1.x, (int)c1.y, (int)c1.z, (int)c1.w};
        p0 = __builtin_amdgcn_mfma_scale_f32_32x32x64_f8f6f4(b0, q8[d], p0, 0, 0, 0, 0x7f7f7f7f, 0, 0x7f7f7f7f);
        p1 = __builtin_amdgcn_mfma_scale_f32_32x32x64_f8f6f4(b1, q8[d], p1, 0, 0, 0, 0x7f7f7f7f, 0, 0x7f7f7f7f);
        if (d == 0) __builtin_amdgcn_sched_barrier(0); }
}
__device__ __forceinline__ void at_finishSM(f32x16& p0, f32x16& p1, float alpha, float& l_reg, v8i32& pa) {
#pragma unroll
    for (int r = 0; r < 16; ++r) p1[r] = __builtin_amdgcn_exp2f(p1[r]);
    f32x2 s2 = (f32x2){p0[0], p0[1]} + (f32x2){p1[0], p1[1]};
#pragma unroll
    for (int r = 2; r < 16; r += 2) { s2 += (f32x2){p0[r], p0[r + 1]}; s2 += (f32x2){p1[r], p1[r + 1]}; }
    float ps = s2.x + s2.y;
    { auto rr = __builtin_amdgcn_permlane32_swap(__float_as_uint(ps), __float_as_uint(ps), false, false); ps = __uint_as_float(rr[0]) + __uint_as_float(rr[1]); }
    l_reg = l_reg * alpha + ps;
#define PK4U(P, B, I) { int w_ = pa[I]; w_ = __builtin_amdgcn_cvt_pk_fp8_f32(P[B], P[B + 1], w_, false); w_ = __builtin_amdgcn_cvt_pk_fp8_f32(P[B + 2], P[B + 3], w_, true); pa[I] = w_; }
    PK4U(p0, 0, 0) PK4U(p0, 4, 1) PK4U(p0, 8, 2) PK4U(p0, 12, 3) PK4U(p1, 0, 4) PK4U(p1, 4, 5) PK4U(p1, 8, 6) PK4U(p1, 12, 7)
#undef PK4U
}
__device__ __forceinline__ void at_pv(f32x16 (&o)[4], const LAS unsigned char* Vs, const int vb0, const int vb1, const v8i32 pa) {
#pragma unroll
    for (int d0 = 0; d0 < 4; ++d0) {
        const u32x4 a0 = *(const LAS u32x4*)(Vs + vb0 + d0 * 2048), a1 = *(const LAS u32x4*)(Vs + vb1 + d0 * 2048);
        const v8i32 vf = (v8i32){(int)a0.x, (int)a0.y, (int)a0.z, (int)a0.w, (int)a1.x, (int)a1.y, (int)a1.z, (int)a1.w};
        o[d0] = __builtin_amdgcn_mfma_scale_f32_32x32x64_f8f6f4(pa, vf, o[d0], 0, 0, 0, 0x7f7f7f7f, 0, 0x7f7f7f7f); }
}
constexpr int AT_WT = 45056, WC_PITCH = 1040, WC_GU = 32 * 128, WC_ALL = WC_GU + 32 * 64;
static_assert(AT_WT + 64 * WC_PITCH <= MISC_OFF, "attention LDS map");
struct WConv { int i, ph, pend; };
__device__ __forceinline__ void wc_issue(LAS unsigned char* lds, const float* gu1, const float* dn1, const int u, const int wid, const int lane) {
    const bool dn = u >= WC_GU; const int v = dn ? u - WC_GU : u;
    const int mat = dn ? v >> 6 : v >> 7, tn = dn ? (v >> 4) & 3 : (v >> 4) & 7, tk = v & 15, N = dn ? 1024 : 2048;
    const __amdgpu_buffer_rsrc_t sw = __builtin_amdgcn_make_buffer_rsrc((void*)(dn ? dn1 : gu1), (short)0, 0x7ffffff0, 0x00020000);
    const unsigned so = (unsigned)((mat * 1024 + tk * 64 + wid * 8) * N + tn * 256) * 4u;
#pragma unroll
    for (int r = 0; r < 8; ++r) __builtin_amdgcn_raw_ptr_buffer_load_lds(sw, (LAS unsigned*)(lds + AT_WT + (wid * 8 + r) * WC_PITCH), 16, lane * 16, (int)(so + (unsigned)(r * N) * 4u), 0, 0);
}
__device__ __forceinline__ void wc_consume(LAS unsigned char* lds, unsigned char* ws, const int u) {
    int tz = threadIdx.x; asm volatile("" : "+v"(tz));
    const int nl = tz >> 1, kh = (tz & 1) * 32;
    const bool dn = u >= WC_GU; const int v = dn ? u - WC_GU : u;
    const int mat = dn ? v >> 6 : v >> 7, tn = dn ? (v >> 4) & 3 : (v >> 4) & 7, tk = v & 15;
    const size_t d0 = dn ? WS_WDN + ((size_t)(32 + mat) * 1024 + tn * 256) * 1024 + tk * 64 : WS_WGU + ((size_t)(32 + mat) * 2048 + tn * 256) * 1024 + tk * 64;
    LAS const float* tile = (LAS const float*)(lds + AT_WT);
    float w[32];
#pragma unroll
    for (int j = 0; j < 32; ++j) w[j] = tile[(kh + j) * 260 + nl] * 32.0f;
    unsigned char* d = ws + d0 + (size_t)nl * 1024 + kh;
#pragma unroll
    for (int q = 0; q < 2; ++q) { u32x4 o; o.x = pk4_fp8(w[q * 16 + 0], w[q * 16 + 1], w[q * 16 + 2], w[q * 16 + 3]); o.y = pk4_fp8(w[q * 16 + 4], w[q * 16 + 5], w[q * 16 + 6], w[q * 16 + 7]);
        o.z = pk4_fp8(w[q * 16 + 8], w[q * 16 + 9], w[q * 16 + 10], w[q * 16 + 11]); o.w = pk4_fp8(w[q * 16 + 12], w[q * 16 + 13], w[q * 16 + 14], w[q * 16 + 15]); *(u32x4*)(d + q * 16) = o; }
}
__device__ __forceinline__ void attn_unit(LAS unsigned char* lds, const __amdgpu_buffer_rsrc_t srd, const bf16_t* __restrict__ Qb, const float* __restrict__ csb, const float* __restrict__ qhn, const unsigned Koff, const unsigned Voff, bf16_t* __restrict__ Ob, const int qb, WConv& wc, const float* gu1, const float* dn1, unsigned char* ws) {
    const int tid = ltid(), wid = __builtin_amdgcn_readfirstlane(tid >> 6), lane = tid & 63, r32 = lane & 31, hi = lane >> 5;
    LAS unsigned char* V_lds = lds + AT_V0; LAS unsigned char* K_lds = lds + AT_K0;
    LAS float* wsf = (LAS float*)(lds + AT_WS) + wid * 64; LAS float* li_l = wsf; LAS float* al_l = wsf + 32;
    float m_reg = -1e30f, l_reg = 0; f32x16 o[4]; v8i32 q8[3];
    { const bf16_t* Qw = Qb + (size_t)(wid * 32 + r32) * (NH * QKD) + hi * 8;
      u32x4 qraw[12]; unsigned qd[24]; float ss = 0.f;
#pragma unroll
      for (int d0 = 0; d0 < 12; ++d0) qraw[d0] = *(const u32x4*)(Qw + d0 * 16);
      const float* csr = csb + (size_t)(wid * 32 + r32) * 64 + hi * 16;
#pragma unroll
      for (int d0 = 0; d0 < 12; ++d0) { const u32x4 w = qraw[d0];
          ss += bf_lo(w.x) * bf_lo(w.x) + bf_hi(w.x) * bf_hi(w.x) + bf_lo(w.y) * bf_lo(w.y) + bf_hi(w.y) * bf_hi(w.y) + bf_lo(w.z) * bf_lo(w.z) + bf_hi(w.z) * bf_hi(w.z) + bf_lo(w.w) * bf_lo(w.w) + bf_hi(w.w) * bf_hi(w.w); }
      ss += __shfl_xor(ss, 32);
      const float rstd = rsqrtf(ss * (1.0f / QKD) + EPS);
#define Q_UNPACK(dst, src_) { const u32x4 t_ = (src_); dst[0] = bf_lo(t_.x); dst[1] = bf_hi(t_.x); dst[2] = bf_lo(t_.y); dst[3] = bf_hi(t_.y); dst[4] = bf_lo(t_.z); dst[5] = bf_hi(t_.z); dst[6] = bf_lo(t_.w); dst[7] = bf_hi(t_.w); }
#define Q_PACK(d0, v) { qd[2 * (d0)] = pk4_fp8(v[0], v[1], v[2], v[3]); qd[2 * (d0) + 1] = pk4_fp8(v[4], v[5], v[6], v[7]); }
#pragma unroll
      for (int d0 = 0; d0 < 8; ++d0) { float v[8]; Q_UNPACK(v, qraw[d0]) const f32x4 g0 = ld4(qhn + d0 * 16 + hi * 8), g1 = ld4(qhn + d0 * 16 + hi * 8 + 4);
#pragma unroll
          for (int j = 0; j < 4; ++j) { v[j] *= rstd * g0[j]; v[4 + j] *= rstd * g1[j]; }
          Q_PACK(d0, v) if (d0 & 1) asm volatile("" ::: "memory"); }
#pragma unroll
      for (int dd = 0; dd < 2; ++dd) {
          float x1[8], x2[8]; Q_UNPACK(x1, qraw[8 + dd]) Q_UNPACK(x2, qraw[10 + dd])
          const f32x4 ga = ld4(qhn + (8 + dd) * 16 + hi * 8), gb = ld4(qhn + (8 + dd) * 16 + hi * 8 + 4), gc = ld4(qhn + (10 + dd) * 16 + hi * 8), gd = ld4(qhn + (10 + dd) * 16 + hi * 8 + 4);
#pragma unroll
          for (int j = 0; j < 8; ++j) { const float g1_ = j < 4 ? ga[j & 3] : gb[j & 3], g2_ = j < 4 ? gc[j & 3] : gd[j & 3];
              const float a = x1[j] * rstd * g1_, b = x2[j] * rstd * g2_;
              const f32x2 cv = *(const f32x2*)(csr + dd * 32 + j * 2); const float cs = cv.x, sn = cv.y;
              x1[j] = a * cs - b * sn; x2[j] = b * cs + a * sn; }
          Q_PACK(8 + dd, x1) Q_PACK(10 + dd, x2) asm volatile("" ::: "memory"); }
#undef Q_UNPACK
#undef Q_PACK
#pragma unroll
      for (int d = 0; d < 3; ++d) q8[d] = (v8i32){(int)qd[8 * d + 0], (int)qd[8 * d + 1], (int)qd[8 * d + 2], (int)qd[8 * d + 3], (int)qd[8 * d + 4], (int)qd[8 * d + 5], (int)qd[8 * d + 6], (int)qd[8 * d + 7]};
    }
    asm volatile("" ::: "memory");
#pragma unroll
    for (int d = 0; d < 4; ++d)
#pragma unroll
        for (int r = 0; r < 16; ++r) o[d][r] = 0.f;
    const int NT = 4 * qb + 4, vis = 4 * qb + (wid >> 1);
#define SDMA(k0, kbuf, vbuf) do { int lz_ = lane; asm volatile("" : "+v"(lz_)); unsigned kofs[2], vofs[2]; \
    _Pragma("unroll") for (int _i = 0; _i < 2; ++_i) { const int p = (_i * 8 + wid) * 64 + lz_, row = p / 12, ps = p - row * 12; kofs[_i] = (unsigned)(row * 192 + (((ps & ~3) | ((ps & 3) ^ ((row >> 2) & 3))) << 4)); } \
    { const int p = wid * 64 + lz_, dr = p >> 2, ps = p & 3; vofs[0] = (unsigned)(dr * 64 + ((ps ^ ((dr >> 2) & 3)) << 4)); vofs[1] = 0; } \
    __builtin_amdgcn_raw_ptr_buffer_load_lds(srd, (LAS unsigned*)(K_lds + (kbuf) * AT_KB + wid * 1024), 16, (int)kofs[0], (int)(Koff + (unsigned)(k0) * 192u), 0, 0); \
    if (wid < 4) __builtin_amdgcn_raw_ptr_buffer_load_lds(srd, (LAS unsigned*)(K_lds + (kbuf) * AT_KB + (8 + wid) * 1024), 16, (int)kofs[1], (int)(Koff + (unsigned)(k0) * 192u), 0, 0); \
    __builtin_amdgcn_raw_ptr_buffer_load_lds(srd, (LAS unsigned*)(V_lds + (vbuf) * AT_VB + wid * 1024), 16, (int)vofs[0], (int)(Voff + (unsigned)(k0) * 128u), 0, 0); } while (0)
#define RESC(a) do { if (__any((a) < 1.f)) { if (hi == 0) al_l[r32] = (a); asm volatile("s_waitcnt lgkmcnt(0)" ::: "memory"); \
    _Pragma("unroll") for (int d = 0; d < 4; ++d) _Pragma("unroll") for (int r = 0; r < 16; ++r) o[d][r] *= al_l[crow(r, hi)]; } } while (0)
    f32x16 p0, p1; float mn, al; v8i32 pa = (v8i32){0, 0, 0, 0, 0, 0, 0, 0};
    SDMA(0, 0, 0); asm volatile("s_waitcnt vmcnt(0)" ::: "memory"); __syncthreads();
    for (int j = 0; j < NT; ++j) {
        const int cur = j & 1;
        if (wc.ph == 3 && wc.pend >= 0) { wc_consume(lds, ws, wc.pend); wc.pend = -1; }
        if (j + 1 < NT) SDMA((j + 1) * 64, cur ^ 1, cur ^ 1);
        bool wiss = false;
        if (wc.ph == 0) { const int u = (int)blockIdx.x + (int)gridDim.x * wc.i; if (u < WC_ALL) { int lw_ = lane; asm volatile("" : "+v"(lw_)); wc_issue(lds, gu1, dn1, u, wid, lw_); wc.pend = u; ++wc.i; wiss = true; } }
        wc.ph = wc.ph == 4 ? 0 : wc.ph + 1;
        SBAR();
        int lq_ = lane; asm volatile("" : "+v"(lq_));
        const int rq_ = lq_ & 31, hq_ = lq_ >> 5, kx = (rq_ >> 2) & 3, kb0 = rq_ * 192 + (((2 * hq_) ^ kx) << 4), kb1 = rq_ * 192 + (((2 * hq_ + 1) ^ kx) << 4);
        const int vb0 = rq_ * 64 + (((2 * hq_) ^ kx) << 4), vb1 = rq_ * 64 + (((2 * hq_ + 1) ^ kx) << 4);
        if (j <= vis) {
            at_qkt(p0, p1, K_lds + cur * AT_KB, q8, kb0, kb1, false);
            at_partialSM(p0, p1, m_reg, mn, al);
            RESC(al);
            at_finishSM(p0, p1, al, l_reg, pa); SBAR();
            at_pv(o, V_lds + cur * AT_VB, vb0, vb1, pa); }
        if (wiss) asm volatile("s_waitcnt vmcnt(8) lgkmcnt(0)" ::: "memory");
        else asm volatile("s_waitcnt vmcnt(0) lgkmcnt(0)" ::: "memory");
        __builtin_amdgcn_s_barrier();
        asm volatile("" ::: "memory");
    }
    if (hi == 0) li_l[r32] = l_reg; asm volatile("s_waitcnt lgkmcnt(0)" ::: "memory");
    { int tz = threadIdx.x; asm volatile("" : "+v"(tz));
      const int lz = tz & 63, rz = lz & 31, hz = lz >> 5; const unsigned loff = (unsigned)(hz * 4 * DM + rz) * 2u;
      const char* Ow = (const char*)(Ob + (size_t)(wid * 32) * DM);
#pragma unroll
      for (int r = 0; r < 16; ++r) { const int rb = (r & 3) + 8 * (r >> 2); const float rl = __builtin_amdgcn_rcpf(li_l[rb + 4 * hz]);
          const char* Or = Ow + (size_t)rb * DM * 2;
#pragma unroll
          for (int d0 = 0; d0 < 4; ++d0) { const unsigned w = cvt_pk_bf16(o[d0][r] * rl, 0.f); *(bf16_t*)(Or + loff + d0 * 64) = (bf16_t)(w & 0xffffu); } } }
    __syncthreads();
#undef SDMA
#undef RESC
}
__device__ __forceinline__ void attn_phase(LAS unsigned char* lds, const __amdgpu_buffer_rsrc_t srd, const bf16_t* __restrict__ qf, const float* __restrict__ cs, const float* __restrict__ qhn, bf16_t* __restrict__ O,
                                           const float* gu1, const float* dn1, unsigned char* ws) {
    WConv wc; wc.i = 0; wc.ph = (int)(blockIdx.x % 5u); wc.pend = -1;
    for (int u = blockIdx.x; u < 256; u += gridDim.x) {
        const int bh = 2 * (u & 7) + ((u >> 3) >> 4), pi = (u >> 3) & 15, b = bh >> 3, h = bh & 7;
        const unsigned Koff = (unsigned)(WS_K + (size_t)bh * SEQ * QKD), Voff = (unsigned)(WS_V + (size_t)bh * SEQ * VD);
#pragma unroll 1
        for (int half = 0; half < 2; ++half) {
            const int qb = half == 0 ? 31 - pi : pi; const size_t row0 = (size_t)b * SEQ + qb * 256;
            attn_unit(lds, srd, qf + row0 * (NH * QKD) + h * QKD, cs + row0 * 64, qhn, Koff, Voff, O + row0 * DM + h * VD, qb, wc, gu1, dn1, ws);
        }
    }
    asm volatile("s_waitcnt vmcnt(0)" ::: "memory"); __syncthreads();
    if (wc.pend >= 0) { wc_consume(lds, ws, wc.pend); wc.pend = -1; }
    for (;;) { const int u = (int)blockIdx.x + (int)gridDim.x * wc.i; if (u >= WC_ALL) break;
        __syncthreads();
        { const int tz = ltid(); wc_issue(lds, gu1, dn1, u, __builtin_amdgcn_readfirstlane(tz >> 6), tz & 63); }
        asm volatile("s_waitcnt vmcnt(0)" ::: "memory"); __syncthreads();
        wc_consume(lds, ws, u); ++wc.i; }
}

#ifndef PH_MASK
#define PH_MASK 0x7FFFF
#endif
typedef const __attribute__((address_space(4))) Params* ParamsK;
__device__ __forceinline__ ParamsK phase_params() { ParamsK q = (ParamsK)__builtin_amdgcn_kernarg_segment_ptr(); asm volatile("" : "+s"(q)); return q; }
#define PIN(i) (pq_->in[i])
#define WSP(T_, OFF) ((T_*)(pq_->ws + (OFF)))
#define WGU WSP(bf16_t, WS_WGU)
#define WDN WSP(bf16_t, WS_WDN)
#define WPG WSP(bf16_t, WS_WPG)
#define WPP WSP(bf16_t, WS_WPP)
#define WPOOL WSP(bf16_t, WS_WPOOL)
#define WIN WSP(bf16_t, WS_WIN)
#define WQB WSP(bf16_t, WS_WQB)
#define WKVB WSP(bf16_t, WS_WKVB)
#define WO WSP(bf16_t, WS_WO)
#define PB WSP(bf16_t, WS_PB)
#define PP WSP(bf16_t, WS_PP)
#define AB WSP(bf16_t, WS_AB)
#define X1 WSP(float, WS_X1)
#define X2 WSP(bf16_t, WS_X2)
#define X3 WSP(float, WS_X3)
#define HN WSP(bf16_t, WS_HN)
#define ACT WSP(bf16_t, WS_ACT)
#define SLOT WSP(bf16_t, WS_SLOT)
#define LIST WSP(int, WS_LIST)
#define GATE WSP(float, WS_GATE)
#define LAT WSP(float, WS_LAT)
#define QN WSP(bf16_t, WS_QN)
#define KVN WSP(bf16_t, WS_KVN)
#define QF WSP(bf16_t, WS_QF)
#define KVF WSP(bf16_t, WS_KVF)
#define QB WSP(bf16_t, WS_Q)
#define KB WSP(bf16_t, WS_K)
#define VB WSP(bf16_t, WS_V)
#define CTLW WSP(unsigned, WS_CTL)

__global__ void __launch_bounds__(NTHREADS, 2) mk_fwd(Params P) {
    extern __shared__ __attribute__((aligned(16))) unsigned char lds_raw[];
    LAS unsigned char* lds = (LAS unsigned char*)lds_raw;
    const int tid = threadIdx.x;
    const int lo = P.ph_lo, hi = P.ph_hi;
    const bool multi = (hi - lo) > 1;
    if (tid == 0) { *(volatile LAS unsigned*)(lds + BARW_OFF) = 0u; *(volatile LAS unsigned*)(lds + BARW_OFF + 4) = 0u; }
    __syncthreads();
    XcdBarrier bar; bar.bar = (unsigned*)(P.ws + WS_CTL); bar.x = 0; bar.st = (volatile LAS unsigned*)(lds + BARW_OFF);
    if (multi) bar = xcd_barrier_post((unsigned*)(P.ws + WS_CTL), (volatile LAS unsigned*)(lds + BARW_OFF));
#define IN(k) ((((PH_MASK) >> (k)) & 1) && lo <= (k) && (k) < hi)
#define SEAM(k) do { if (IN(k) && IN((k) + 1)) xcd_barrier(bar); } while (0)
#define SRD_WS __builtin_amdgcn_make_buffer_rsrc((void*)pq_->ws, (short)0, 0x7ffffff0, 0x00020000)
#define PHASE(k, ...) if (IN(k)) { ParamsK pq_ = phase_params(); __VA_ARGS__ }

    PHASE(0,
        int rot = 0;
        transpose_seg_f8<2048, 1024>(lds, PIN(I_W_GU), WSP(unsigned char, WS_WGU), 32, rot);
        transpose_seg_f8<1024, 1024>(lds, PIN(I_W_DN), WSP(unsigned char, WS_WDN), 32, rot);
        transpose_seg_f8<1024, 1024>(lds, PIN(I_PLE_GATE_W), WSP(unsigned char, WS_WPG), 1, rot, PIN(I_PLE_NORM));
        transpose_seg_f8<1024, 1024>(lds, PIN(I_PLE_GATE_W) + (size_t)1024 * 1024, WSP(unsigned char, WS_WPG) + (size_t)1024 * 1024, 1, rot, PIN(I_PLE_NORM) + DM);
        transpose_seg<1024, 256>(lds, PIN(I_PLE_PROJ_W), WPP, 2, rot);
        transpose_seg<256, 256>(lds, PIN(I_POOL_W), WPOOL, 4, rot);
        transpose_seg<704, 1024>(lds, PIN(I_W_IN), WIN, 1, rot, PIN(I_NORM_MIX) + DM);
        transpose_seg<1536, 384>(lds, PIN(I_W_QB), WQB, 1, rot, PIN(I_Q_NORM));
        transpose_seg<2048, 256>(lds, PIN(I_W_KVB), WKVB, 1, rot, PIN(I_KV_NORM));
        transpose_seg<1024, 1024>(lds, PIN(I_W_O), WO, 1, rot);
        cvt_p_phase(PIN(I_P), PB);
        rope_table_phase((const int*)PIN(I_POS), WSP(float, WS_CS));
        wrg_phase(PIN(I_NORM_FFN), PIN(I_ROUTER_W), WSP(float, WS_WRG));
        pool_diff_phase(lds, PIN(I_X), PIN(I_NORM_MIX), AB);)
    SEAM(0);
    PHASE(1,
        { ProvDense<EpiPool> Pv; Pv.init(ltid(), WS_AB, DM * 2, WS_WPOOL, 256, 4, 256, 512, EpiPool{PIN(I_X), PIN(I_POOL_SCALE), X1, 0, 0}); gemm_stream(lds, SRD_WS, Pv); }
        )
    SEAM(1);
#define ROUTE_CALL(L, XIN) route_phase<(L) == 1>(lds, XIN, PIN(I_NORM_FFN) + (L) * DM, WSP(float, WS_WRG) + (size_t)(L) * DM * NE, PIN(I_ROUTER_B) + (L) * NE, HN, CTLW + CW_GCNT + (L) * 32 * 64, LIST, GATE)
#define MOE_PLE_LAYER(L, PH, XIN, XOUT) \
    if (IN(PH)) { ParamsK pq_ = phase_params(); ROUTE_CALL(L, XIN); } \
    SEAM(PH); \
    PHASE((PH) + 1, moe_setup(lds, CTLW + CW_GCNT + (L) * 32 * 64); \
        moe_gemm1_phase(lds, SRD_WS, (unsigned)WS_HN, (unsigned)(WS_WGU + (size_t)(L) * 32 * 2048 * DM), PIN(I_B_GU) + (size_t)(L) * 32 * 2048, LIST, WSP(unsigned char, WS_ACT));) \
    SEAM((PH) + 1); \
    PHASE((PH) + 2, moe_setup(lds, CTLW + CW_GCNT + (L) * 32 * 64); \
        moe_gemm2_phase(lds, SRD_WS, (unsigned)WS_ACT, (unsigned)(WS_WDN + (size_t)(L) * 32 * 1024 * DFF), PIN(I_B_DN) + (size_t)(L) * 32 * DM, LIST, GATE, SLOT, (L), PP + (size_t)(L) * T * DM);) \
    SEAM((PH) + 2); \
    PHASE((PH) + 3, combine_phase<(L) == 1>(XIN, SLOT, X2, WSP(unsigned char, WS_AB), WSP(float, WS_QN));) \
    SEAM((PH) + 3); \
    PHASE((PH) + 4, ProvDense<EpiPle<(L) == 0> > Pv; Pv.init(ltid(), WS_AB, DM, WS_WPG + (size_t)(L) * 1024 * DM, DM / 2  , 4, 256, 0, EpiPle<(L) == 0>{X2, WSP(float, WS_QN), PP + (size_t)(L) * T * DM, XOUT, HN, WSP(float, WS_STAT), 0, 0}); gemm_stream_f8(lds, SRD_WS, Pv);)

    MOE_PLE_LAYER(0, 2, X1, X3)
    SEAM(6);
    PHASE(8, ProvDense<EpiLat> Pv; Pv.init(ltid(), WS_HN, DM * 2, WS_WIN, DM, 3, 192, 0, EpiLat{WSP(float, WS_STAT), WSP(bf16_t, WS_LAT), WSP(float, WS_STAT) + (size_t)T * 16, WSP(float, WS_STAT) + (size_t)T * 32, 0, 0}); gemm_stream(lds, SRD_WS, Pv);)
    SEAM(8);
    PHASE(10,
        { ProvDense<EpiBf16S> Pv; Pv.init(ltid(), WS_LAT, LATP * 2, WS_WQB, QL, 6, 384, 0, EpiBf16S{QF, NH * QKD, WSP(float, WS_STAT) + (size_t)T * 16, 3, 1.0f / QL, 0, 0}); gemm_stream(lds, SRD_WS, Pv); }
        { ProvDense<EpiBf16S> Pv; Pv.init(ltid(), WS_LAT + QL * 2, LATP * 2, WS_WKVB, KVL, 8, 512, 0, EpiBf16S{KVF, NH * 256, WSP(float, WS_STAT) + (size_t)T * 32, 2, 1.0f / KVL, 0, 0}); gemm_stream(lds, SRD_WS, Pv); })
    SEAM(10);
    PHASE(11, v_transpose_phase(KVF, pq_->ws + WS_V); k_finalize_phase(KVF, WSP(bf16_t, WS_LAT), WSP(float, WS_CS), PIN(I_KH_NORM), KB);)
    SEAM(11);
    PHASE(12, attn_phase(lds, SRD_WS, QF, WSP(float, WS_CS), PIN(I_QH_NORM), AB, PIN(I_W_GU) + (size_t)32 * 1024 * 2048, PIN(I_W_DN) + (size_t)32 * 1024 * 1024, pq_->ws);)
    SEAM(12);
    PHASE(13, ProvDense<EpiRes> Pv; Pv.init(ltid(), WS_AB, DM * 2, WS_WO, DM, 4, 256, 0, EpiRes{HN, (bf16_t*)X1, 0, 0}); gemm_stream(lds, SRD_WS, Pv);)
    SEAM(13);
    MOE_PLE_LAYER(1, 14, X1, pq_->out)
#undef IN
#undef SEAM
}

extern "C" void kernel_launch(void* const* d_in, const int* in_sizes, int n_in, void* d_out, int out_size, void* d_ws, size_t ws_size, hipStream_t stream) {
    static int grid = 0;
    if (grid == 0) {
        if (n_in != N_IN || out_size != T * DM || ws_size < WS_END) { fprintf(stderr, "kernel_launch: shape/workspace mismatch (n_in %d out %d ws %zu need %zu)\n", n_in, out_size, ws_size, (size_t)WS_END); grid = -1; return; }
        int dev = 0, cus = 0, per_cu = 0;
        if (hipGetDevice(&dev) != hipSuccess || hipDeviceGetAttribute(&cus, hipDeviceAttributeMultiprocessorCount, dev) != hipSuccess) { grid = -1; return; }
        if (hipFuncSetAttribute((const void*)mk_fwd, hipFuncAttributeMaxDynamicSharedMemorySize, LDS_BYTES) != hipSuccess) { fprintf(stderr, "kernel_launch: hipFuncSetAttribute failed\n"); grid = -1; return; }
        if (hipOccupancyMaxActiveBlocksPerMultiprocessor(&per_cu, (const void*)mk_fwd, NTHREADS, LDS_BYTES) != hipSuccess || per_cu < 1) { fprintf(stderr, "kernel_launch: occupancy query says %d\n", per_cu); (void)hipGetLastError(); grid = -1; return; }
        grid = cus;
    }
    if (grid < 0) return;
    (void)in_sizes;
    hipMemsetAsync((char*)d_ws + WS_CTL, 0, CTL_BYTES, stream);
    Params p{};
    for (int i = 0; i < N_IN; ++i) p.in[i] = (const float*)d_in[i];
    p.out = (float*)d_out; p.ws = (unsigned char*)d_ws;
#if MK_MULTI
    for (int ph = 0; ph < NPHASE; ++ph) { p.ph_lo = ph; p.ph_hi = ph + 1; hipLaunchKernelGGL(mk_fwd, dim3(grid), dim3(NTHREADS), LDS_BYTES, stream, p); }
#else
    p.ph_lo = 0; p.ph_hi = NPHASE; hipLaunchKernelGGL(mk_fwd, dim3(grid), dim3(NTHREADS), LDS_BYTES, stream, p);
#endif
}
```

```cpp
#include <hip/hip_runtime.h>
#include <cstdio>
#include <cstdint>

#ifndef MK_MULTI
#define MK_MULTI 0
#endif

#define LAS __attribute__((address_space(3)))
typedef unsigned short bf16_t;
typedef short bf16x8 __attribute__((ext_vector_type(8)));
typedef short s16x4 __attribute__((ext_vector_type(4)));
typedef float f32x2 __attribute__((ext_vector_type(2)));
typedef float f32x4 __attribute__((ext_vector_type(4)));
typedef float f32x16 __attribute__((ext_vector_type(16)));
typedef unsigned u32x2 __attribute__((ext_vector_type(2)));
typedef unsigned u32x4 __attribute__((ext_vector_type(4)));

constexpr int T = 16384, DM = 1024, SEQ = 8192, NE = 32, DFF = 1024, PLE = 256;
constexpr int NPAIR = T * 4;
constexpr int QL = 384, KVL = 256, NH = 8, QKD = 192, VD = 128, LATP = 768;
constexpr float EPS = 1e-6f;
constexpr int NTHREADS = 512;
constexpr int LDS_BYTES = 147456;
constexpr int MISC_OFF = 131072;
constexpr int BARW_OFF = LDS_BYTES - 16;
constexpr int NPHASE = 19;

enum { I_X = 0, I_P, I_POS, I_NORM_MIX, I_POOL_W, I_POOL_SCALE, I_W_IN, I_Q_NORM, I_W_QB, I_KV_NORM, I_W_KVB, I_QH_NORM, I_KH_NORM, I_W_O,
       I_NORM_FFN, I_ROUTER_W, I_ROUTER_B, I_W_GU, I_B_GU, I_W_DN, I_B_DN, I_PLE_NORM, I_PLE_GATE_W, I_PLE_PROJ_W, N_IN };

constexpr size_t al256(size_t x) { return (x + 255) & ~(size_t)255; }
constexpr size_t CTL_BYTES = 65536;
constexpr size_t WS_CTL  = 0;
constexpr size_t WS_WGU  = WS_CTL + CTL_BYTES;
constexpr size_t WS_WDN  = WS_WGU + (size_t)2 * 32 * 2048 * 1024 * 2;
constexpr size_t WS_WPG  = WS_WDN + (size_t)2 * 32 * 1024 * 1024 * 2;
constexpr size_t WS_WPP  = WS_WPG + (size_t)2 * 1024 * 1024 * 2;
constexpr size_t WS_WPOOL= WS_WPP + (size_t)2 * 1024 * 256 * 2;
constexpr size_t WS_WIN  = WS_WPOOL + (size_t)4 * 256 * 256 * 2;
constexpr size_t WS_WQB  = WS_WIN + (size_t)768 * 1024 * 2;
constexpr size_t WS_WKVB = WS_WQB + (size_t)1536 * 384 * 2;
constexpr size_t WS_WO   = WS_WKVB + (size_t)2048 * 256 * 2;
constexpr size_t WS_PB   = WS_WO + (size_t)1024 * 1024 * 2;
constexpr size_t WS_PP   = WS_PB + (size_t)2 * T * 256 * 2;
constexpr size_t WS_AB   = WS_PP + (size_t)2 * T * 1024 * 2;
constexpr size_t WS_X1   = WS_AB + (size_t)T * 1024 * 2;
constexpr size_t WS_X2   = WS_X1 + (size_t)T * 1024 * 4;
constexpr size_t WS_X3   = WS_X2 + (size_t)T * 1024 * 4;
constexpr size_t WS_HN   = WS_X3 + (size_t)T * 1024 * 4;
constexpr size_t WS_ACT  = WS_HN + (size_t)T * 1024 * 2;
constexpr size_t WS_SLOT = WS_ACT + (size_t)(NPAIR + 256) * 1024 * 2;
constexpr size_t WS_LIST = WS_SLOT + (size_t)NPAIR * 1024 * 2;
constexpr size_t WS_GATE = WS_LIST + (size_t)32 * T * 4;
constexpr size_t WS_LAT  = WS_GATE + (size_t)NPAIR * 4;
constexpr size_t WS_QN   = WS_LAT + (size_t)T * 768 * 4;
constexpr size_t WS_KVN  = WS_QN + (size_t)T * 384 * 2;
constexpr size_t WS_QF   = WS_KVN + (size_t)T * 256 * 2;
constexpr size_t WS_KVF  = WS_QF + (size_t)T * 1536 * 2;
constexpr size_t WS_Q    = WS_KVF + (size_t)T * 2048 * 2;
constexpr size_t WS_K    = WS_Q + (size_t)T * 8 * 192 * 2;
constexpr size_t WS_V    = WS_K + (size_t)T * 8 * 192 * 2;
constexpr size_t WS_WRG  = WS_V + (size_t)T * 8 * 128 * 2;
constexpr size_t WS_STAT = WS_WRG + (size_t)2 * 1024 * 32 * 4;
constexpr size_t WS_CS   = WS_STAT + (size_t)3 * T * 16 * 4;
constexpr size_t WS_END  = WS_CS + (size_t)T * 32 * 2 * 4;
constexpr int CW_GCNT = 4096;

struct Params { const float* in[N_IN]; float* out; unsigned char* ws; int ph_lo, ph_hi; };

__device__ __forceinline__ unsigned cvt_pk_bf16(float lo, float hi) { unsigned r; asm volatile("v_cvt_pk_bf16_f32 %0, %1, %2" : "=v"(r) : "v"(lo), "v"(hi)); return r; }
__device__ __forceinline__ float bf_lo(unsigned w) { return __uint_as_float(w << 16); }
__device__ __forceinline__ float bf_hi(unsigned w) { return __uint_as_float(w & 0xffff0000u); }
__device__ __forceinline__ float wave_sum(float v) {
#pragma unroll
    for (int o = 32; o > 0; o >>= 1) v += __shfl_xor(v, o);
    return v;
}
__device__ __forceinline__ int ltid() { int t = threadIdx.x; asm volatile("" : "+v"(t)); return t; }
__device__ __forceinline__ f32x4 ld4(const float* p) { return *(const f32x4*)p; }
__device__ __forceinline__ f32x4 ld4bf(const bf16_t* p) { const u32x2 w = *(const u32x2*)p; return (f32x4){bf_lo(w.x), bf_hi(w.x), bf_lo(w.y), bf_hi(w.y)}; }
__device__ __forceinline__ void st4bf(bf16_t* p, f32x4 v) { u32x2 w; w.x = cvt_pk_bf16(v[0], v[1]); w.y = cvt_pk_bf16(v[2], v[3]); *(u32x2*)p = w; }
__device__ __forceinline__ f32x4 dpp_ror8(const f32x4 v) { f32x4 r;
#pragma unroll
    for (int j = 0; j < 4; ++j) r[j] = __uint_as_float((unsigned)__builtin_amdgcn_update_dpp(0, (int)__float_as_uint(v[j]), 0x128, 0xf, 0xf, false));
    return r; }
__device__ __forceinline__ f32x4 sel4(const bool c, const f32x4 a, const f32x4 b) { f32x4 r;
#pragma unroll
    for (int j = 0; j < 4; ++j) r[j] = c ? a[j] : b[j];
    return r; }
__device__ __forceinline__ void ld_rows8_f32(const float* blk16, const size_t ld, const int fr, const int fq, f32x4& x0, f32x4& x1) {
    const bool hi8 = fr >= 8; const float* p = blk16 + (size_t)(fr & 7) * ld + (hi8 ? 16 : 0) + fq * 4;
    const f32x4 L1 = ld4(p), L2 = ld4(p + 8 * ld);
    const f32x4 rv = dpp_ror8(sel4(hi8, L1, L2));
    x0 = sel4(hi8, rv, L1); x1 = sel4(hi8, L2, rv);
}
__device__ __forceinline__ void st_rows8_f32(float* blk16, const size_t ld, const int fr, const int fq, const f32x4 v0, const f32x4 v1) {
    const bool hi8 = fr >= 8; float* p = blk16 + (size_t)(fr & 7) * ld + (hi8 ? 16 : 0) + fq * 4;
    const f32x4 rv = dpp_ror8(sel4(hi8, v0, v1));
    *(f32x4*)p = sel4(hi8, rv, v0); *(f32x4*)(p + 8 * ld) = sel4(hi8, v1, rv);
}
__device__ __forceinline__ void ld_pair_bf16(const bf16_t* blk, const int fq, u32x2& w0, u32x2& w1) {
    const u32x4 w = *(const u32x4*)(blk + (fq & 1) * 16 + (fq >> 1) * 8);
    const auto sx = __builtin_amdgcn_permlane16_swap(w.x, w.z, false, false); const auto sy = __builtin_amdgcn_permlane16_swap(w.y, w.w, false, false);
    w0.x = sx[0]; w0.y = sy[0]; w1.x = sx[1]; w1.y = sy[1];
}
__device__ __forceinline__ void st_pair_bf16(bf16_t* blk, const f32x4 v0, const f32x4 v1, const int fq) {
    const auto sx = __builtin_amdgcn_permlane16_swap(cvt_pk_bf16(v0[0], v0[1]), cvt_pk_bf16(v1[0], v1[1]), false, false);
    const auto sy = __builtin_amdgcn_permlane16_swap(cvt_pk_bf16(v0[2], v0[3]), cvt_pk_bf16(v1[2], v1[3]), false, false);
    u32x4 w; w.x = sx[0]; w.y = sy[0]; w.z = sx[1]; w.w = sy[1];
    *(u32x4*)(blk + (fq & 1) * 16 + (fq >> 1) * 8) = w;
}
__device__ __forceinline__ unsigned pk4_fp8(float a, float b, float c, float d) { int w = __builtin_amdgcn_cvt_pk_fp8_f32(a, b, 0, false); w = __builtin_amdgcn_cvt_pk_fp8_f32(c, d, w, true); return (unsigned)w; }
__device__ __forceinline__ float sigmoidf_(float z) { return __builtin_amdgcn_rcpf(1.0f + __builtin_amdgcn_exp2f(-1.4426950408889634f * z)); }

#define XB_TMO      128
#define XB_XCNT(j)  (256  + 64 * (j))
#define XB_XSUB(j)  (1280 + 64 * (j))
#define XB_XGEN(j)  (2304 + 64 * (j))
#define XB_TOP      3328
#define XB_TOPGEN   3392
#define XCD_BAR_WORDS 3456
#define XB_SPIN_CAP (1u << 24)
__device__ __forceinline__ unsigned xb_ld(unsigned* p)              { return __hip_atomic_load(p, __ATOMIC_RELAXED, __HIP_MEMORY_SCOPE_AGENT); }
__device__ __forceinline__ unsigned xb_add(unsigned* p, unsigned v) { return __hip_atomic_fetch_add(p, v, __ATOMIC_RELAXED, __HIP_MEMORY_SCOPE_AGENT); }
__device__ __forceinline__ unsigned xb_xcc_id() { return (unsigned)__builtin_amdgcn_s_getreg((3 << 11) | 20) & 0xFu; }
#define XB_SPIN(cond, bar) do { unsigned _sp = 0; while (cond) { __builtin_amdgcn_s_sleep(1); \
    if ((++_sp & 255u) == 0u) { if (xb_ld(&(bar)[XB_TMO])) break; if (_sp > XB_SPIN_CAP) { atomicAdd(&(bar)[XB_TMO], 1u); break; } } } } while (0)
struct XcdBarrier { unsigned* bar; unsigned x; volatile LAS unsigned* st; };
__device__ __forceinline__ XcdBarrier xcd_barrier_post(unsigned* bar, volatile LAS unsigned* st) {
    XcdBarrier b; b.bar = bar; b.x = xb_xcc_id(); b.st = st;
    if (threadIdx.x == 0) (void)xb_add(&bar[XB_XCNT(b.x)], 1u);
    return b;
}
__device__ __forceinline__ void xcd_barrier_complete(unsigned* bar, unsigned x, unsigned& nloc, unsigned& nx) {
    const unsigned G = gridDim.x * gridDim.y * gridDim.z;
    unsigned sum, cnt, mine, sp = 0u;
    for (;;) {
        sum = 0u; cnt = 0u; mine = 0u;
#pragma unroll
        for (unsigned j = 0; j < 16; ++j) { const unsigned c = xb_ld(&bar[XB_XCNT(j)]); sum += c; cnt += (c > 0u) ? 1u : 0u; mine = (j == x) ? c : mine; }
        if (sum == G) break;
        __builtin_amdgcn_s_sleep(1);
        if ((++sp & 255u) == 0u) { if (xb_ld(&bar[XB_TMO])) break; if (sp > XB_SPIN_CAP) { atomicAdd(&bar[XB_TMO], 1u); break; } }
    }
    nloc = mine > 0u ? mine : 1u; nx = cnt > 0u ? cnt : 1u;
}
__device__ __forceinline__ void xcd_barrier(const XcdBarrier& b) {
    asm volatile("s_waitcnt vmcnt(0)" ::: "memory");
    __syncthreads();
    if (threadIdx.x == 0) {
        unsigned* bar = b.bar;
        __builtin_amdgcn_s_waitcnt(0);
        unsigned nloc = b.st[0], nx = b.st[1];
        if (nloc == 0u) { xcd_barrier_complete(bar, b.x, nloc, nx); b.st[0] = nloc; b.st[1] = nx; }
        const unsigned old = xb_add(&bar[XB_XSUB(b.x)], 1u);
        const unsigned gen = old / nloc;
        if (old + 1u == (gen + 1u) * nloc) {
            __builtin_amdgcn_fence(__ATOMIC_RELEASE, "agent");
            asm volatile("s_waitcnt vmcnt(0)" ::: "memory");
            const unsigned og = xb_add(&bar[XB_TOP], 1u);
            const unsigned tg = og / nx;
            if (og + 1u == (tg + 1u) * nx) xb_add(&bar[XB_TOPGEN], 1u);
            else XB_SPIN(xb_ld(&bar[XB_TOPGEN]) == tg, bar);
            __builtin_amdgcn_fence(__ATOMIC_ACQUIRE, "agent");
            xb_add(&bar[XB_XGEN(b.x)], 1u);
            asm volatile("s_waitcnt vmcnt(0)" ::: "memory");
        } else {
            XB_SPIN(xb_ld(&bar[XB_XGEN(b.x)]) == gen, bar);
            __builtin_amdgcn_fence(__ATOMIC_ACQUIRE, "agent");
            asm volatile("s_waitcnt vmcnt(0)" ::: "memory");
        }
    }
    __syncthreads();
}

constexpr int HTB = 16384;
__device__ __forceinline__ int lds_byte(int r, int c) { const int st = (r >> 4) * 2 + (c >> 5), rr = r & 15, cc = c & 31, ob = rr * 64 + cc * 2; return st * 1024 + (ob ^ (((ob >> 9) & 1) << 5)); }
__device__ __forceinline__ void stage_rc(int b, int& R, int& C) { const int st = b / 1024, sb = b % 1024, swz = sb ^ (((sb >> 9) & 1) << 5); R = (st >> 1) * 16 + swz / 64; C = (st & 1) * 32 + (swz % 64) / 2; }
#define SA_(b, h) (((b) * 2 + (h)) * HTB)
#define SB_(b, h) ((4 + (b) * 2 + (h)) * HTB)
#define G_STAGE(bufoff, sbase, voff) do { _Pragma("unroll") for (int _i = 0; _i < 2; ++_i) \
    __builtin_amdgcn_raw_ptr_buffer_load_lds(srd, (LAS unsigned*)(lds + (bufoff) + ldsw + _i * 8192), 16, (int)(voff)[_i], (int)(sbase), 0, 0); } while (0)
#define G_LDA(dst, b, h) do { _Pragma("unroll") for (int m = 0; m < 4; ++m) _Pragma("unroll") for (int k = 0; k < 2; ++k) dst[m][k] = *(const LAS bf16x8*)(lds + SA_(b, h) + aoff + m * 2048 + k * 1024); } while (0)
#define G_LDB(dst, b, h) do { _Pragma("unroll") for (int n = 0; n < 2; ++n) _Pragma("unroll") for (int k = 0; k < 2; ++k) dst[n][k] = *(const LAS bf16x8*)(lds + SB_(b, h) + boff + n * 2048 + k * 1024); } while (0)
#define G_MMA(ai, bj, At, Bt) do { __builtin_amdgcn_s_setprio(1); _Pragma("unroll") for (int m = 0; m < 4; ++m) _Pragma("unroll") for (int n = 0; n < 2; ++n) _Pragma("unroll") for (int k = 0; k < 2; ++k) \
    acc[ai][bj][m][n] = __builtin_amdgcn_mfma_f32_16x16x32_bf16(Bt[n][k], At[m][k], acc[ai][bj][m][n], 0, 0, 0); __builtin_amdgcn_s_setprio(0); } while (0)
#define WAIT_V(n) asm volatile("s_waitcnt vmcnt(" #n ")" ::: "memory")
#define WAIT_L(n) asm volatile("s_waitcnt lgkmcnt(" #n ")" ::: "memory")
#define BAR __builtin_amdgcn_s_barrier()
#define SCHED __builtin_amdgcn_sched_barrier(0)

__device__ __forceinline__ void stage_coords(int tid, int (&R)[2], int (&C)[2]) { stage_rc(tid * 16, R[0], C[0]); stage_rc(tid * 16 + 8192, R[1], C[1]); }

template <class Prov>
__device__ __forceinline__ void gemm_stream(LAS unsigned char* lds, const __amdgpu_buffer_rsrc_t srd, const Prov& P) {
    const int tid = ltid(), wid = __builtin_amdgcn_readfirstlane(tid >> 6), lane = tid & 63, wr = wid >> 2, wc = wid & 3, fr = lane & 15, fq = lane >> 4;
    const unsigned ldsw = (unsigned)wid * 1024u;
    const int aoff = lds_byte(wr * 64 + fr, fq * 8), boff = lds_byte(wc * 32 + fr, fq * 8);
    typename Prov::Unit cur, nxt;
    if (!P.next(0, cur)) return;
    unsigned oA[2][2]; P.offs(cur, oA);
    const unsigned oB[2] = {P.offB[0], P.offB[1]};
    const int nt = P.nt;
    f32x4 acc[2][2][4][2];
#pragma unroll
    for (int a = 0; a < 2; ++a)
#pragma unroll
        for (int b = 0; b < 2; ++b)
#pragma unroll
            for (int m = 0; m < 4; ++m)
#pragma unroll
                for (int n = 0; n < 2; ++n) acc[a][b][m][n] = (f32x4){0.f, 0.f, 0.f, 0.f};
    bf16x8 At[4][2], B0[2][2], B1[2][2];
    unsigned cA = cur.A, cB0 = cur.B0, cB1 = cur.B1;
    G_STAGE(SB_(0, 0), cB0, oB); G_STAGE(SA_(0, 0), cA, oA[0]); G_STAGE(SB_(0, 1), cB1, oB); G_STAGE(SA_(0, 1), cA, oA[1]);
    if (wr == 1) BAR;
    WAIT_V(4); BAR;
    G_STAGE(SB_(1, 0), cB0 + 128, oB); G_STAGE(SA_(1, 0), cA + 128, oA[0]); G_STAGE(SB_(1, 1), cB1 + 128, oB);
    WAIT_V(6); BAR;
    int ui = 0;
    for (;;) {
        const bool has_next = P.next(ui + 1, nxt);
        const unsigned nA = has_next ? nxt.A : cA, nB0 = has_next ? nxt.B0 : cB0, nB1 = has_next ? nxt.B1 : cB1;
        for (int t = 0; t < nt; t += 2) {
            const bool last = (t == nt - 2);
            const unsigned a1 = cA + (t + 1) * 128;
            G_LDB(B0, 0, 0); SCHED; G_LDA(At, 0, 0); G_STAGE(SA_(1, 1), a1, oA[1]);
            WAIT_L(8); BAR; WAIT_L(0); G_MMA(0, 0, At, B0); BAR; SCHED;
            if (last && has_next) P.offs(nxt, oA);
            const unsigned a2 = last ? nA : cA + (t + 2) * 128, p0 = last ? nB0 : cB0 + (t + 2) * 128, p1 = last ? nB1 : cB1 + (t + 2) * 128;
            G_LDB(B1, 0, 1); G_STAGE(SB_(0, 0), p0, oB);
            BAR; WAIT_L(0); G_MMA(0, 1, At, B1); BAR;
            G_LDA(At, 0, 1); G_STAGE(SA_(0, 0), a2, oA[0]);
            BAR; WAIT_L(0); G_MMA(1, 0, At, B0); BAR; SCHED;
            G_STAGE(SB_(0, 1), p1, oB);
            WAIT_V(6); BAR; G_MMA(1, 1, At, B1); BAR;
            G_LDB(B0, 1, 0); SCHED; G_LDA(At, 1, 0); G_STAGE(SA_(0, 1), a2, oA[1]);
            WAIT_L(8); BAR; WAIT_L(0); G_MMA(0, 0, At, B0); BAR; SCHED;
            G_LDB(B1, 1, 1); G_STAGE(SB_(1, 0), p0 + 128, oB);
            BAR; WAIT_L(0); G_MMA(0, 1, At, B1); BAR;
            G_LDA(At, 1, 1); G_STAGE(SA_(1, 0), a2 + 128, oA[0]);
            BAR; WAIT_L(0); G_MMA(1, 0, At, B0); BAR; SCHED;
            G_STAGE(SB_(1, 1), p1 + 128, oB);
            WAIT_V(6); BAR; G_MMA(1, 1, At, B1); BAR;
        }
        { int tz = threadIdx.x; asm volatile("" : "+v"(tz)); const int wz = __builtin_amdgcn_readfirstlane(tz >> 6), lz = tz & 63; P.epi(acc, cur, wz >> 2, wz & 3, lz & 15, lz >> 4); }
        if (!has_next) break;
#pragma unroll
        for (int a = 0; a < 2; ++a)
#pragma unroll
            for (int b = 0; b < 2; ++b)
#pragma unroll
                for (int m = 0; m < 4; ++m)
#pragma unroll
                    for (int n = 0; n < 2; ++n) acc[a][b][m][n] = (f32x4){0.f, 0.f, 0.f, 0.f};
        cur = nxt; cA = nA; cB0 = nB0; cB1 = nB1; ++ui;
    }
    WAIT_V(0);
    if (wr == 0) BAR;
    BAR;
    __syncthreads();
}

typedef int v8i32 __attribute__((ext_vector_type(8)));
#define F8_LDA(dst, b, h) do { _Pragma("unroll") for (int m = 0; m < 4; ++m) { const u32x4 _lo = *(const LAS u32x4*)(lds + SA_(b, h) + aoff + m * 2048), _hi = *(const LAS u32x4*)(lds + SA_(b, h) + aoff + m * 2048 + 16); \
    dst[m] = (v8i32){(int)_lo.x, (int)_lo.y, (int)_lo.z, (int)_lo.w, (int)_hi.x, (int)_hi.y, (int)_hi.z, (int)_hi.w}; } } while (0)
#define F8_LDB(dst, b, h) do { _Pragma("unroll") for (int n = 0; n < 2; ++n) { const u32x4 _lo = *(const LAS u32x4*)(lds + SB_(b, h) + boff + n * 2048), _hi = *(const LAS u32x4*)(lds + SB_(b, h) + boff + n * 2048 + 16); \
    dst[n] = (v8i32){(int)_lo.x, (int)_lo.y, (int)_lo.z, (int)_lo.w, (int)_hi.x, (int)_hi.y, (int)_hi.z, (int)_hi.w}; } } while (0)
#define F8_MMA(ai, bj, At, Bt) do { __builtin_amdgcn_s_setprio(1); _Pragma("unroll") for (int m = 0; m < 4; ++m) _Pragma("unroll") for (int n = 0; n < 2; ++n) \
    acc[ai][bj][m][n] = __builtin_amdgcn_mfma_scale_f32_16x16x128_f8f6f4(Bt[n], At[m], acc[ai][bj][m][n], 0, 0, 0, 0x7a7a7a7a  , 0, 0x7f7f7f7f  ); __builtin_amdgcn_s_setprio(0); } while (0)
template <class Prov>
__device__ __forceinline__ void gemm_stream_f8(LAS unsigned char* lds, const __amdgpu_buffer_rsrc_t srd, const Prov& P) {
    const int tid = ltid(), wid = __builtin_amdgcn_readfirstlane(tid >> 6), lane = tid & 63, wr = wid >> 2, wc = wid & 3, fr = lane & 15, fq = lane >> 4;
    const unsigned ldsw = (unsigned)wid * 1024u;
    const int aoff = lds_byte(wr * 64 + fr, fq * 16), boff = lds_byte(wc * 32 + fr, fq * 16);
    typename Prov::Unit cur, nxt;
    if (!P.next(0, cur)) return;
    unsigned oA[2][2]; P.offs(cur, oA);
    const unsigned oB[2] = {P.offB[0], P.offB[1]};
    const int nt = P.nt;
    f32x4 acc[2][2][4][2];
#pragma unroll
    for (int a = 0; a < 2; ++a)
#pragma unroll
        for (int b = 0; b < 2; ++b)
#pragma unroll
            for (int m = 0; m < 4; ++m)
#pragma unroll
                for (int n = 0; n < 2; ++n) acc[a][b][m][n] = (f32x4){0.f, 0.f, 0.f, 0.f};
    v8i32 At[4], B0[2], B1[2];
    unsigned cA = cur.A, cB0 = cur.B0, cB1 = cur.B1;
    G_STAGE(SB_(0, 0), cB0, oB); G_STAGE(SA_(0, 0), cA, oA[0]); G_STAGE(SB_(0, 1), cB1, oB); G_STAGE(SA_(0, 1), cA, oA[1]);
    if (wr == 1) BAR;
    WAIT_V(4); BAR;
    G_STAGE(SB_(1, 0), cB0 + 128, oB); G_STAGE(SA_(1, 0), cA + 128, oA[0]); G_STAGE(SB_(1, 1), cB1 + 128, oB);
    WAIT_V(6); BAR;
    int ui = 0;
    for (;;) {
        const bool has_next = P.next(ui + 1, nxt);
        const unsigned nA = has_next ? nxt.A : cA, nB0 = has_next ? nxt.B0 : cB0, nB1 = has_next ? nxt.B1 : cB1;
        for (int t = 0; t < nt; t += 2) {
            const bool last = (t == nt - 2);
            const unsigned a1 = cA + (t + 1) * 128;
            F8_LDB(B0, 0, 0); SCHED; F8_LDA(At, 0, 0); G_STAGE(SA_(1, 1), a1, oA[1]);
            WAIT_L(8); BAR; WAIT_L(0); F8_MMA(0, 0, At, B0); BAR; SCHED;
            if (last && has_next) P.offs(nxt, oA);
            const unsigned a2 = last ? nA : cA + (t + 2) * 128, p0 = last ? nB0 : cB0 + (t + 2) * 128, p1 = last ? nB1 : cB1 + (t + 2) * 128;
            F8_LDB(B1, 0, 1); G_STAGE(SB_(0, 0), p0, oB);
            BAR; WAIT_L(0); F8_MMA(0, 1, At, B1); BAR;
            F8_LDA(At, 0, 1); G_STAGE(SA_(0, 0), a2, oA[0]);
            BAR; WAIT_L(0); F8_MMA(1, 0, At, B0); BAR; SCHED;
            G_STAGE(SB_(0, 1), p1, oB);
            WAIT_V(6); BAR; F8_MMA(1, 1, At, B1); BAR;
            F8_LDB(B0, 1, 0); SCHED; F8_LDA(At, 1, 0); G_STAGE(SA_(0, 1), a2, oA[1]);
            WAIT_L(8); BAR; WAIT_L(0); F8_MMA(0, 0, At, B0); BAR; SCHED;
            F8_LDB(B1, 1, 1); G_STAGE(SB_(1, 0), p0 + 128, oB);
            BAR; WAIT_L(0); F8_MMA(0, 1, At, B1); BAR;
            F8_LDA(At, 1, 1); G_STAGE(SA_(1, 0), a2 + 128, oA[0]);
            BAR; WAIT_L(0); F8_MMA(1, 0, At, B0); BAR; SCHED;
            G_STAGE(SB_(1, 1), p1 + 128, oB);
            WAIT_V(6); BAR; F8_MMA(1, 1, At, B1); BAR;
        }
        { int tz = threadIdx.x; asm volatile("" : "+v"(tz)); const int wz = __builtin_amdgcn_readfirstlane(tz >> 6), lz = tz & 63; P.epi(acc, cur, wz >> 2, wz & 3, lz & 15, lz >> 4); }
        if (!has_next) break;
#pragma unroll
        for (int a = 0; a < 2; ++a)
#pragma unroll
            for (int b = 0; b < 2; ++b)
#pragma unroll
                for (int m = 0; m < 4; ++m)
#pragma unroll
                    for (int n = 0; n < 2; ++n) acc[a][b][m][n] = (f32x4){0.f, 0.f, 0.f, 0.f};
        cur = nxt; cA = nA; cB0 = nB0; cB1 = nB1; ++ui;
    }
    WAIT_V(0);
    if (wr == 0) BAR;
    BAR;
    __syncthreads();
}

#define EPI_ROWS(ai, m) (ai * 128 + wr * 64 + m * 16 + fr)
#define EPI_COLS(bj, n) (bj * 128 + wc * 32 + n * 16 + fq * 4)
#define EPI_ROW16(ai, m) (ai * 128 + wr * 64 + m * 16)
typedef const f32x4 (&AccRef)[2][2][4][2];

struct EpiPool {
    const float* x; const float* scale; float* o; int row0, col0;
    __device__ __forceinline__ void operator()(AccRef acc, int wr, int wc, int fr, int fq) const {
#pragma unroll
        for (int ai = 0; ai < 2; ++ai)
#pragma unroll
            for (int m = 0; m < 4; ++m) { const size_t rb = (size_t)(row0 + EPI_ROW16(ai, m)) * DM;
#pragma unroll
                for (int bj = 0; bj < 2; ++bj) { const int cb = col0 + bj * 128 + wc * 32; f32x4 x0, x1; ld_rows8_f32(x + rb + cb, DM, fr, fq, x0, x1);
                    const f32x4 s0 = ld4(scale + cb + fq * 4), s1 = ld4(scale + cb + 16 + fq * 4);
                    st_rows8_f32(o + rb + cb, DM, fr, fq, x0 + s0 * acc[ai][bj][m][0], x1 + s1 * acc[ai][bj][m][1]); }
                if (m == 3) asm volatile("" ::: "memory"); }
    }
};
struct EpiRes {
    const bf16_t* base; bf16_t* o; int row0, col0;
    __device__ __forceinline__ void operator()(AccRef acc, int wr, int wc, int fr, int fq) const {
#pragma unroll
        for (int ai = 0; ai < 2; ++ai)
#pragma unroll
            for (int m = 0; m < 4; ++m) { const size_t rb = (size_t)(row0 + EPI_ROW16(ai, m)) * DM;
#pragma unroll
                for (int bj = 0; bj < 2; ++bj) { const int cb = col0 + bj * 128 + wc * 32; u32x2 w0, w1; ld_pair_bf16(base + (size_t)(row0 + EPI_ROWS(ai, m)) * DM + cb, fq, w0, w1);
                    const f32x4 x0 = (f32x4){bf_lo(w0.x), bf_hi(w0.x), bf_lo(w0.y), bf_hi(w0.y)}, x1 = (f32x4){bf_lo(w1.x), bf_hi(w1.x), bf_lo(w1.y), bf_hi(w1.y)};
                    st_pair_bf16(o + (size_t)(row0 + EPI_ROWS(ai, m)) * DM + cb, x0 + acc[ai][bj][m][0], x1 + acc[ai][bj][m][1], fq); }
                if (m == 3) asm volatile("" ::: "memory"); }
    }
};
struct EpiBf16 {
    bf16_t* o; int ld, row0, col0;
    __device__ __forceinline__ void operator()(AccRef acc, int wr, int wc, int fr, int fq) const {
#pragma unroll
        for (int ai = 0; ai < 2; ++ai)
#pragma unroll
            for (int m = 0; m < 4; ++m) { const size_t ro = (size_t)(row0 + EPI_ROWS(ai, m)) * ld;
#pragma unroll
                for (int bj = 0; bj < 2; ++bj) st_pair_bf16(o + ro + col0 + bj * 128 + wc * 32, acc[ai][bj][m][0], acc[ai][bj][m][1], fq); }
    }
};
template <bool STATS>
struct EpiPle {
    const bf16_t* x2; const float* rs2; const bf16_t* pp; float* o; bf16_t* xb; float* ss; int row0, col0;
    __device__ __forceinline__ void operator()(AccRef acc, int wr, int wc, int fr, int fq) const {
#pragma unroll
        for (int ai = 0; ai < 2; ++ai)
#pragma unroll
            for (int m = 0; m < 4; ++m) { const int row = row0 + EPI_ROWS(ai, m); const size_t ro = (size_t)row * DM; float sq = 0.f; const float rs = rs2[row];
#pragma unroll
                for (int bj = 0; bj < 2; ++bj) { f32x4 rr[2]; u32x2 pwv[2], xwv[2]; const int cb = col0 + bj * 128 + wc * 32; const size_t rb = (size_t)(row0 + EPI_ROW16(ai, m)) * DM;
                    ld_pair_bf16(x2 + ro + cb, fq, xwv[0], xwv[1]); ld_pair_bf16(pp + ro + cb, fq, pwv[0], pwv[1]);
#pragma unroll
                    for (int n = 0; n < 2; ++n) { const f32x4 a = acc[ai][bj][m][n]; const u32x2 pw = pwv[n], xw = xwv[n];
                        f32x4 r; r[0] = bf_lo(xw.x) + sigmoidf_(a[0] * rs) * bf_lo(pw.x); r[1] = bf_hi(xw.x) + sigmoidf_(a[1] * rs) * bf_hi(pw.x);
                        r[2] = bf_lo(xw.y) + sigmoidf_(a[2] * rs) * bf_lo(pw.y); r[3] = bf_hi(xw.y) + sigmoidf_(a[3] * rs) * bf_hi(pw.y);
                        rr[n] = r;
                        if (STATS) sq += r[0] * r[0] + r[1] * r[1] + r[2] * r[2] + r[3] * r[3]; }
                    if (STATS) st_pair_bf16(xb + ro + cb, rr[0], rr[1], fq);
                    else st_rows8_f32(o + rb + cb, DM, fr, fq, rr[0], rr[1]); }
                if (STATS) { sq += __shfl_xor(sq, 16); sq += __shfl_xor(sq, 32); if (fq == 0) ss[(size_t)row * 16 + (col0 >> 8) * 4 + wc] = sq; }
                if (m == 3) asm volatile("" ::: "memory"); }
    }
};
__device__ __forceinline__ float sum16(const float* p, int n4) { float t = 0.f; for (int i = 0; i < n4; ++i) { const f32x4 v = ld4(p + 4 * i); t += (v[0] + v[1]) + (v[2] + v[3]); } return t; }
struct EpiLat {
    const float* ss3; bf16_t* o; float* ssq; float* sskv; int row0, col0;
    __device__ __forceinline__ void operator()(AccRef acc, int wr, int wc, int fr, int fq) const {
#pragma unroll
        for (int ai = 0; ai < 2; ++ai)
#pragma unroll
            for (int m = 0; m < 4; ++m) { const int row = row0 + EPI_ROWS(ai, m); const float rs = rsqrtf(sum16(ss3 + (size_t)row * 16, 4) * (1.0f / DM) + EPS); float sq[2];
#pragma unroll
                for (int bj = 0; bj < 2; ++bj) { sq[bj] = 0.f;
#pragma unroll
                    for (int n = 0; n < 2; ++n) { const f32x4 v = acc[ai][bj][m][n] * rs; sq[bj] += v[0] * v[0] + v[1] * v[1] + v[2] * v[2] + v[3] * v[3]; }
                    st_pair_bf16(o + (size_t)row * LATP + col0 + bj * 128 + wc * 32, acc[ai][bj][m][0] * rs, acc[ai][bj][m][1] * rs, fq);
                    sq[bj] += __shfl_xor(sq[bj], 16); sq[bj] += __shfl_xor(sq[bj], 32); }
                if (fq == 0) {
                    const int h0 = col0 >> 7;
#pragma unroll
                    for (int bj = 0; bj < 2; ++bj) { const int h = h0 + bj; if (h < 3) ssq[(size_t)row * 16 + 4 * h + wc] = sq[bj]; else if (h < 5) sskv[(size_t)row * 16 + 4 * (h - 3) + wc] = sq[bj]; } } }
    }
};
struct EpiBf16S {
    bf16_t* o; int ld; const float* ss; int np4; float inv_k; int row0, col0;
    __device__ __forceinline__ void operator()(AccRef acc, int wr, int wc, int fr, int fq) const {
#pragma unroll
        for (int ai = 0; ai < 2; ++ai)
#pragma unroll
            for (int m = 0; m < 4; ++m) { const int row = row0 + EPI_ROWS(ai, m); const float rs = rsqrtf(sum16(ss + (size_t)row * 16, np4) * inv_k + EPS); const size_t ro = (size_t)row * ld;
#pragma unroll
                for (int bj = 0; bj < 2; ++bj) st_pair_bf16(o + ro + col0 + bj * 128 + wc * 32, acc[ai][bj][m][0] * rs, acc[ai][bj][m][1] * rs, fq); }
    }
};
struct EpiKV {
    bf16_t* o; const float* ss; unsigned char* vt; int row0, col0;
    __device__ __forceinline__ void operator()(AccRef acc, int wr, int wc, int fr, int fq) const {
        const int t = fr & 3; const unsigned selq = 0x0c0c0400u + (unsigned)t * 0x0101u;
        const bool hi8 = fr >= 8;
#pragma unroll
        for (int ai = 0; ai < 2; ++ai) { float rs[4];
#pragma unroll
            for (int m = 0; m < 4; ++m) { const int row = row0 + EPI_ROWS(ai, m); rs[m] = rsqrtf(sum16(ss + (size_t)row * 16, 2) * (1.0f / KVL) + EPS);
                st_pair_bf16(o + (size_t)row * (NH * 256) + col0 + wc * 32, acc[ai][0][m][0] * rs[m], acc[ai][0][m][1] * rs[m], fq); }
            const int tok0 = row0 + ai * 128 + wr * 64, b = tok0 / SEQ, kt = (tok0 % SEQ) >> 6;
            unsigned char* tile = vt + ((size_t)(b * NH + (col0 >> 8)) * (SEQ / 64) + kt) * 8192;
#pragma unroll
            for (int n = 0; n < 2; ++n) { unsigned W[4];
#pragma unroll
                for (int m = 0; m < 4; ++m) { const f32x4 v = acc[ai][1][m][n] * rs[m]; const int D = (int)pk4_fp8(v[0], v[1], v[2], v[3]);
                    const unsigned q0 = (unsigned)__builtin_amdgcn_update_dpp(0, D, 0x00, 0xf, 0xf, false), q1 = (unsigned)__builtin_amdgcn_update_dpp(0, D, 0x55, 0xf, 0xf, false);
                    const unsigned q2 = (unsigned)__builtin_amdgcn_update_dpp(0, D, 0xAA, 0xf, 0xf, false), q3 = (unsigned)__builtin_amdgcn_update_dpp(0, D, 0xFF, 0xf, 0xf, false);
                    const unsigned lo = __builtin_amdgcn_perm(q1, q0, selq), hi = __builtin_amdgcn_perm(q3, q2, selq);
                    W[m] = lo | (hi << 16); }
                const unsigned s0 = hi8 ? W[0] : W[2], s1 = hi8 ? W[1] : W[3];
                const unsigned r0 = (unsigned)__builtin_amdgcn_update_dpp(0, (int)s0, 0x128, 0xf, 0xf, false), r1 = (unsigned)__builtin_amdgcn_update_dpp(0, (int)s1, 0x128, 0xf, 0xf, false);
                u32x4 ov; ov.x = hi8 ? r0 : W[0]; ov.y = hi8 ? W[2] : r0; ov.z = hi8 ? r1 : W[1]; ov.w = hi8 ? W[3] : r1;
                const int d = wc * 32 + n * 16 + fq * 4 + t;
                *(u32x4*)(tile + d * 64 + ((fr >> 2) & 1) * 32 + (fr >> 3) * 16) = ov; }
            asm volatile("" ::: "memory"); }
    }
};
struct EpiMoe1 {
    const float* bg; const float* bu; unsigned char* act; int nv;
    __device__ __forceinline__ void operator()(AccRef acc, int wr, int wc, int fr, int fq) const {
        f32x4 bgv[2], buv[2];
#pragma unroll
        for (int n = 0; n < 2; ++n) { const int c = wc * 32 + n * 16 + fq * 4; bgv[n] = ld4(bg + c); buv[n] = ld4(bu + c); }
#pragma unroll
        for (int ai = 0; ai < 2; ++ai)
#pragma unroll
            for (int m = 0; m < 4; ++m) { const int r = EPI_ROWS(ai, m);
                unsigned dw[2];
#pragma unroll
                for (int n = 0; n < 2; ++n) {
                    const f32x4 g4 = acc[ai][0][m][n] + bgv[n], u4 = acc[ai][1][m][n] + buv[n]; float a[4];
#pragma unroll
                    for (int j = 0; j < 4; j += 2) {
                        const f32x2 g = (f32x2){fminf(g4[j], 7.0f), fminf(g4[j + 1], 7.0f)}, u = (f32x2){fminf(fmaxf(u4[j], -7.0f), 7.0f), fminf(fmaxf(u4[j + 1], -7.0f), 7.0f)};
                        const f32x2 t = g * (f32x2){-1.702f * 1.4426950408889634f, -1.702f * 1.4426950408889634f};
                        const f32x2 d = (f32x2){__builtin_amdgcn_exp2f(t.x), __builtin_amdgcn_exp2f(t.y)} + (f32x2){1.0f, 1.0f};
                        const f32x2 q = (u + (f32x2){1.0f, 1.0f}) * g * (f32x2){__builtin_amdgcn_rcpf(d.x), __builtin_amdgcn_rcpf(d.y)};
                        a[j] = q.x; a[j + 1] = q.y; }
                    dw[n] = pk4_fp8(a[0], a[1], a[2], a[3]); }
                const auto sw = __builtin_amdgcn_permlane16_swap(dw[0], dw[1], false, false);
                u32x2 w; w.x = sw[0]; w.y = sw[1];
                if (r < nv) *(u32x2*)(act + (size_t)r * DFF + wc * 32 + (fq & 1) * 16 + (fq >> 1) * 8) = w; }
    }
};
constexpr float SLOT_SCALE = 8.0f;
struct EpiMoe2 {
    const float* bd; LAS const int* lpair; LAS const float* lgate; bf16_t* slot; int nv, col0;
    __device__ __forceinline__ void operator()(AccRef acc, int wr, int wc, int fr, int fq) const {
        f32x4 bv[2][2];
#pragma unroll
        for (int bj = 0; bj < 2; ++bj)
#pragma unroll
            for (int n = 0; n < 2; ++n) bv[bj][n] = ld4(bd + col0 + EPI_COLS(bj, n));
#pragma unroll
        for (int ai = 0; ai < 2; ++ai)
#pragma unroll
            for (int m = 0; m < 4; ++m) { const int r = EPI_ROWS(ai, m); const int pair = lpair[r]; const float g = lgate[r] * SLOT_SCALE; unsigned char* orow = (unsigned char*)slot + (size_t)pair * DM + col0;
#pragma unroll
                for (int bj = 0; bj < 2; ++bj) {
                    unsigned dq[2];
#pragma unroll
                    for (int n = 0; n < 2; ++n) { f32x4 v = (acc[ai][bj][m][n] + bv[bj][n]) * g;
#pragma unroll
                        for (int j = 0; j < 4; ++j) v[j] = __builtin_amdgcn_fmed3f(v[j], -440.0f, 440.0f);
                        dq[n] = pk4_fp8(v[0], v[1], v[2], v[3]); }
                    const auto sw = __builtin_amdgcn_permlane16_swap(dq[0], dq[1], false, false);
                    u32x2 w; w.x = sw[0]; w.y = sw[1];
                    if (r < nv) *(u32x2*)(orow + bj * 128 + wc * 32 + (fq & 1) * 16 + (fq >> 1) * 8) = w;
                    asm volatile("" ::: "memory"); } }
    }
};

__device__ __forceinline__ void offs_contig(const int (&R)[2], const int (&C)[2], unsigned ldaB, unsigned ldbB, unsigned (&offA)[2][2], unsigned (&offB)[2]) {
#pragma unroll
    for (int i = 0; i < 2; ++i) { offA[0][i] = (unsigned)R[i] * ldaB + C[i] * 2; offA[1][i] = (unsigned)(R[i] + 128) * ldaB + C[i] * 2; offB[i] = (unsigned)R[i] * ldbB + C[i] * 2; }
}

template <int N, int K>
__device__ __forceinline__ void tr_load(const float* __restrict__ src, const float* __restrict__ ksc, int u, int r, int c4, f32x4 (&v)[8]) {
    constexpr int TN = (N + 255) / 256, TK = K / 64, PTM = TN * TK;
    const int mat = u / PTM, rem = u - mat * PTM, tn = rem / TK, tk = rem - tn * TK;
    const bool ok = (N % 256 == 0) || (tn * 256 + c4 < N);
    const float* s = src + (size_t)mat * K * N + (size_t)(tk * 64 + r) * N + (ok ? tn * 256 + c4 : 0);
#pragma unroll
    for (int p = 0; p < 8; ++p) { f32x4 t = ld4(s + (size_t)p * 8 * N); if (N % 256 != 0) { if (!ok) t = (f32x4){0.f, 0.f, 0.f, 0.f}; } if (ksc) t = t * ksc[tk * 64 + p * 8 + r]; v[p] = t; }
}
template <int N, int K>
__device__ __forceinline__ void transpose_seg(LAS unsigned char* lds, const float* __restrict__ src, bf16_t* __restrict__ dst, int nmat, int& rot, const float* __restrict__ ksc = nullptr) {
    constexpr int TN = (N + 255) / 256, TK = K / 64, PTM = TN * TK;
    const int G = gridDim.x, tid = threadIdx.x, total = nmat * PTM;
    LAS float* tile = (LAS float*)lds;
    const int r = tid >> 6, c4 = (tid & 63) * 4, nl = tid >> 1, kh = (tid & 1) * 32;
    int u = (int)blockIdx.x - rot; if (u < 0) u += G;
    f32x4 v[8];
    if (u < total) tr_load<N, K>(src, ksc, u, r, c4, v);
    while (u < total) {
#pragma unroll
        for (int p = 0; p < 8; ++p) *(LAS f32x4*)(tile + (p * 8 + r) * 260 + c4) = v[p];
        __syncthreads();
        const int mat = u / PTM, rem = u - mat * PTM, tn = rem / TK, tk = rem - tn * TK;
        const int un = u + G;
        if (un < total) tr_load<N, K>(src, ksc, un, r, c4, v);
        float w[32];
#pragma unroll
        for (int j = 0; j < 32; ++j) w[j] = tile[(kh + j) * 260 + nl];
        bf16_t* d = dst + ((size_t)mat * TN * 256 + tn * 256 + nl) * K + tk * 64 + kh;
#pragma unroll
        for (int q = 0; q < 4; ++q) { u32x4 o; o.x = cvt_pk_bf16(w[q * 8 + 0], w[q * 8 + 1]); o.y = cvt_pk_bf16(w[q * 8 + 2], w[q * 8 + 3]);
            o.z = cvt_pk_bf16(w[q * 8 + 4], w[q * 8 + 5]); o.w = cvt_pk_bf16(w[q * 8 + 6], w[q * 8 + 7]); *(u32x4*)(d + q * 8) = o; }
        __syncthreads();
        u = un;
    }
    rot = (rot + total) % G;
}
template <int N, int K>
__device__ __forceinline__ void transpose_seg_f8(LAS unsigned char* lds, const float* __restrict__ src, unsigned char* __restrict__ dst, int nmat, int& rot, const float* __restrict__ ksc = nullptr) {
    constexpr int TN = (N + 255) / 256, TK = K / 64, PTM = TN * TK;
    const int G = gridDim.x, tid = threadIdx.x, total = nmat * PTM;
    LAS float* tile = (LAS float*)lds;
    const int r = tid >> 6, c4 = (tid & 63) * 4, nl = tid >> 1, kh = (tid & 1) * 32;
    int u = (int)blockIdx.x - rot; if (u < 0) u += G;
    f32x4 v[8];
    if (u < total) tr_load<N, K>(src, ksc, u, r, c4, v);
    while (u < total) {
#pragma unroll
        for (int p = 0; p < 8; ++p) *(LAS f32x4*)(tile + (p * 8 + r) * 260 + c4) = v[p];
        __syncthreads();
        const int mat = u / PTM, rem = u - mat * PTM, tn = rem / TK, tk = rem - tn * TK;
        const int un = u + G;
        if (un < total) tr_load<N, K>(src, ksc, un, r, c4, v);
        float w[32];
#pragma unroll
        for (int j = 0; j < 32; ++j) w[j] = tile[(kh + j) * 260 + nl] * 32.0f;
        unsigned char* d = dst + ((size_t)mat * TN * 256 + tn * 256 + nl) * K + tk * 64 + kh;
#pragma unroll
        for (int q = 0; q < 2; ++q) { u32x4 o; o.x = pk4_fp8(w[q * 16 + 0], w[q * 16 + 1], w[q * 16 + 2], w[q * 16 + 3]); o.y = pk4_fp8(w[q * 16 + 4], w[q * 16 + 5], w[q * 16 + 6], w[q * 16 + 7]);
            o.z = pk4_fp8(w[q * 16 + 8], w[q * 16 + 9], w[q * 16 + 10], w[q * 16 + 11]); o.w = pk4_fp8(w[q * 16 + 12], w[q * 16 + 13], w[q * 16 + 14], w[q * 16 + 15]); *(u32x4*)(d + q * 16) = o; }
        __syncthreads();
        u = un;
    }
    rot = (rot + total) % G;
}
__device__ __forceinline__ void rope_table_phase(const int* __restrict__ pos, float* __restrict__ cs) {
    for (int idx = blockIdx.x * NTHREADS + threadIdx.x; idx < T * 32; idx += gridDim.x * NTHREADS) { const int tok = idx >> 5, i = idx & 31;
        const float ang = (float)pos[tok] * exp2f(-(float)i * (13.287712379549449f / 32.0f));
        double tr = (double)ang * 0.15915494309189535; tr -= __builtin_rint(tr); const float frv = (float)tr;
        *(f32x2*)(cs + (size_t)idx * 2) = (f32x2){__builtin_amdgcn_cosf(frv), __builtin_amdgcn_sinf(frv)}; }
}
__device__ __forceinline__ void cvt_p_phase(const float* __restrict__ p, bf16_t* __restrict__ pb) {
    const size_t n8 = (size_t)2 * T * PLE / 8, stride = (size_t)gridDim.x * NTHREADS;
    size_t i = (size_t)blockIdx.x * NTHREADS + threadIdx.x;
    for (; i + 3 * stride < n8; i += 4 * stride) { f32x4 a[4], b[4];
#pragma unroll
        for (int k = 0; k < 4; ++k) { a[k] = ld4(p + (i + k * stride) * 8); b[k] = ld4(p + (i + k * stride) * 8 + 4); }
#pragma unroll
        for (int k = 0; k < 4; ++k) { u32x4 o; o.x = cvt_pk_bf16(a[k][0], a[k][1]); o.y = cvt_pk_bf16(a[k][2], a[k][3]); o.z = cvt_pk_bf16(b[k][0], b[k][1]); o.w = cvt_pk_bf16(b[k][2], b[k][3]);
            *(u32x4*)(pb + (i + k * stride) * 8) = o; } }
    for (; i < n8; i += stride) { const f32x4 a = ld4(p + i * 8), b = ld4(p + i * 8 + 4);
        u32x4 o; o.x = cvt_pk_bf16(a[0], a[1]); o.y = cvt_pk_bf16(a[2], a[3]); o.z = cvt_pk_bf16(b[0], b[1]); o.w = cvt_pk_bf16(b[2], b[3]);
        *(u32x4*)(pb + i * 8) = o; }
}
template <int WIN>
__device__ __forceinline__ void pool_diff_cols(const float* __restrict__ x, LAS const float* rs, const f32x2 gv, bf16_t* __restrict__ diff, int t0, int s0, int c) {
    constexpr int NR = 32 + WIN - 1;
    f32x2 h[NR];
#pragma unroll
    for (int j = 0; j < NR; ++j) { const int row = t0 - (WIN - 1) + j; const bool ok = (s0 - (WIN - 1) + j) >= 0;
        h[j] = *(const f32x2*)(x + (size_t)(ok ? row : t0) * DM + c); }
#pragma unroll
    for (int j = 0; j < NR; ++j) { const int ri = 15 - (WIN - 1) + j; const bool ok = (s0 - (WIN - 1) + j) >= 0; h[j] = ok ? h[j] * rs[ri] * gv : (f32x2){0.f, 0.f}; }
    f32x2 W = (f32x2){0.f, 0.f};
#pragma unroll
    for (int j = 0; j < WIN - 1; ++j) W += h[j];
#pragma unroll
    for (int i = 0; i < 32; ++i) {
        W += h[i + WIN - 1];
        const int s = s0 + i; const int cnt = (s + 1 < WIN) ? s + 1 : WIN;
        const f32x2 d = W * (1.0f / (float)cnt) - h[i + WIN - 1];
        *(unsigned*)(diff + (size_t)(t0 + i) * DM + c) = cvt_pk_bf16(d.x, d.y);
        W -= h[i];
    }
}
__device__ __forceinline__ void pool_diff_phase(LAS unsigned char* lds, const float* __restrict__ x, const float* __restrict__ g, bf16_t* __restrict__ diff) {
    LAS float* rs = (LAS float*)lds;
    const int tid = threadIdx.x, wid = tid >> 6, lane = tid & 63;
    const int c = tid * 2, grp = __builtin_amdgcn_readfirstlane(c >> 8);
    const f32x2 gv = *(const f32x2*)(g + c);
    for (int run = blockIdx.x; run < T / 32; run += gridDim.x) {
        const int t0 = run * 32, s0 = t0 % SEQ, back = s0 < 15 ? s0 : 15;
        __syncthreads();
        { f32x4 v[6][4]; const int r0 = 15 - back + wid;
#pragma unroll
          for (int k = 0; k < 6; ++k) { const int r = r0 + 8 * k; const float* xr = x + (size_t)(t0 - 15 + (r < 47 ? r : 46)) * DM;
#pragma unroll
              for (int q = 0; q < 4; ++q) v[k][q] = ld4(xr + q * 256 + lane * 4); }
#pragma unroll
          for (int k = 0; k < 6; ++k) { const int r = r0 + 8 * k; float ss = 0.f;
#pragma unroll
              for (int q = 0; q < 4; ++q) ss += v[k][q][0] * v[k][q][0] + v[k][q][1] * v[k][q][1] + v[k][q][2] * v[k][q][2] + v[k][q][3] * v[k][q][3];
              ss = wave_sum(ss);
              if (lane == 0 && r < 47) rs[r] = rsqrtf(ss * (1.0f / DM) + EPS); } }
        __syncthreads();
        if (grp == 0) pool_diff_cols<2>(x, rs, gv, diff, t0, s0, c);
        else if (grp == 1) pool_diff_cols<4>(x, rs, gv, diff, t0, s0, c);
        else if (grp == 2) pool_diff_cols<8>(x, rs, gv, diff, t0, s0, c);
        else pool_diff_cols<16>(x, rs, gv, diff, t0, s0, c);
    }
}

template <bool XBF> __device__ __forceinline__ void combine_phase(const float* __restrict__ x1, const bf16_t* __restrict__ slot, bf16_t* __restrict__ x2, unsigned char* __restrict__ x2q, float* __restrict__ rs2) {
    const int tid = threadIdx.x, wid = tid >> 6, lane = tid & 63;
    for (int row0 = blockIdx.x * 8 + wid; row0 < T; row0 += gridDim.x * 16) {
        const int row1 = row0 + gridDim.x * 8; const bool has1 = row1 < T;
        f32x4 xa[2][4]; unsigned sw[2][4][4];
#pragma unroll
        for (int t = 0; t < 2; ++t) { const int row = (t && has1) ? row1 : row0;
#pragma unroll
            for (int q = 0; q < 4; ++q) { const int col = q * 256 + lane * 4;
                if (XBF) { const u32x2 w = *(const u32x2*)((const bf16_t*)x1 + (size_t)row * DM + col); xa[t][q] = (f32x4){bf_lo(w.x), bf_hi(w.x), bf_lo(w.y), bf_hi(w.y)}; } else xa[t][q] = ld4(x1 + (size_t)row * DM + col);
#pragma unroll
                for (int k = 0; k < 4; ++k) sw[t][q][k] = *(const unsigned*)((const unsigned char*)slot + ((size_t)row * 4 + k) * DM + col); } }
#pragma unroll
        for (int t = 0; t < 2; ++t) { if (t == 1 && !has1) break; const int row = t ? row1 : row0; float ss = 0.f;
#pragma unroll
            for (int q = 0; q < 4; ++q) { const int col = q * 256 + lane * 4; f32x4 a = xa[t][q];
                { f32x2 s01 = (f32x2){0.f, 0.f}, s23 = (f32x2){0.f, 0.f};
#pragma unroll
                  for (int k = 0; k < 4; ++k) { const int w = (int)sw[t][q][k]; s01 += __builtin_amdgcn_cvt_pk_f32_fp8(w, false); s23 += __builtin_amdgcn_cvt_pk_f32_fp8(w, true); }
                  a[0] += s01.x * (1.0f / SLOT_SCALE); a[1] += s01.y * (1.0f / SLOT_SCALE); a[2] += s23.x * (1.0f / SLOT_SCALE); a[3] += s23.y * (1.0f / SLOT_SCALE); }
                xa[t][q] = a; st4bf(x2 + (size_t)row * DM + col, a); *(unsigned*)(x2q + (size_t)row * DM + col) = pk4_fp8(a[0], a[1], a[2], a[3]); ss += a[0] * a[0] + a[1] * a[1] + a[2] * a[2] + a[3] * a[3]; }
            ss = wave_sum(ss); if (lane == 0) rs2[row] = rsqrtf(ss * (1.0f / DM) + EPS); }
    }
}
__device__ __forceinline__ void k_finalize_phase(const bf16_t* __restrict__ kvf, const bf16_t* __restrict__ lat, const float* __restrict__ cst, const float* __restrict__ khn, bf16_t* __restrict__ K) {
    const int tid = ltid(), wid = tid >> 6, lane = tid & 63, h = lane >> 3, j = lane & 7;
    const bool x2h = j >= 4;
    f32x4 gn[4], gr[2];
#pragma unroll
    for (int q = 0; q < 4; ++q) gn[q] = ld4(khn + j * 16 + q * 4);
#pragma unroll
    for (int q = 0; q < 2; ++q) gr[q] = ld4(khn + 128 + j * 8 + q * 4);
    const int nb = (j >> 2) * 64 + (j & 3) * 8, rbyte = 128 + (j & 1) * 32 + (j >> 1) * 8;
    constexpr int KT = 2;
    for (int tok0 = blockIdx.x * 8 + wid; tok0 < T; tok0 += gridDim.x * 8 * KT) {
        u32x4 n0[KT], n1[KT], rp[KT]; f32x4 cs[KT][4];
#pragma unroll
        for (int t = 0; t < KT; ++t) { const int tk = tok0 + t * (int)gridDim.x * 8; const int tok = tk < T ? tk : tok0;
            const bf16_t* kp = kvf + (size_t)tok * (NH * 256) + h * 256 + j * 16; n0[t] = *(const u32x4*)kp; n1[t] = *(const u32x4*)(kp + 8);
            rp[t] = *(const u32x4*)(lat + (size_t)tok * LATP + QL + KVL + j * 8);
#pragma unroll
            for (int q = 0; q < 4; ++q) cs[t][q] = ld4(cst + (size_t)tok * 64 + (j & 3) * 16 + q * 4); }
#pragma unroll
        for (int t = 0; t < KT; ++t) { const int tok = tok0 + t * (int)gridDim.x * 8; if (tok >= T) break;
            const int b = tok / SEQ, sq = tok % SEQ;
            float v[16], r[8];
#define UNP8(dst, o_, w_) { dst[o_ + 0] = bf_lo(w_.x); dst[o_ + 1] = bf_hi(w_.x); dst[o_ + 2] = bf_lo(w_.y); dst[o_ + 3] = bf_hi(w_.y); dst[o_ + 4] = bf_lo(w_.z); dst[o_ + 5] = bf_hi(w_.z); dst[o_ + 6] = bf_lo(w_.w); dst[o_ + 7] = bf_hi(w_.w); }
            UNP8(v, 0, n0[t]) UNP8(v, 8, n1[t]) UNP8(r, 0, rp[t])
#undef UNP8
            float ss = 0.f;
#pragma unroll
            for (int i = 0; i < 16; ++i) ss += v[i] * v[i];
#pragma unroll
            for (int i = 0; i < 8; ++i) ss += r[i] * r[i];
            ss += __shfl_xor(ss, 1); ss += __shfl_xor(ss, 2); ss += __shfl_xor(ss, 4);
            const float rstd = rsqrtf(ss * (1.0f / QKD) + EPS);
#pragma unroll
            for (int i = 0; i < 16; ++i) v[i] *= rstd * gn[i >> 2][i & 3];
#pragma unroll
            for (int i = 0; i < 8; ++i) r[i] *= rstd * gr[i >> 2][i & 3];
            float ro[8];
#pragma unroll
            for (int i = 0; i < 8; ++i) { const float o = __shfl_xor(r[i], 4); const float c = cs[t][i >> 1][(i & 1) * 2], sn = cs[t][i >> 1][(i & 1) * 2 + 1];
                ro[i] = x2h ? (r[i] * c + o * sn) : (r[i] * c - o * sn); }
            unsigned char* kr = (unsigned char*)K + ((size_t)(b * NH + h) * SEQ + sq) * QKD;
            u32x2 w;
            w.x = pk4_fp8(v[0], v[1], v[2], v[3]); w.y = pk4_fp8(v[4], v[5], v[6], v[7]); *(u32x2*)(kr + nb) = w;
            w.x = pk4_fp8(v[8], v[9], v[10], v[11]); w.y = pk4_fp8(v[12], v[13], v[14], v[15]); *(u32x2*)(kr + nb + 32) = w;
            w.x = pk4_fp8(ro[0], ro[1], ro[2], ro[3]); w.y = pk4_fp8(ro[4], ro[5], ro[6], ro[7]); *(u32x2*)(kr + rbyte) = w;
        }
    }
}

__device__ __forceinline__ void v_transpose_phase(const bf16_t* __restrict__ kvf, unsigned char* __restrict__ VT) {
    const int tid = ltid(), wid = tid >> 6, lane = tid & 63;
    for (int item = blockIdx.x * 8 + wid; item < (T / 64) * NH; item += gridDim.x * 8) {
        const int h = item & 7, tt = item >> 3, b = tt / (SEQ / 64), kt = tt % (SEQ / 64);
        const bf16_t* src = kvf + (size_t)tt * 64 * (NH * 256) + h * 256 + 128 + 2 * lane;
        unsigned v[64];
#pragma unroll
        for (int k = 0; k < 64; ++k) v[k] = *(const unsigned*)(src + (size_t)k * (NH * 256));
        unsigned char* dst = VT + ((size_t)(b * NH + h) * (SEQ / 64) + kt) * 8192 + lane * 128;
#pragma unroll
        for (int half = 0; half < 2; ++half)
#pragma unroll
            for (int w4 = 0; w4 < 4; ++w4) { u32x4 o;
#pragma unroll
                for (int e = 0; e < 4; ++e) { const int w = w4 * 4 + e, kb = 32 * ((w >> 2) & 1) + 8 * (w & 3) + 4 * (w >> 3);
                    const unsigned q = half ? pk4_fp8(bf_hi(v[kb]), bf_hi(v[kb + 1]), bf_hi(v[kb + 2]), bf_hi(v[kb + 3])) : pk4_fp8(bf_lo(v[kb]), bf_lo(v[kb + 1]), bf_lo(v[kb + 2]), bf_lo(v[kb + 3]));
                    if (e == 0) o.x = q; else if (e == 1) o.y = q; else if (e == 2) o.z = q; else o.w = q; }
                *(u32x4*)(dst + half * 64 + w4 * 16) = o; }
    }
}

constexpr int RT_PART = 0, RT_SSX = 32768, RT_RSTD = RT_SSX + 2048, RT_HIST = RT_RSTD + 256, RT_BASE = RT_HIST + 128, RT_PE = RT_BASE + 128, RT_PRANK = RT_PE + 1024, RT_PGATE = RT_PRANK + 1024;
static_assert(RT_PGATE + 1024 <= BARW_OFF, "router LDS map");
static_assert(WS_END < 0x7ffffff0ull, "workspace must fit one 2 GiB buffer descriptor");
__device__ __forceinline__ void wrg_phase(const float* __restrict__ g, const float* __restrict__ rw, float* __restrict__ wrg) {
    for (int i = blockIdx.x * NTHREADS + threadIdx.x; i < 2 * DM * NE / 4; i += gridDim.x * NTHREADS) { const f32x4 w = ld4(rw + (size_t)i * 4); *(f32x4*)(wrg + (size_t)i * 4) = w * g[i >> 3]; }
}
template <bool XBF>   __device__ __forceinline__ void route_phase(LAS unsigned char* lds, const float* __restrict__ x1, const float* __restrict__ g, const float* __restrict__ wrg, const float* __restrict__ rb,
                                            bf16_t* __restrict__ hn, unsigned* gcnt, int* __restrict__ list, float* __restrict__ gate) {
    const int tid = ltid(), wid = __builtin_amdgcn_readfirstlane(tid >> 6), lane = tid & 63, i32 = lane & 31, kk = lane >> 5, tg = wid >> 2, kq = wid & 3;
    LAS float* part = (LAS float*)(lds + RT_PART); LAS float* ssx = (LAS float*)(lds + RT_SSX); LAS float* rstd_l = (LAS float*)(lds + RT_RSTD);
    LAS int* hist = (LAS int*)(lds + RT_HIST); LAS int* sbase = (LAS int*)(lds + RT_BASE);
    LAS int* pe = (LAS int*)(lds + RT_PE); LAS int* prank = (LAS int*)(lds + RT_PRANK); LAS float* pgate = (LAS float*)(lds + RT_PGATE);
    const float bias = rb[lane & 31];
    const int kbase = kq * 256 + kk * 128;
    for (int blk = blockIdx.x; blk < T / 64; blk += gridDim.x) {
        __syncthreads();
        if (tid < 32) hist[tid] = 0;
        const int tok = blk * 64 + tg * 32 + i32;
        f32x4 xr[32]; float ss = 0.f;
        if (XBF) { const bf16_t* xp = (const bf16_t*)x1 + (size_t)tok * DM + kbase; u32x4 xw[16];
#pragma unroll
            for (int q = 0; q < 16; ++q) xw[q] = *(const u32x4*)(xp + q * 8);
#pragma unroll
            for (int q = 0; q < 16; ++q) { xr[2 * q] = (f32x4){bf_lo(xw[q].x), bf_hi(xw[q].x), bf_lo(xw[q].y), bf_hi(xw[q].y)}; xr[2 * q + 1] = (f32x4){bf_lo(xw[q].z), bf_hi(xw[q].z), bf_lo(xw[q].w), bf_hi(xw[q].w)}; } }
        else { const float* xp = x1 + (size_t)tok * DM + kbase;
#pragma unroll
            for (int q = 0; q < 32; ++q) xr[q] = ld4(xp + q * 4); }
#pragma unroll
        for (int q = 0; q < 32; ++q) ss += xr[q][0] * xr[q][0] + xr[q][1] * xr[q][1] + xr[q][2] * xr[q][2] + xr[q][3] * xr[q][3];
        ssx[(tg * 32 + i32) * 8 + kq * 2 + kk] = ss;
        f32x16 D;
#pragma unroll
        for (int r = 0; r < 16; ++r) D[r] = 0.f;
        const float* wp = wrg + (size_t)kbase * NE + i32; asm volatile("" : "+v"(wp));
        float bA[16], bB[16];
#define RT_LDB(dst, c) _Pragma("unroll") for (int j = 0; j < 16; ++j) dst[j] = wp[((c) * 16 + j) * NE];
#define RT_MMA(src, c) _Pragma("unroll") for (int j = 0; j < 16; ++j) D = __builtin_amdgcn_mfma_f32_32x32x2f32(xr[(c) * 4 + (j >> 2)][j & 3], src[j], D, 0, 0, 0);
        RT_LDB(bA, 0)
        RT_LDB(bB, 1) asm volatile("" ::: "memory"); RT_MMA(bA, 0)
        RT_LDB(bA, 2) asm volatile("" ::: "memory"); RT_MMA(bB, 1)
        RT_LDB(bB, 3) asm volatile("" ::: "memory"); RT_MMA(bA, 2)
        RT_LDB(bA, 4) asm volatile("" ::: "memory"); RT_MMA(bB, 3)
        RT_LDB(bB, 5) asm volatile("" ::: "memory"); RT_MMA(bA, 4)
        RT_LDB(bA, 6) asm volatile("" ::: "memory"); RT_MMA(bB, 5)
        RT_LDB(bB, 7) asm volatile("" ::: "memory"); RT_MMA(bA, 6)
        RT_MMA(bB, 7)
#undef RT_LDB
#undef RT_MMA
#pragma unroll
        for (int r = 0; r < 16; ++r) part[(kq * 64 + tg * 32 + (r & 3) + 8 * (r >> 2) + 4 * kk) * 32 + i32] = D[r];
        __syncthreads();
        if (tid < 64) { float t = 0.f;
#pragma unroll
            for (int j = 0; j < 8; ++j) t += ssx[tid * 8 + j];
            rstd_l[tid] = rsqrtf(t * (1.0f / DM) + EPS); }
        __syncthreads();
        { const float rs = rstd_l[tg * 32 + i32]; unsigned char* hp = (unsigned char*)hn + (size_t)tok * DM + kbase; const float* gp = g + kbase; asm volatile("" : "+v"(gp));
#pragma unroll
          for (int q = 0; q < 8; ++q) { u32x4 o; unsigned ow[4];
#pragma unroll
              for (int t = 0; t < 4; ++t) { const f32x4 gq = ld4(gp + q * 16 + t * 4); const f32x4 a = xr[4 * q + t] * rs * gq; ow[t] = pk4_fp8(a[0], a[1], a[2], a[3]); }
              o.x = ow[0]; o.y = ow[1]; o.z = ow[2]; o.w = ow[3]; *(u32x4*)(hp + q * 16) = o; } }
        const int me = lane & 31;
#pragma unroll
        for (int i = 0; i < 8; ++i) {
            const int tl = wid * 8 + i;
            float logit = ((part[(0 * 64 + tl) * 32 + me] + part[(1 * 64 + tl) * 32 + me]) + (part[(2 * 64 + tl) * 32 + me] + part[(3 * 64 + tl) * 32 + me])) * rstd_l[tl] + bias;
            float tv[4]; int ti[4];
#pragma unroll
            for (int r = 0; r < 4; ++r) { float bv = logit; int bi = me;
#pragma unroll
                for (int msk = 1; msk < 32; msk <<= 1) { const float ov = __shfl_xor(bv, msk); const int oi = __shfl_xor(bi, msk); if (ov > bv || (ov == bv && oi < bi)) { bv = ov; bi = oi; } }
                tv[r] = bv; ti[r] = bi; if (me == bi) logit = -3.0e38f; }
            const float e1 = __expf(tv[1] - tv[0]), e2 = __expf(tv[2] - tv[0]), e3 = __expf(tv[3] - tv[0]); const float isum = 1.0f / (1.0f + e1 + e2 + e3);
            if (lane < 4) { const int e = lane == 0 ? ti[0] : lane == 1 ? ti[1] : lane == 2 ? ti[2] : ti[3];
                const float gt = (lane == 0 ? 1.0f : lane == 1 ? e1 : lane == 2 ? e2 : e3) * isum;
                const int rank = __hip_atomic_fetch_add(hist + e, 1, __ATOMIC_RELAXED, __HIP_MEMORY_SCOPE_WORKGROUP);
                const int pl = tl * 4 + lane; pe[pl] = e; prank[pl] = rank; pgate[pl] = gt; }
        }
        __syncthreads();
        if (tid < 32) sbase[tid] = (int)__hip_atomic_fetch_add(gcnt + tid * 64, (unsigned)hist[tid], __ATOMIC_RELAXED, __HIP_MEMORY_SCOPE_AGENT);
        __syncthreads();
        if (tid < 256) { const int e = pe[tid], slot = sbase[e] + prank[tid], pair = (blk * 64 + (tid >> 2)) * 4 + (tid & 3); list[(size_t)e * T + slot] = pair; gate[pair] = pgate[tid]; }
    }
}

__device__ __forceinline__ bool xcd_deal(int i, int nsplit_log2, int MT, int& gt, int& nj) {
    const int c = (int)blockIdx.x;
    if (gridDim.x == 256) { const int xcd = c & 7, sl = c >> 3; gt = ((i * 8 + xcd) << (5 - nsplit_log2)) + (sl >> nsplit_log2); nj = sl & ((1 << nsplit_log2) - 1); }
    else { const int idx = c + i * (int)gridDim.x; gt = idx >> nsplit_log2; nj = idx & ((1 << nsplit_log2) - 1); }
    return gt < MT;
}
struct UnitC { unsigned A, B0, B1; int row0, col0; };
template <class EpiT>
struct ProvDense {
    typedef UnitC Unit;
    int nt; unsigned offB[2]; unsigned oA0[2][2];
    unsigned A, B; unsigned ldaB, ldbB; int nN, nunits; int a_col_step;
    unsigned b_tile_step;
    int deal_first, deal_stride;
    int mt_per_grp; unsigned b_grp_step;
    EpiT E;
    __device__ __forceinline__ void init(int tid, size_t A_, unsigned ldaB_, size_t B_, unsigned K, int nN_, int nunits_, int a_col_step_, const EpiT& E_, int mt_per_grp_ = 1 << 30, unsigned b_grp_step_ = 0) {
        mt_per_grp = mt_per_grp_; b_grp_step = b_grp_step_; deal_first = 0; deal_stride = 0;
        int R[2], C[2]; stage_coords(tid, R, C); A = (unsigned)A_; B = (unsigned)B_; ldaB = ldaB_; ldbB = K * 2; nN = nN_; nunits = nunits_; a_col_step = a_col_step_; nt = (int)K / 64; b_tile_step = 256u * K * 2u; E = E_;
#pragma unroll
        for (int i = 0; i < 2; ++i) { oA0[0][i] = (unsigned)R[i] * ldaB + C[i] * 2; oA0[1][i] = (unsigned)(R[i] + 128) * ldaB + C[i] * 2; offB[i] = (unsigned)R[i] * ldbB + C[i] * 2; }
    }
    __device__ __forceinline__ bool next(int i, Unit& u) const {
        int mt, nj;
        if (deal_stride > 0) { const int idx = deal_first + i * deal_stride; if (deal_first < 0 || idx >= nunits) return false; mt = idx / nN; nj = idx - mt * nN; }
        else if (nN == 4) { if (!xcd_deal(i, 2, nunits >> 2, mt, nj)) return false; }
        else if (nN == 8) { if (!xcd_deal(i, 3, nunits >> 3, mt, nj)) return false; }
        else { const int idx = (int)blockIdx.x + i * (int)gridDim.x; if (idx >= nunits) return false; mt = idx / nN; nj = idx - mt * nN; }
        u.A = A + (unsigned)mt * 256u * ldaB + (unsigned)nj * (unsigned)a_col_step; u.B0 = B + (unsigned)(mt / mt_per_grp) * b_grp_step + (unsigned)nj * b_tile_step; u.B1 = u.B0 + 128u * ldbB; u.row0 = mt * 256; u.col0 = nj * 256; return true;
    }
    __device__ __forceinline__ void offs(const Unit&, unsigned (&oA)[2][2]) const { oA[0][0] = oA0[0][0]; oA[0][1] = oA0[0][1]; oA[1][0] = oA0[1][0]; oA[1][1] = oA0[1][1]; }
    __device__ __forceinline__ void epi(AccRef acc, const Unit& u, int wr, int wc, int fr, int fq) const { EpiT e = E; e.row0 = u.row0; e.col0 = u.col0; e(acc, wr, wc, fr, fq); }
};

constexpr int MO_CNT = MISC_OFF, MO_OFF = MISC_OFF + 128, MO_TP = MISC_OFF + 256, MO_TE = MISC_OFF + 512;
constexpr int MO_MAXT = 320;
constexpr int MO_DESC = MISC_OFF + 2048;
constexpr int MO_IDX = MISC_OFF + 2560;
constexpr int MO_MAXU = 12;
static_assert(MO_IDX + MO_MAXU * 1024 <= BARW_OFF, "MoE LDS map");
__device__ __forceinline__ void moe_setup(LAS unsigned char* lds, unsigned* gcnt) {
    LAS int* cnt = (LAS int*)(lds + MO_CNT); LAS int* off = (LAS int*)(lds + MO_OFF); LAS int* tp = (LAS int*)(lds + MO_TP); LAS int* te = (LAS int*)(lds + MO_TE);
    const int tid = threadIdx.x;
    __syncthreads();
    if (tid < 64) {
        const int e = tid & 31; const int c = (int)__hip_atomic_load(gcnt + e * 64, __ATOMIC_RELAXED, __HIP_MEMORY_SCOPE_AGENT); const int nt_ = (c + 255) >> 8;
        int so = c, st = nt_;
#pragma unroll
        for (int d = 1; d < 32; d <<= 1) { const int a = __shfl_up(so, d), b = __shfl_up(st, d); if ((tid & 31) >= d) { so += a; st += b; } }
        if (tid < 32) { cnt[e] = c; off[e] = so - c; tp[e] = st - nt_; if (e == 31) tp[32] = st;
            for (int m = 0; m < nt_; ++m) te[st - nt_ + m] = e; }
    }
    __syncthreads();
}
__device__ __forceinline__ void moe_descs(LAS unsigned char* lds, int nsplit_log2) {
    LAS int* cnt = (LAS int*)(lds + MO_CNT); LAS int* off = (LAS int*)(lds + MO_OFF); LAS int* tp = (LAS int*)(lds + MO_TP); LAS int* te = (LAS int*)(lds + MO_TE);
    LAS int* desc = (LAS int*)(lds + MO_DESC);
    const int tid = threadIdx.x;
    if (tid < 16) { int gt, nj;
        if (xcd_deal(tid, nsplit_log2, tp[32], gt, nj)) { const int e = te[gt], mt = gt - tp[e]; int nv = cnt[e] - mt * 256; nv = nv > 256 ? 256 : nv;
            desc[tid * 4 + 0] = e; desc[tid * 4 + 1] = mt; desc[tid * 4 + 2] = nv; desc[tid * 4 + 3] = off[e] + mt * 256; }
        else desc[tid * 4 + 0] = -1; }
    __syncthreads();
}
struct UnitM1 { unsigned A, B0, B1; const float* bg; unsigned char* act; int nv, ul; };
struct ProvMoe1 {
    typedef UnitM1 Unit;
    int nt; unsigned offB[2]; int R0, R1, C0, C1;
    LAS unsigned char* lds; unsigned hn, wgu; const float* bgu; unsigned char* actb; int nunits;
    __device__ __forceinline__ bool next(int i, Unit& u) const {
        int gt, n8; if (i >= MO_MAXU || !xcd_deal(i, 3, nunits >> 3, gt, n8)) return false;
        LAS const int* d = (LAS const int*)(lds + MO_DESC) + i * 4;
        const int e = __builtin_amdgcn_readfirstlane(d[0]), nv = __builtin_amdgcn_readfirstlane(d[2]), p0 = __builtin_amdgcn_readfirstlane(d[3]);
        u.A = hn; u.B0 = wgu + (unsigned)(e * 2048 + n8 * 128) * (unsigned)DM; u.B1 = u.B0 + 1024u * DM;
        u.bg = bgu + e * 2048 + n8 * 128; u.act = actb + (size_t)p0 * DFF + n8 * 128; u.nv = nv; u.ul = i; return true;
    }
    __device__ __forceinline__ void offs(const Unit& u, unsigned (&oA)[2][2]) const {
        LAS const unsigned* ix = (LAS const unsigned*)(lds + MO_IDX) + u.ul * 256;
        oA[0][0] = ix[R0] + C0 * 2; oA[0][1] = ix[R1] + C1 * 2; oA[1][0] = ix[128 + R0] + C0 * 2; oA[1][1] = ix[128 + R1] + C1 * 2;
    }
    __device__ __forceinline__ void epi(AccRef acc, const Unit& u, int wr, int wc, int fr, int fq) const { EpiMoe1 e{u.bg, u.bg + 1024, u.act, u.nv}; e(acc, wr, wc, fr, fq); }
};
__device__ __forceinline__ void moe_gemm1_phase(LAS unsigned char* lds, const __amdgpu_buffer_rsrc_t srd, unsigned hn, unsigned wgu, const float* __restrict__ bgu, const int* __restrict__ list, unsigned char* __restrict__ actb) {
    LAS int* tp = (LAS int*)(lds + MO_TP); LAS int* desc = (LAS int*)(lds + MO_DESC); LAS unsigned* ix = (LAS unsigned*)(lds + MO_IDX);
    const int tid = ltid();
    moe_descs(lds, 3);
    { int pr[MO_MAXU / 2];
#pragma unroll
      for (int k = 0; k < MO_MAXU / 2; ++k) { const int ul = 2 * k + (tid >> 8); const int e = desc[ul * 4 + 0], mt = desc[ul * 4 + 1], nv = desc[ul * 4 + 2]; const int row = tid & 255;
          pr[k] = (e >= 0) ? list[(size_t)e * T + mt * 256 + (row < nv ? row : 0)] : 0; }
#pragma unroll
      for (int k = 0; k < MO_MAXU / 2; ++k) { const int ul = 2 * k + (tid >> 8); ix[ul * 256 + (tid & 255)] = (unsigned)(pr[k] >> 2) * (unsigned)DM; } }
    __syncthreads();
    ProvMoe1 P; int R[2], C[2]; stage_coords(tid, R, C); P.R0 = R[0]; P.R1 = R[1]; P.C0 = C[0]; P.C1 = C[1];
    P.nt = DM / 128; P.offB[0] = (unsigned)R[0] * (unsigned)DM + C[0] * 2; P.offB[1] = (unsigned)R[1] * (unsigned)DM + C[1] * 2;
    P.lds = lds; P.hn = hn; P.wgu = wgu; P.bgu = bgu; P.actb = actb; P.nunits = tp[32] * 8;
    gemm_stream_f8(lds, srd, P);
}
struct UnitM2 { unsigned A, B0, B1; const float* bd; int nv, col0, ul; };
struct ProvMoe2 {
    typedef UnitM2 Unit;
    int nt; unsigned offB[2]; unsigned oA0[2][2];
    LAS unsigned char* lds; unsigned actb, wdn; const float* bdn; const int* list; const float* gate; bf16_t* slot; int nunits;
    __device__ __forceinline__ bool next(int i, Unit& u) const {
        int gt, n4; if (i >= 6 || !xcd_deal(i, 2, nunits >> 2, gt, n4)) return false;
        LAS const int* d = (LAS const int*)(lds + MO_DESC) + i * 4;
        const int e = __builtin_amdgcn_readfirstlane(d[0]), mt = __builtin_amdgcn_readfirstlane(d[1]), nv = __builtin_amdgcn_readfirstlane(d[2]), p0 = __builtin_amdgcn_readfirstlane(d[3]);
        u.A = actb + (unsigned)p0 * (unsigned)DFF; u.B0 = wdn + (unsigned)(e * 1024 + n4 * 256) * (unsigned)DFF; u.B1 = u.B0 + 128u * DFF;
        u.bd = bdn + e * DM; u.nv = nv; u.col0 = n4 * 256; u.ul = i; return true;
    }
    __device__ __forceinline__ void offs(const Unit&, unsigned (&oA)[2][2]) const { oA[0][0] = oA0[0][0]; oA[0][1] = oA0[0][1]; oA[1][0] = oA0[1][0]; oA[1][1] = oA0[1][1]; }
    __device__ __forceinline__ void epi(AccRef acc, const Unit& u, int wr, int wc, int fr, int fq) const { EpiMoe2 e{u.bd, (LAS const int*)(lds + MO_IDX) + u.ul * 512, (LAS const float*)(lds + MO_IDX) + u.ul * 512 + 256, slot, u.nv, u.col0}; e(acc, wr, wc, fr, fq); }
};
__device__ __forceinline__ void moe_gemm2_phase(LAS unsigned char* lds, const __amdgpu_buffer_rsrc_t srd, unsigned actb, unsigned wdn, const float* __restrict__ bdn, const int* __restrict__ list,
                                                const float* __restrict__ gate, bf16_t* __restrict__ slot, int layer, bf16_t* pp_out) {
    LAS int* tp = (LAS int*)(lds + MO_TP);
    const int tid = ltid();
    moe_descs(lds, 2);
    { LAS int* desc = (LAS int*)(lds + MO_DESC); LAS int* lp = (LAS int*)(lds + MO_IDX); LAS float* lg = (LAS float*)(lds + MO_IDX);
      int pr[3]; float gv[3];
#pragma unroll
      for (int k = 0; k < 3; ++k) { const int ul = 2 * k + (tid >> 8); const int e = desc[ul * 4 + 0], mt = desc[ul * 4 + 1], nv = desc[ul * 4 + 2]; const int row = tid & 255;
          pr[k] = (e >= 0) ? list[(size_t)e * T + mt * 256 + (row < nv ? row : 0)] : 0; }
#pragma unroll
      for (int k = 0; k < 3; ++k) gv[k] = gate[pr[k]];
#pragma unroll
      for (int k = 0; k < 3; ++k) { const int ul = 2 * k + (tid >> 8); lp[ul * 512 + (tid & 255)] = pr[k]; lg[ul * 512 + 256 + (tid & 255)] = gv[k]; }
      __syncthreads(); }
    ProvMoe2 P; int R[2], C[2]; stage_coords(tid, R, C); unsigned oB[2]; offs_contig(R, C, DFF, DFF, P.oA0, oB); P.offB[0] = oB[0]; P.offB[1] = oB[1];
    P.nt = DFF / 128; P.lds = lds; P.actb = actb; P.wdn = wdn; P.bdn = bdn; P.list = list; P.gate = gate; P.slot = slot; P.nunits = tp[32] * 4;
    gemm_stream_f8(lds, srd, P);
    {
        const int MT = tp[32], c = (int)blockIdx.x; int first, stride;
        if (gridDim.x == 256) { const int maxr = (MT + 63) >> 6, rem = MT - 64 * (maxr - 1), v = 8 * (c & 7) + (c >> 5);
            if (rem >= 64) { first = c; stride = 256; } else { stride = (64 - rem) * 4; first = v >= rem ? (v - rem) * 4 + ((c >> 3) & 3) : -1; } }
        else { first = c; stride = (int)gridDim.x; }
        ProvDense<EpiBf16> Pv; Pv.init(ltid(), WS_PB + (size_t)layer * T * PLE * 2, PLE * 2, WS_WPP + (size_t)layer * 1024 * PLE * 2, PLE, 4, 256, 0, EpiBf16{pp_out, DM, 0, 0}); Pv.deal_first = first; Pv.deal_stride = stride;
        gemm_stream(lds, srd, Pv);
    }
}

constexpr int AT_VB = 128 * 64, AT_KB = 64 * 192, AT_V0 = 0, AT_K0 = 2 * AT_VB, AT_WS = AT_K0 + 2 * AT_KB;
constexpr float AT_SCALE = 0.07216878364870322f;
constexpr float AT_THR = 3.0f, AT_PSH = 4.0f;
__device__ __forceinline__ int kswz(int row, int cb) { return row * 384 + (cb ^ (((row >> 1) & 7) << 4)); }
__device__ __forceinline__ int crow(int r, int hi) { return (r & 3) + 8 * (r >> 2) + 4 * hi; }
__device__ __forceinline__ int v_st(int k, int c) { const int kk = (k & ~0xC) | ((k & 4) << 1) | ((k & 8) >> 1); return ((kk >> 3) * 4 + (c >> 5)) * 512 + ((kk & 7) * 32 + (c & 31)) * 2; }
__device__ __forceinline__ int v_rd_base(int lane) { return ((lane & 3) << 3) | (((lane >> 2) & 3) << 6) | (((lane >> 4) & 1) << 5) | (((lane >> 5) & 1) << 8); }
constexpr int v_rd_off(int d0, int ks, int half) { return d0 * 512 + ks * 4096 + half * 2048; }
template <int OFF> __device__ __forceinline__ s16x4 tr_read(int vb) { s16x4 r; asm volatile("ds_read_b64_tr_b16 %0, %1 offset:%2" : "=&v"(r) : "v"(vb), "i"(OFF) : "memory"); return r; }
#define SBAR() __builtin_amdgcn_sched_barrier(0)

__device__ __forceinline__ void at_partialSM(f32x16& p0, f32x16& p1, float& m_reg, float& mn, float& alpha) {
    constexpr float C = AT_SCALE * 1.4426950408889634f;
    float pmax = p0[0];
#pragma unroll
    for (int r = 1; r < 16; ++r) pmax = fmaxf(pmax, p0[r]);
#pragma unroll
    for (int r = 0; r < 16; ++r) pmax = fmaxf(pmax, p1[r]);
    { auto rr = __builtin_amdgcn_permlane32_swap(__float_as_uint(pmax), __float_as_uint(pmax), false, false); pmax = fmaxf(__uint_as_float(rr[0]), __uint_as_float(rr[1])); }
    if (__builtin_expect(__all(pmax - m_reg <= AT_THR / AT_SCALE), 1)) { mn = m_reg; alpha = 1.f; }
    else { mn = fmaxf(m_reg, pmax); alpha = __builtin_amdgcn_exp2f((m_reg - mn) * C); m_reg = mn; }
    const float mnC = AT_PSH - mn * C;
    const f32x2 C2 = (f32x2){C, C}, M2 = (f32x2){mnC, mnC};
#pragma unroll
    for (int r = 0; r < 16; r += 2) { const f32x2 t = __builtin_elementwise_fma((f32x2){p0[r], p0[r + 1]}, C2, M2); p0[r] = t.x; p0[r + 1] = t.y; }
#pragma unroll
    for (int r = 0; r < 16; r += 2) { const f32x2 t = __builtin_elementwise_fma((f32x2){p1[r], p1[r + 1]}, C2, M2); p1[r] = t.x; p1[r + 1] = t.y; }
#pragma unroll
    for (int r = 0; r < 16; ++r) p0[r] = __builtin_amdgcn_exp2f(p0[r]);
}
__device__ __forceinline__ void at_qkt(f32x16& p0, f32x16& p1, const LAS unsigned char* Ks, const v8i32 (&q8)[3], const int kb0, const int kb1, bool masked) {
    if (masked) {
#pragma unroll
        for (int r = 0; r < 16; ++r) { p0[r] = -1.0e30f; p1[r] = -1.0e30f; }
        return;
    }
#pragma unroll
    for (int r = 0; r < 16; ++r) { p0[r] = 0.f; p1[r] = 0.f; }
#pragma unroll
    for (int d = 0; d < 3; ++d) {
        const u32x4 a0 = *(const LAS u32x4*)(Ks + kb0 + d * 64), a1 = *(const LAS u32x4*)(Ks + kb1 + d * 64);
        const u32x4 c0 = *(const LAS u32x4*)(Ks + kb0 + d * 64 + 32 * 192), c1 = *(const LAS u32x4*)(Ks + kb1 + d * 64 + 32 * 192);
        const v8i32 b0 = (v8i32){(int)a0.x, (int)a0.y, (int)a0.z, (int)a0.w, (int)a1.x, (int)a1.y, (int)a1.z, (int)a1.w};
        const v8i32 b1 = (v8i32){(int)c0.x, (int)c0.y, (int)c0.z, (int)c0.w, (int)c1.x, (int)c1.y, (int)c1.z, (int)c1.w};
        p0 = __builtin_amdgcn_mfma_scale_f32_32x32x64_f8f6f4(b0, q8[d], p0, 0, 0, 0, 0x7f7f7f7f, 0, 0x7f7f7f7f);
        p1 = __builtin_amdgcn_mfma_scale_f32_32x32x64_f8f6f4(b1, q8[d], p1, 0, 0, 0, 0x7f7f7f7f, 0, 0x7f7f7f7f);
        if (d == 0) __builtin_amdgcn_sched_barrier(0); }
}
__device__ __forceinline__ void at_finishSM(f32x16& p0, f32x16& p1, float alpha, float& l_reg, v8i32& pa) {
#pragma unroll
    for (int r = 0; r < 16; ++r) p1[r] = __builtin_amdgcn_exp2f(p1[r]);
    f32x2 s2 = (f32x2){p0[0], p0[1]} + (f32x2){p1[0], p1[1]};
#pragma unroll
    for (int r = 2; r < 16; r += 2) { s2 += (f32x2){p0[r], p0[r + 1]}; s2 += (f32x2){p1[r], p1[r + 1]}; }
    float ps = s2.x + s2.y;
    { auto rr = __builtin_amdgcn_permlane32_swap(__float_as_uint(ps), __float_as_uint(ps), false, false); ps = __uint_as_float(rr[0]) + __uint_as_float(rr[1]); }
    l_reg = l_reg * alpha + ps;
#define PK4U(P, B, I) { int w_ = pa[I]; w_ = __builtin_amdgcn_cvt_pk_fp8_f32(P[B], P[B + 1], w_, false); w_ = __builtin_amdgcn_cvt_pk_fp8_f32(P[B + 2], P[B + 3], w_, true); pa[I] = w_; }
    PK4U(p0, 0, 0) PK4U(p0, 4, 1) PK4U(p0, 8, 2) PK4U(p0, 12, 3) PK4U(p1, 0, 4) PK4U(p1, 4, 5) PK4U(p1, 8, 6) PK4U(p1, 12, 7)
#undef PK4U
}
__device__ __forceinline__ void at_pv(f32x16 (&o)[4], const LAS unsigned char* Vs, const int vb0, const int vb1, const v8i32 pa) {
#pragma unroll
    for (int d0 = 0; d0 < 4; ++d0) {
        const u32x4 a0 = *(const LAS u32x4*)(Vs + vb0 + d0 * 2048), a1 = *(const LAS u32x4*)(Vs + vb1 + d0 * 2048);
        const v8i32 vf = (v8i32){(int)a0.x, (int)a0.y, (int)a0.z, (int)a0.w, (int)a1.x, (int)a1.y, (int)a1.z, (int)a1.w};
        o[d0] = __builtin_amdgcn_mfma_scale_f32_32x32x64_f8f6f4(pa, vf, o[d0], 0, 0, 0, 0x7f7f7f7f, 0, 0x7f7f7f7f); }
}
constexpr int AT_WT = 45056, WC_PITCH = 1040, WC_GU = 32 * 128, WC_ALL = WC_GU + 32 * 64;
static_assert(AT_WT + 64 * WC_PITCH <= MISC_OFF, "attention LDS map");
struct WConv { int i, ph, pend; };
__device__ __forceinline__ void wc_issue(LAS unsigned char* lds, const float* gu1, const float* dn1, const int u, const int wid, const int lane) {
    const bool dn = u >= WC_GU; const int v = dn ? u - WC_GU : u;
    const int mat = dn ? v >> 6 : v >> 7, tn = dn ? (v >> 4) & 3 : (v >> 4) & 7, tk = v & 15, N = dn ? 1024 : 2048;
    const __amdgpu_buffer_rsrc_t sw = __builtin_amdgcn_make_buffer_rsrc((void*)(dn ? dn1 : gu1), (short)0, 0x7ffffff0, 0x00020000);
    const unsigned so = (unsigned)((mat * 1024 + tk * 64 + wid * 8) * N + tn * 256) * 4u;
#pragma unroll
    for (int r = 0; r < 8; ++r) __builtin_amdgcn_raw_ptr_buffer_load_lds(sw, (LAS unsigned*)(lds + AT_WT + (wid * 8 + r) * WC_PITCH), 16, lane * 16, (int)(so + (unsigned)(r * N) * 4u), 0, 0);
}
__device__ __forceinline__ void wc_consume(LAS unsigned char* lds, unsigned char* ws, const int u) {
    int tz = threadIdx.x; asm volatile("" : "+v"(tz));
    const int nl = tz >> 1, kh = (tz & 1) * 32;
    const bool dn = u >= WC_GU; const int v = dn ? u - WC_GU : u;
    const int mat = dn ? v >> 6 : v >> 7, tn = dn ? (v >> 4) & 3 : (v >> 4) & 7, tk = v & 15;
    const size_t d0 = dn ? WS_WDN + ((size_t)(32 + mat) * 1024 + tn * 256) * 1024 + tk * 64 : WS_WGU + ((size_t)(32 + mat) * 2048 + tn * 256) * 1024 + tk * 64;
    LAS const float* tile = (LAS const float*)(lds + AT_WT);
    float w[32];
#pragma unroll
    for (int j = 0; j < 32; ++j) w[j] = tile[(kh + j) * 260 + nl] * 32.0f;
    unsigned char* d = ws + d0 + (size_t)nl * 1024 + kh;
#pragma unroll
    for (int q = 0; q < 2; ++q) { u32x4 o; o.x = pk4_fp8(w[q * 16 + 0], w[q * 16 + 1], w[q * 16 + 2], w[q * 16 + 3]); o.y = pk4_fp8(w[q * 16 + 4], w[q * 16 + 5], w[q * 16 + 6], w[q * 16 + 7]);
        o.z = pk4_fp8(w[q * 16 + 8], w[q * 16 + 9], w[q * 16 + 10], w[q * 16 + 11]); o.w = pk4_fp8(w[q * 16 + 12], w[q * 16 + 13], w[q * 16 + 14], w[q * 16 + 15]); *(u32x4*)(d + q * 16) = o; }
}
__device__ __forceinline__ void attn_unit(LAS unsigned char* lds, const __amdgpu_buffer_rsrc_t srd, const bf16_t* __restrict__ Qb, const float* __restrict__ csb, const float* __restrict__ qhn, const unsigned Koff, const unsigned Voff, bf16_t* __restrict__ Ob, const int qb, WConv& wc, const float* gu1, const float* dn1, unsigned char* ws) {
    const int tid = ltid(), wid = __builtin_amdgcn_readfirstlane(tid >> 6), lane = tid & 63, r32 = lane & 31, hi = lane >> 5;
    LAS unsigned char* V_lds = lds + AT_V0; LAS unsigned char* K_lds = lds + AT_K0;
    LAS float* wsf = (LAS float*)(lds + AT_WS) + wid * 64; LAS float* li_l = wsf; LAS float* al_l = wsf + 32;
    float m_reg = -1e30f, l_reg = 0; f32x16 o[4]; v8i32 q8[3];
    { const bf16_t* Qw = Qb + (size_t)(wid * 32 + r32) * (NH * QKD) + hi * 8;
      u32x4 qraw[12]; unsigned qd[24]; float ss = 0.f;
#pragma unroll
      for (int d0 = 0; d0 < 12; ++d0) qraw[d0] = *(const u32x4*)(Qw + d0 * 16);
      const float* csr = csb + (size_t)(wid * 32 + r32) * 64 + hi * 16;
#pragma unroll
      for (int d0 = 0; d0 < 12; ++d0) { const u32x4 w = qraw[d0];
          ss += bf_lo(w.x) * bf_lo(w.x) + bf_hi(w.x) * bf_hi(w.x) + bf_lo(w.y) * bf_lo(w.y) + bf_hi(w.y) * bf_hi(w.y) + bf_lo(w.z) * bf_lo(w.z) + bf_hi(w.z) * bf_hi(w.z) + bf_lo(w.w) * bf_lo(w.w) + bf_hi(w.w) * bf_hi(w.w); }
      ss += __shfl_xor(ss, 32);
      const float rstd = rsqrtf(ss * (1.0f / QKD) + EPS);
#define Q_UNPACK(dst, src_) { const u32x4 t_ = (src_); dst[0] = bf_lo(t_.x); dst[1] = bf_hi(t_.x); dst[2] = bf_lo(t_.y); dst[3] = bf_hi(t_.y); dst[4] = bf_lo(t_.z); dst[5] = bf_hi(t_.z); dst[6] = bf_lo(t_.w); dst[7] = bf_hi(t_.w); }
#define Q_PACK(d0, v) { qd[2 * (d0)] = pk4_fp8(v[0], v[1], v[2], v[3]); qd[2 * (d0) + 1] = pk4_fp8(v[4], v[5], v[6], v[7]); }
#pragma unroll
      for (int d0 = 0; d0 < 8; ++d0) { float v[8]; Q_UNPACK(v, qraw[d0]) const f32x4 g0 = ld4(qhn + d0 * 16 + hi * 8), g1 = ld4(qhn + d0 * 16 + hi * 8 + 4);
#pragma unroll
          for (int j = 0; j < 4; ++j) { v[j] *= rstd * g0[j]; v[4 + j] *= rstd * g1[j]; }
          Q_PACK(d0, v) if (d0 & 1) asm volatile("" ::: "memory"); }
#pragma unroll
      for (int dd = 0; dd < 2; ++dd) {
          float x1[8], x2[8]; Q_UNPACK(x1, qraw[8 + dd]) Q_UNPACK(x2, qraw[10 + dd])
          const f32x4 ga = ld4(qhn + (8 + dd) * 16 + hi * 8), gb = ld4(qhn + (8 + dd) * 16 + hi * 8 + 4), gc = ld4(qhn + (10 + dd) * 16 + hi * 8), gd = ld4(qhn + (10 + dd) * 16 + hi * 8 + 4);
#pragma unroll
          for (int j = 0; j < 8; ++j) { const float g1_ = j < 4 ? ga[j & 3] : gb[j & 3], g2_ = j < 4 ? gc[j & 3] : gd[j & 3];
              const float a = x1[j] * rstd * g1_, b = x2[j] * rstd * g2_;
              const f32x2 cv = *(const f32x2*)(csr + dd * 32 + j * 2); const float cs = cv.x, sn = cv.y;
              x1[j] = a * cs - b * sn; x2[j] = b * cs + a * sn; }
          Q_PACK(8 + dd, x1) Q_PACK(10 + dd, x2) asm volatile("" ::: "memory"); }
#undef Q_UNPACK
#undef Q_PACK
#pragma unroll
      for (int d = 0; d < 3; ++d) q8[d] = (v8i32){(int)qd[8 * d + 0], (int)qd[8 * d + 1], (int)qd[8 * d + 2], (int)qd[8 * d + 3], (int)qd[8 * d + 4], (int)qd[8 * d + 5], (int)qd[8 * d + 6], (int)qd[8 * d + 7]};
    }
    asm volatile("" ::: "memory");
#pragma unroll
    for (int d = 0; d < 4; ++d)
#pragma unroll
        for (int r = 0; r < 16; ++r) o[d][r] = 0.f;
    const int NT = 4 * qb + 4, vis = 4 * qb + (wid >> 1);
#define SDMA(k0, kbuf, vbuf) do { int lz_ = lane; asm volatile("" : "+v"(lz_)); unsigned kofs[2], vofs[2]; \
    _Pragma("unroll") for (int _i = 0; _i < 2; ++_i) { const int p = (_i * 8 + wid) * 64 + lz_, row = p / 12, ps = p - row * 12; kofs[_i] = (unsigned)(row * 192 + (((ps & ~3) | ((ps & 3) ^ ((row >> 2) & 3))) << 4)); } \
    { const int p = wid * 64 + lz_, dr = p >> 2, ps = p & 3; vofs[0] = (unsigned)(dr * 64 + ((ps ^ ((dr >> 2) & 3)) << 4)); vofs[1] = 0; } \
    __builtin_amdgcn_raw_ptr_buffer_load_lds(srd, (LAS unsigned*)(K_lds + (kbuf) * AT_KB + wid * 1024), 16, (int)kofs[0], (int)(Koff + (unsigned)(k0) * 192u), 0, 0); \
    if (wid < 4) __builtin_amdgcn_raw_ptr_buffer_load_lds(srd, (LAS unsigned*)(K_lds + (kbuf) * AT_KB + (8 + wid) * 1024), 16, (int)kofs[1], (int)(Koff + (unsigned)(k0) * 192u), 0, 0); \
    __builtin_amdgcn_raw_ptr_buffer_load_lds(srd, (LAS unsigned*)(V_lds + (vbuf) * AT_VB + wid * 1024), 16, (int)vofs[0], (int)(Voff + (unsigned)(k0) * 128u), 0, 0); } while (0)
#define RESC(a) do { if (__any((a) < 1.f)) { if (hi == 0) al_l[r32] = (a); asm volatile("s_waitcnt lgkmcnt(0)" ::: "memory"); \
    _Pragma("unroll") for (int d = 0; d < 4; ++d) _Pragma("unroll") for (int r = 0; r < 16; ++r) o[d][r] *= al_l[crow(r, hi)]; } } while (0)
    f32x16 p0, p1; float mn, al; v8i32 pa = (v8i32){0, 0, 0, 0, 0, 0, 0, 0};
    SDMA(0, 0, 0); asm volatile("s_waitcnt vmcnt(0)" ::: "memory"); __syncthreads();
    for (int j = 0; j < NT; ++j) {
        const int cur = j & 1;
        if (wc.ph == 3 && wc.pend >= 0) { wc_consume(lds, ws, wc.pend); wc.pend = -1; }
        if (j + 1 < NT) SDMA((j + 1) * 64, cur ^ 1, cur ^ 1);
        bool wiss = false;
        if (wc.ph == 0) { const int u = (int)blockIdx.x + (int)gridDim.x * wc.i; if (u < WC_ALL) { int lw_ = lane; asm volatile("" : "+v"(lw_)); wc_issue(lds, gu1, dn1, u, wid, lw_); wc.pend = u; ++wc.i; wiss = true; } }
        wc.ph = wc.ph == 4 ? 0 : wc.ph + 1;
        SBAR();
        int lq_ = lane; asm volatile("" : "+v"(lq_));
        const int rq_ = lq_ & 31, hq_ = lq_ >> 5, kx = (rq_ >> 2) & 3, kb0 = rq_ * 192 + (((2 * hq_) ^ kx) << 4), kb1 = rq_ * 192 + (((2 * hq_ + 1) ^ kx) << 4);
        const int vb0 = rq_ * 64 + (((2 * hq_) ^ kx) << 4), vb1 = rq_ * 64 + (((2 * hq_ + 1) ^ kx) << 4);
        if (j <= vis) {
            at_qkt(p0, p1, K_lds + cur * AT_KB, q8, kb0, kb1, false);
            at_partialSM(p0, p1, m_reg, mn, al);
            RESC(al);
            at_finishSM(p0, p1, al, l_reg, pa); SBAR();
            at_pv(o, V_lds + cur * AT_VB, vb0, vb1, pa); }
        if (wiss) asm volatile("s_waitcnt vmcnt(8) lgkmcnt(0)" ::: "memory");
        else asm volatile("s_waitcnt vmcnt(0) lgkmcnt(0)" ::: "memory");
        __builtin_amdgcn_s_barrier();
        asm volatile("" ::: "memory");
    }
    if (hi == 0) li_l[r32] = l_reg; asm volatile("s_waitcnt lgkmcnt(0)" ::: "memory");
    { int tz = threadIdx.x; asm volatile("" : "+v"(tz));
      const int lz = tz & 63, rz = lz & 31, hz = lz >> 5; const unsigned loff = (unsigned)(hz * 4 * DM + rz) * 2u;
      const char* Ow = (const char*)(Ob + (size_t)(wid * 32) * DM);
#pragma unroll
      for (int r = 0; r < 16; ++r) { const int rb = (r & 3) + 8 * (r >> 2); const float rl = __builtin_amdgcn_rcpf(li_l[rb + 4 * hz]);
          const char* Or = Ow + (size_t)rb * DM * 2;
#pragma unroll
          for (int d0 = 0; d0 < 4; ++d0) { const unsigned w = cvt_pk_bf16(o[d0][r] * rl, 0.f); *(bf16_t*)(Or + loff + d0 * 64) = (bf16_t)(w & 0xffffu); } } }
    __syncthreads();
#undef SDMA
#undef RESC
}
__device__ __forceinline__ void attn_phase(LAS unsigned char* lds, const __amdgpu_buffer_rsrc_t srd, const bf16_t* __restrict__ qf, const float* __restrict__ cs, const float* __restrict__ qhn, bf16_t* __restrict__ O,
                                           const float* gu1, const float* dn1, unsigned char* ws) {
    WConv wc; wc.i = 0; wc.ph = (int)(blockIdx.x % 5u); wc.pend = -1;
    for (int u = blockIdx.x; u < 256; u += gridDim.x) {
        const int bh = 2 * (u & 7) + ((u >> 3) >> 4), pi = (u >> 3) & 15, b = bh >> 3, h = bh & 7;
        const unsigned Koff = (unsigned)(WS_K + (size_t)bh * SEQ * QKD), Voff = (unsigned)(WS_V + (size_t)bh * SEQ * VD);
#pragma unroll 1
        for (int half = 0; half < 2; ++half) {
            const int qb = half == 0 ? 31 - pi : pi; const size_t row0 = (size_t)b * SEQ + qb * 256;
            attn_unit(lds, srd, qf + row0 * (NH * QKD) + h * QKD, cs + row0 * 64, qhn, Koff, Voff, O + row0 * DM + h * VD, qb, wc, gu1, dn1, ws);
        }
    }
    asm volatile("s_waitcnt vmcnt(0)" ::: "memory"); __syncthreads();
    if (wc.pend >= 0) { wc_consume(lds, ws, wc.pend); wc.pend = -1; }
    for (;;) { const int u = (int)blockIdx.x + (int)gridDim.x * wc.i; if (u >= WC_ALL) break;
        __syncthreads();
        { const int tz = ltid(); wc_issue(lds, gu1, dn1, u, __builtin_amdgcn_readfirstlane(tz >> 6), tz & 63); }
        asm volatile("s_waitcnt vmcnt(0)" ::: "memory"); __syncthreads();
        wc_consume(lds, ws, u); ++wc.i; }
}

#ifndef PH_MASK
#define PH_MASK 0x7FFFF
#endif
typedef const __attribute__((address_space(4))) Params* ParamsK;
__device__ __forceinline__ ParamsK phase_params() { ParamsK q = (ParamsK)__builtin_amdgcn_kernarg_segment_ptr(); asm volatile("" : "+s"(q)); return q; }
#define PIN(i) (pq_->in[i])
#define WSP(T_, OFF) ((T_*)(pq_->ws + (OFF)))
#define WGU WSP(bf16_t, WS_WGU)
#define WDN WSP(bf16_t, WS_WDN)
#define WPG WSP(bf16_t, WS_WPG)
#define WPP WSP(bf16_t, WS_WPP)
#define WPOOL WSP(bf16_t, WS_WPOOL)
#define WIN WSP(bf16_t, WS_WIN)
#define WQB WSP(bf16_t, WS_WQB)
#define WKVB WSP(bf16_t, WS_WKVB)
#define WO WSP(bf16_t, WS_WO)
#define PB WSP(bf16_t, WS_PB)
#define PP WSP(bf16_t, WS_PP)
#define AB WSP(bf16_t, WS_AB)
#define X1 WSP(float, WS_X1)
#define X2 WSP(bf16_t, WS_X2)
#define X3 WSP(float, WS_X3)
#define HN WSP(bf16_t, WS_HN)
#define ACT WSP(bf16_t, WS_ACT)
#define SLOT WSP(bf16_t, WS_SLOT)
#define LIST WSP(int, WS_LIST)
#define GATE WSP(float, WS_GATE)
#define LAT WSP(float, WS_LAT)
#define QN WSP(bf16_t, WS_QN)
#define KVN WSP(bf16_t, WS_KVN)
#define QF WSP(bf16_t, WS_QF)
#define KVF WSP(bf16_t, WS_KVF)
#define QB WSP(bf16_t, WS_Q)
#define KB WSP(bf16_t, WS_K)
#define VB WSP(bf16_t, WS_V)
#define CTLW WSP(unsigned, WS_CTL)

__global__ void __launch_bounds__(NTHREADS, 2) mk_fwd(Params P) {
    extern __shared__ __attribute__((aligned(16))) unsigned char lds_raw[];
    LAS unsigned char* lds = (LAS unsigned char*)lds_raw;
    const int tid = threadIdx.x;
    const int lo = P.ph_lo, hi = P.ph_hi;
    const bool multi = (hi - lo) > 1;
    if (tid == 0) { *(volatile LAS unsigned*)(lds + BARW_OFF) = 0u; *(volatile LAS unsigned*)(lds + BARW_OFF + 4) = 0u; }
    __syncthreads();
    XcdBarrier bar; bar.bar = (unsigned*)(P.ws + WS_CTL); bar.x = 0; bar.st = (volatile LAS unsigned*)(lds + BARW_OFF);
    if (multi) bar = xcd_barrier_post((unsigned*)(P.ws + WS_CTL), (volatile LAS unsigned*)(lds + BARW_OFF));
#define IN(k) ((((PH_MASK) >> (k)) & 1) && lo <= (k) && (k) < hi)
#define SEAM(k) do { if (IN(k) && IN((k) + 1)) xcd_barrier(bar); } while (0)
#define SRD_WS __builtin_amdgcn_make_buffer_rsrc((void*)pq_->ws, (short)0, 0x7ffffff0, 0x00020000)
#define PHASE(k, ...) if (IN(k)) { ParamsK pq_ = phase_params(); __VA_ARGS__ }

    PHASE(0,
        int rot = 0;
        transpose_seg_f8<2048, 1024>(lds, PIN(I_W_GU), WSP(unsigned char, WS_WGU), 32, rot);
        transpose_seg_f8<1024, 1024>(lds, PIN(I_W_DN), WSP(unsigned char, WS_WDN), 32, rot);
        transpose_seg_f8<1024, 1024>(lds, PIN(I_PLE_GATE_W), WSP(unsigned char, WS_WPG), 1, rot, PIN(I_PLE_NORM));
        transpose_seg_f8<1024, 1024>(lds, PIN(I_PLE_GATE_W) + (size_t)1024 * 1024, WSP(unsigned char, WS_WPG) + (size_t)1024 * 1024, 1, rot, PIN(I_PLE_NORM) + DM);
        transpose_seg<1024, 256>(lds, PIN(I_PLE_PROJ_W), WPP, 2, rot);
        transpose_seg<256, 256>(lds, PIN(I_POOL_W), WPOOL, 4, rot);
        transpose_seg<704, 1024>(lds, PIN(I_W_IN), WIN, 1, rot, PIN(I_NORM_MIX) + DM);
        transpose_seg<1536, 384>(lds, PIN(I_W_QB), WQB, 1, rot, PIN(I_Q_NORM));
        transpose_seg<2048, 256>(lds, PIN(I_W_KVB), WKVB, 1, rot, PIN(I_KV_NORM));
        transpose_seg<1024, 1024>(lds, PIN(I_W_O), WO, 1, rot);
        cvt_p_phase(PIN(I_P), PB);
        rope_table_phase((const int*)PIN(I_POS), WSP(float, WS_CS));
        wrg_phase(PIN(I_NORM_FFN), PIN(I_ROUTER_W), WSP(float, WS_WRG));
        pool_diff_phase(lds, PIN(I_X), PIN(I_NORM_MIX), AB);)
    SEAM(0);
    PHASE(1,
        { ProvDense<EpiPool> Pv; Pv.init(ltid(), WS_AB, DM * 2, WS_WPOOL, 256, 4, 256, 512, EpiPool{PIN(I_X), PIN(I_POOL_SCALE), X1, 0, 0}); gemm_stream(lds, SRD_WS, Pv); }
        )
    SEAM(1);
#define ROUTE_CALL(L, XIN) route_phase<(L) == 1>(lds, XIN, PIN(I_NORM_FFN) + (L) * DM, WSP(float, WS_WRG) + (size_t)(L) * DM * NE, PIN(I_ROUTER_B) + (L) * NE, HN, CTLW + CW_GCNT + (L) * 32 * 64, LIST, GATE)
#define MOE_PLE_LAYER(L, PH, XIN, XOUT) \
    if (IN(PH)) { ParamsK pq_ = phase_params(); ROUTE_CALL(L, XIN); } \
    SEAM(PH); \
    PHASE((PH) + 1, moe_setup(lds, CTLW + CW_GCNT + (L) * 32 * 64); \
        moe_gemm1_phase(lds, SRD_WS, (unsigned)WS_HN, (unsigned)(WS_WGU + (size_t)(L) * 32 * 2048 * DM), PIN(I_B_GU) + (size_t)(L) * 32 * 2048, LIST, WSP(unsigned char, WS_ACT));) \
    SEAM((PH) + 1); \
    PHASE((PH) + 2, moe_setup(lds, CTLW + CW_GCNT + (L) * 32 * 64); \
        moe_gemm2_phase(lds, SRD_WS, (unsigned)WS_ACT, (unsigned)(WS_WDN + (size_t)(L) * 32 * 1024 * DFF), PIN(I_B_DN) + (size_t)(L) * 32 * DM, LIST, GATE, SLOT, (L), PP + (size_t)(L) * T * DM);) \
    SEAM((PH) + 2); \
    PHASE((PH) + 3, combine_phase<(L) == 1>(XIN, SLOT, X2, WSP(unsigned char, WS_AB), WSP(float, WS_QN));) \
    SEAM((PH) + 3); \
    PHASE((PH) + 4, ProvDense<EpiPle<(L) == 0> > Pv; Pv.init(ltid(), WS_AB, DM, WS_WPG + (size_t)(L) * 1024 * DM, DM / 2  , 4, 256, 0, EpiPle<(L) == 0>{X2, WSP(float, WS_QN), PP + (size_t)(L) * T * DM, XOUT, HN, WSP(float, WS_STAT), 0, 0}); gemm_stream_f8(lds, SRD_WS, Pv);)

    MOE_PLE_LAYER(0, 2, X1, X3)
    SEAM(6);
    PHASE(8, ProvDense<EpiLat> Pv; Pv.init(ltid(), WS_HN, DM * 2, WS_WIN, DM, 3, 192, 0, EpiLat{WSP(float, WS_STAT), WSP(bf16_t, WS_LAT), WSP(float, WS_STAT) + (size_t)T * 16, WSP(float, WS_STAT) + (size_t)T * 32, 0, 0}); gemm_stream(lds, SRD_WS, Pv);)
    SEAM(8);
    PHASE(10,
        { ProvDense<EpiBf16S> Pv; Pv.init(ltid(), WS_LAT, LATP * 2, WS_WQB, QL, 6, 384, 0, EpiBf16S{QF, NH * QKD, WSP(float, WS_STAT) + (size_t)T * 16, 3, 1.0f / QL, 0, 0}); gemm_stream(lds, SRD_WS, Pv); }
        { ProvDense<EpiKV> Pv; Pv.init(ltid(), WS_LAT + QL * 2, LATP * 2, WS_WKVB, KVL, 8, 512, 0, EpiKV{KVF, WSP(float, WS_STAT) + (size_t)T * 32, pq_->ws + WS_V, 0, 0}); gemm_stream(lds, SRD_WS, Pv); })
    SEAM(10);
    PHASE(11, k_finalize_phase(KVF, WSP(bf16_t, WS_LAT), WSP(float, WS_CS), PIN(I_KH_NORM), KB);)
    SEAM(11);
    PHASE(12, attn_phase(lds, SRD_WS, QF, WSP(float, WS_CS), PIN(I_QH_NORM), AB, PIN(I_W_GU) + (size_t)32 * 1024 * 2048, PIN(I_W_DN) + (size_t)32 * 1024 * 1024, pq_->ws);)
    SEAM(12);
    PHASE(13, ProvDense<EpiRes> Pv; Pv.init(ltid(), WS_AB, DM * 2, WS_WO, DM, 4, 256, 0, EpiRes{HN, (bf16_t*)X1, 0, 0}); gemm_stream(lds, SRD_WS, Pv);)
    SEAM(13);
    MOE_PLE_LAYER(1, 14, X1, pq_->out)
#undef IN
#undef SEAM
}

extern "C" void kernel_launch(void* const* d_in, const int* in_sizes, int n_in, void* d_out, int out_size, void* d_ws, size_t ws_size, hipStream_t stream) {
    static int grid = 0;
    if (grid == 0) {
        if (n_in != N_IN || out_size != T * DM || ws_size < WS_END) { fprintf(stderr, "kernel_launch: shape/workspace mismatch (n_in %d out %d ws %zu need %zu)\n", n_in, out_size, ws_size, (size_t)WS_END); grid = -1; return; }
        int dev = 0, cus = 0, per_cu = 0;
        if (hipGetDevice(&dev) != hipSuccess || hipDeviceGetAttribute(&cus, hipDeviceAttributeMultiprocessorCount, dev) != hipSuccess) { grid = -1; return; }
        if (hipFuncSetAttribute((const void*)mk_fwd, hipFuncAttributeMaxDynamicSharedMemorySize, LDS_BYTES) != hipSuccess) { fprintf(stderr, "kernel_launch: hipFuncSetAttribute failed\n"); grid = -1; return; }
        if (hipOccupancyMaxActiveBlocksPerMultiprocessor(&per_cu, (const void*)mk_fwd, NTHREADS, LDS_BYTES) != hipSuccess || per_cu < 1) { fprintf(stderr, "kernel_launch: occupancy query says %d\n", per_cu); (void)hipGetLastError(); grid = -1; return; }
        grid = cus;
    }
    if (grid < 0) return;
    (void)in_sizes;
    hipMemsetAsync((char*)d_ws + WS_CTL, 0, CTL_BYTES, stream);
    Params p{};
    for (int i = 0; i < N_IN; ++i) p.in[i] = (const float*)d_in[i];
    p.out = (float*)d_out; p.ws = (unsigned char*)d_ws;
#if MK_MULTI
    for (int ph = 0; ph < NPHASE; ++ph) { p.ph_lo = ph; p.ph_hi = ph + 1; hipLaunchKernelGGL(mk_fwd, dim3(grid), dim3(NTHREADS), LDS_BYTES, stream, p); }
#else
    p.ph_lo = 0; p.ph_hi = NPHASE; hipLaunchKernelGGL(mk_fwd, dim3(grid), dim3(NTHREADS), LDS_BYTES, stream, p);
#endif
}
```

```cpp
#include <hip/hip_runtime.h>
#include <cstdio>
#include <cstdint>

#ifndef MK_MULTI
#define MK_MULTI 0
#endif

#define LAS __attribute__((address_space(3)))
typedef unsigned short bf16_t;
typedef short bf16x8 __attribute__((ext_vector_type(8)));
typedef short s16x4 __attribute__((ext_vector_type(4)));
typedef float f32x2 __attribute__((ext_vector_type(2)));
typedef float f32x4 __attribute__((ext_vector_type(4)));
typedef float f32x16 __attribute__((ext_vector_type(16)));
typedef unsigned u32x2 __attribute__((ext_vector_type(2)));
typedef unsigned u32x4 __attribute__((ext_vector_type(4)));

constexpr int T = 16384, DM = 1024, SEQ = 8192, NE = 32, DFF = 1024, PLE = 256;
constexpr int NPAIR = T * 4;
constexpr int QL = 384, KVL = 256, NH = 8, QKD = 192, VD = 128, LATP = 768;
constexpr float EPS = 1e-6f;
constexpr int NTHREADS = 512;
constexpr int LDS_BYTES = 147456;
constexpr int MISC_OFF = 131072;
constexpr int BARW_OFF = LDS_BYTES - 16;
constexpr int NPHASE = 19;

enum { I_X = 0, I_P, I_POS, I_NORM_MIX, I_POOL_W, I_POOL_SCALE, I_W_IN, I_Q_NORM, I_W_QB, I_KV_NORM, I_W_KVB, I_QH_NORM, I_KH_NORM, I_W_O,
       I_NORM_FFN, I_ROUTER_W, I_ROUTER_B, I_W_GU, I_B_GU, I_W_DN, I_B_DN, I_PLE_NORM, I_PLE_GATE_W, I_PLE_PROJ_W, N_IN };

constexpr size_t al256(size_t x) { return (x + 255) & ~(size_t)255; }
constexpr size_t CTL_BYTES = 65536;
constexpr size_t WS_CTL  = 0;
constexpr size_t WS_WGU  = WS_CTL + CTL_BYTES;
constexpr size_t WS_WDN  = WS_WGU + (size_t)2 * 32 * 2048 * 1024 * 2;
constexpr size_t WS_WPG  = WS_WDN + (size_t)2 * 32 * 1024 * 1024 * 2;
constexpr size_t WS_WPP  = WS_WPG + (size_t)2 * 1024 * 1024 * 2;
constexpr size_t WS_WPOOL= WS_WPP + (size_t)2 * 1024 * 256 * 2;
constexpr size_t WS_WIN  = WS_WPOOL + (size_t)4 * 256 * 256 * 2;
constexpr size_t WS_WQB  = WS_WIN + (size_t)768 * 1024 * 2;
constexpr size_t WS_WKVB = WS_WQB + (size_t)1536 * 384 * 2;
constexpr size_t WS_WO   = WS_WKVB + (size_t)2048 * 256 * 2;
constexpr size_t WS_PB   = WS_WO + (size_t)1024 * 1024 * 2;
constexpr size_t WS_PP   = WS_PB + (size_t)2 * T * 256 * 2;
constexpr size_t WS_AB   = WS_PP + (size_t)2 * T * 1024 * 2;
constexpr size_t WS_X1   = WS_AB + (size_t)T * 1024 * 2;
constexpr size_t WS_X2   = WS_X1 + (size_t)T * 1024 * 4;
constexpr size_t WS_X3   = WS_X2 + (size_t)T * 1024 * 4;
constexpr size_t WS_HN   = WS_X3 + (size_t)T * 1024 * 4;
constexpr size_t WS_ACT  = WS_HN + (size_t)T * 1024 * 2;
constexpr size_t WS_SLOT = WS_ACT + (size_t)(NPAIR + 256) * 1024 * 2;
constexpr size_t WS_LIST = WS_SLOT + (size_t)NPAIR * 1024 * 2;
constexpr size_t WS_GATE = WS_LIST + (size_t)32 * T * 4;
constexpr size_t WS_LAT  = WS_GATE + (size_t)NPAIR * 4;
constexpr size_t WS_QN   = WS_LAT + (size_t)T * 768 * 4;
constexpr size_t WS_KVN  = WS_QN + (size_t)T * 384 * 2;
constexpr size_t WS_QF   = WS_KVN + (size_t)T * 256 * 2;
constexpr size_t WS_KVF  = WS_QF + (size_t)T * 1536 * 2;
constexpr size_t WS_Q    = WS_KVF + (size_t)T * 2048 * 2;
constexpr size_t WS_K    = WS_Q + (size_t)T * 8 * 192 * 2;
constexpr size_t WS_V    = WS_K + (size_t)T * 8 * 192 * 2;
constexpr size_t WS_WRG  = WS_V + (size_t)T * 8 * 128 * 2;
constexpr size_t WS_STAT = WS_WRG + (size_t)2 * 1024 * 32 * 4;
constexpr size_t WS_CS   = WS_STAT + (size_t)3 * T * 16 * 4;
constexpr size_t WS_END  = WS_CS + (size_t)T * 32 * 2 * 4;
constexpr int CW_GCNT = 4096;

struct Params { const float* in[N_IN]; float* out; unsigned char* ws; int ph_lo, ph_hi; };

__device__ __forceinline__ unsigned cvt_pk_bf16(float lo, float hi) { unsigned r; asm volatile("v_cvt_pk_bf16_f32 %0, %1, %2" : "=v"(r) : "v"(lo), "v"(hi)); return r; }
__device__ __forceinline__ float bf_lo(unsigned w) { return __uint_as_float(w << 16); }
__device__ __forceinline__ float bf_hi(unsigned w) { return __uint_as_float(w & 0xffff0000u); }
__device__ __forceinline__ float wave_sum(float v) {
#pragma unroll
    for (int o = 32; o > 0; o >>= 1) v += __shfl_xor(v, o);
    return v;
}
__device__ __forceinline__ int ltid() { int t = threadIdx.x; asm volatile("" : "+v"(t)); return t; }
__device__ __forceinline__ f32x4 ld4(const float* p) { return *(const f32x4*)p; }
__device__ __forceinline__ f32x4 ld4bf(const bf16_t* p) { const u32x2 w = *(const u32x2*)p; return (f32x4){bf_lo(w.x), bf_hi(w.x), bf_lo(w.y), bf_hi(w.y)}; }
__device__ __forceinline__ void st4bf(bf16_t* p, f32x4 v) { u32x2 w; w.x = cvt_pk_bf16(v[0], v[1]); w.y = cvt_pk_bf16(v[2], v[3]); *(u32x2*)p = w; }
__device__ __forceinline__ f32x4 dpp_ror8(const f32x4 v) { f32x4 r;
#pragma unroll
    for (int j = 0; j < 4; ++j) r[j] = __uint_as_float((unsigned)__builtin_amdgcn_update_dpp(0, (int)__float_as_uint(v[j]), 0x128, 0xf, 0xf, false));
    return r; }
__device__ __forceinline__ f32x4 sel4(const bool c, const f32x4 a, const f32x4 b) { f32x4 r;
#pragma unroll
    for (int j = 0; j < 4; ++j) r[j] = c ? a[j] : b[j];
    return r; }
__device__ __forceinline__ void ld_rows8_f32(const float* blk16, const size_t ld, const int fr, const int fq, f32x4& x0, f32x4& x1) {
    const bool hi8 = fr >= 8; const float* p = blk16 + (size_t)(fr & 7) * ld + (hi8 ? 16 : 0) + fq * 4;
    const f32x4 L1 = ld4(p), L2 = ld4(p + 8 * ld);
    const f32x4 rv = dpp_ror8(sel4(hi8, L1, L2));
    x0 = sel4(hi8, rv, L1); x1 = sel4(hi8, L2, rv);
}
__device__ __forceinline__ void st_rows8_f32(float* blk16, const size_t ld, const int fr, const int fq, const f32x4 v0, const f32x4 v1) {
    const bool hi8 = fr >= 8; float* p = blk16 + (size_t)(fr & 7) * ld + (hi8 ? 16 : 0) + fq * 4;
    const f32x4 rv = dpp_ror8(sel4(hi8, v0, v1));
    *(f32x4*)p = sel4(hi8, rv, v0); *(f32x4*)(p + 8 * ld) = sel4(hi8, v1, rv);
}
__device__ __forceinline__ void ld_pair_bf16(const bf16_t* blk, const int fq, u32x2& w0, u32x2& w1) {
    const u32x4 w = *(const u32x4*)(blk + (fq & 1) * 16 + (fq >> 1) * 8);
    const auto sx = __builtin_amdgcn_permlane16_swap(w.x, w.z, false, false); const auto sy = __builtin_amdgcn_permlane16_swap(w.y, w.w, false, false);
    w0.x = sx[0]; w0.y = sy[0]; w1.x = sx[1]; w1.y = sy[1];
}
__device__ __forceinline__ void st_pair_bf16(bf16_t* blk, const f32x4 v0, const f32x4 v1, const int fq) {
    const auto sx = __builtin_amdgcn_permlane16_swap(cvt_pk_bf16(v0[0], v0[1]), cvt_pk_bf16(v1[0], v1[1]), false, false);
    const auto sy = __builtin_amdgcn_permlane16_swap(cvt_pk_bf16(v0[2], v0[3]), cvt_pk_bf16(v1[2], v1[3]), false, false);
    u32x4 w; w.x = sx[0]; w.y = sy[0]; w.z = sx[1]; w.w = sy[1];
    *(u32x4*)(blk + (fq & 1) * 16 + (fq >> 1) * 8) = w;
}
__device__ __forceinline__ unsigned pk4_fp8(float a, float b, float c, float d) { int w = __builtin_amdgcn_cvt_pk_fp8_f32(a, b, 0, false); w = __builtin_amdgcn_cvt_pk_fp8_f32(c, d, w, true); return (unsigned)w; }
__device__ __forceinline__ float sigmoidf_(float z) { return __builtin_amdgcn_rcpf(1.0f + __builtin_amdgcn_exp2f(-1.4426950408889634f * z)); }

#define XB_TMO      128
#define XB_XCNT(j)  (256  + 64 * (j))
#define XB_XSUB(j)  (1280 + 64 * (j))
#define XB_XGEN(j)  (2304 + 64 * (j))
#define XB_TOP      3328
#define XB_TOPGEN   3392
#define XCD_BAR_WORDS 3456
#define XB_SPIN_CAP (1u << 24)
__device__ __forceinline__ unsigned xb_ld(unsigned* p)              { return __hip_atomic_load(p, __ATOMIC_RELAXED, __HIP_MEMORY_SCOPE_AGENT); }
__device__ __forceinline__ unsigned xb_add(unsigned* p, unsigned v) { return __hip_atomic_fetch_add(p, v, __ATOMIC_RELAXED, __HIP_MEMORY_SCOPE_AGENT); }
__device__ __forceinline__ unsigned xb_xcc_id() { return (unsigned)__builtin_amdgcn_s_getreg((3 << 11) | 20) & 0xFu; }
#define XB_SPIN(cond, bar) do { unsigned _sp = 0; while (cond) { __builtin_amdgcn_s_sleep(1); \
    if ((++_sp & 255u) == 0u) { if (xb_ld(&(bar)[XB_TMO])) break; if (_sp > XB_SPIN_CAP) { atomicAdd(&(bar)[XB_TMO], 1u); break; } } } } while (0)
struct XcdBarrier { unsigned* bar; unsigned x; volatile LAS unsigned* st; };
__device__ __forceinline__ XcdBarrier xcd_barrier_post(unsigned* bar, volatile LAS unsigned* st) {
    XcdBarrier b; b.bar = bar; b.x = xb_xcc_id(); b.st = st;
    if (threadIdx.x == 0) (void)xb_add(&bar[XB_XCNT(b.x)], 1u);
    return b;
}
__device__ __forceinline__ void xcd_barrier_complete(unsigned* bar, unsigned x, unsigned& nloc, unsigned& nx) {
    const unsigned G = gridDim.x * gridDim.y * gridDim.z;
    unsigned sum, cnt, mine, sp = 0u;
    for (;;) {
        sum = 0u; cnt = 0u; mine = 0u;
#pragma unroll
        for (unsigned j = 0; j < 16; ++j) { const unsigned c = xb_ld(&bar[XB_XCNT(j)]); sum += c; cnt += (c > 0u) ? 1u : 0u; mine = (j == x) ? c : mine; }
        if (sum == G) break;
        __builtin_amdgcn_s_sleep(1);
        if ((++sp & 255u) == 0u) { if (xb_ld(&bar[XB_TMO])) break; if (sp > XB_SPIN_CAP) { atomicAdd(&bar[XB_TMO], 1u); break; } }
    }
    nloc = mine > 0u ? mine : 1u; nx = cnt > 0u ? cnt : 1u;
}
__device__ __forceinline__ void xcd_barrier(const XcdBarrier& b) {
    asm volatile("s_waitcnt vmcnt(0)" ::: "memory");
    __syncthreads();
    if (threadIdx.x == 0) {
        unsigned* bar = b.bar;
        __builtin_amdgcn_s_waitcnt(0);
        unsigned nloc = b.st[0], nx = b.st[1];
        if (nloc == 0u) { xcd_barrier_complete(bar, b.x, nloc, nx); b.st[0] = nloc; b.st[1] = nx; }
        const unsigned old = xb_add(&bar[XB_XSUB(b.x)], 1u);
        const unsigned gen = old / nloc;
        if (old + 1u == (gen + 1u) * nloc) {
            __builtin_amdgcn_fence(__ATOMIC_RELEASE, "agent");
            asm volatile("s_waitcnt vmcnt(0)" ::: "memory");
            const unsigned og = xb_add(&bar[XB_TOP], 1u);
            const unsigned tg = og / nx;
            if (og + 1u == (tg + 1u) * nx) xb_add(&bar[XB_TOPGEN], 1u);
            else XB_SPIN(xb_ld(&bar[XB_TOPGEN]) == tg, bar);
            __builtin_amdgcn_fence(__ATOMIC_ACQUIRE, "agent");
            xb_add(&bar[XB_XGEN(b.x)], 1u);
            asm volatile("s_waitcnt vmcnt(0)" ::: "memory");
        } else {
            XB_SPIN(xb_ld(&bar[XB_XGEN(b.x)]) == gen, bar);
            __builtin_amdgcn_fence(__ATOMIC_ACQUIRE, "agent");
            asm volatile("s_waitcnt vmcnt(0)" ::: "memory");
        }
    }
    __syncthreads();
}

constexpr int HTB = 16384;
__device__ __forceinline__ int lds_byte(int r, int c) { const int st = (r >> 4) * 2 + (c >> 5), rr = r & 15, cc = c & 31, ob = rr * 64 + cc * 2; return st * 1024 + (ob ^ (((ob >> 9) & 1) << 5)); }
__device__ __forceinline__ void stage_rc(int b, int& R, int& C) { const int st = b / 1024, sb = b % 1024, swz = sb ^ (((sb >> 9) & 1) << 5); R = (st >> 1) * 16 + swz / 64; C = (st & 1) * 32 + (swz % 64) / 2; }
#define SA_(b, h) (((b) * 2 + (h)) * HTB)
#define SB_(b, h) ((4 + (b) * 2 + (h)) * HTB)
#define G_STAGE(bufoff, sbase, voff) do { _Pragma("unroll") for (int _i = 0; _i < 2; ++_i) \
    __builtin_amdgcn_raw_ptr_buffer_load_lds(srd, (LAS unsigned*)(lds + (bufoff) + ldsw + _i * 8192), 16, (int)(voff)[_i], (int)(sbase), 0, 0); } while (0)
#define G_LDA(dst, b, h) do { _Pragma("unroll") for (int m = 0; m < 4; ++m) _Pragma("unroll") for (int k = 0; k < 2; ++k) dst[m][k] = *(const LAS bf16x8*)(lds + SA_(b, h) + aoff + m * 2048 + k * 1024); } while (0)
#define G_LDB(dst, b, h) do { _Pragma("unroll") for (int n = 0; n < 2; ++n) _Pragma("unroll") for (int k = 0; k < 2; ++k) dst[n][k] = *(const LAS bf16x8*)(lds + SB_(b, h) + boff + n * 2048 + k * 1024); } while (0)
#define G_MMA(ai, bj, At, Bt) do { __builtin_amdgcn_s_setprio(1); _Pragma("unroll") for (int m = 0; m < 4; ++m) _Pragma("unroll") for (int n = 0; n < 2; ++n) _Pragma("unroll") for (int k = 0; k < 2; ++k) \
    acc[ai][bj][m][n] = __builtin_amdgcn_mfma_f32_16x16x32_bf16(Bt[n][k], At[m][k], acc[ai][bj][m][n], 0, 0, 0); __builtin_amdgcn_s_setprio(0); } while (0)
#define WAIT_V(n) asm volatile("s_waitcnt vmcnt(" #n ")" ::: "memory")
#define WAIT_L(n) asm volatile("s_waitcnt lgkmcnt(" #n ")" ::: "memory")
#define BAR __builtin_amdgcn_s_barrier()
#define SCHED __builtin_amdgcn_sched_barrier(0)

__device__ __forceinline__ void stage_coords(int tid, int (&R)[2], int (&C)[2]) { stage_rc(tid * 16, R[0], C[0]); stage_rc(tid * 16 + 8192, R[1], C[1]); }

template <class Prov>
__device__ __forceinline__ void gemm_stream(LAS unsigned char* lds, const __amdgpu_buffer_rsrc_t srd, const Prov& P) {
    const int tid = ltid(), wid = __builtin_amdgcn_readfirstlane(tid >> 6), lane = tid & 63, wr = wid >> 2, wc = wid & 3, fr = lane & 15, fq = lane >> 4;
    const unsigned ldsw = (unsigned)wid * 1024u;
    const int aoff = lds_byte(wr * 64 + fr, fq * 8), boff = lds_byte(wc * 32 + fr, fq * 8);
    typename Prov::Unit cur, nxt;
    if (!P.next(0, cur)) return;
    unsigned oA[2][2]; P.offs(cur, oA);
    const unsigned oB[2] = {P.offB[0], P.offB[1]};
    const int nt = P.nt;
    f32x4 acc[2][2][4][2];
#pragma unroll
    for (int a = 0; a < 2; ++a)
#pragma unroll
        for (int b = 0; b < 2; ++b)
#pragma unroll
            for (int m = 0; m < 4; ++m)
#pragma unroll
                for (int n = 0; n < 2; ++n) acc[a][b][m][n] = (f32x4){0.f, 0.f, 0.f, 0.f};
    bf16x8 At[4][2], B0[2][2], B1[2][2];
    unsigned cA = cur.A, cB0 = cur.B0, cB1 = cur.B1;
    G_STAGE(SB_(0, 0), cB0, oB); G_STAGE(SA_(0, 0), cA, oA[0]); G_STAGE(SB_(0, 1), cB1, oB); G_STAGE(SA_(0, 1), cA, oA[1]);
    if (wr == 1) BAR;
    WAIT_V(4); BAR;
    G_STAGE(SB_(1, 0), cB0 + 128, oB); G_STAGE(SA_(1, 0), cA + 128, oA[0]); G_STAGE(SB_(1, 1), cB1 + 128, oB);
    WAIT_V(6); BAR;
    int ui = 0;
    for (;;) {
        const bool has_next = P.next(ui + 1, nxt);
        const unsigned nA = has_next ? nxt.A : cA, nB0 = has_next ? nxt.B0 : cB0, nB1 = has_next ? nxt.B1 : cB1;
        for (int t = 0; t < nt; t += 2) {
            const bool last = (t == nt - 2);
            const unsigned a1 = cA + (t + 1) * 128;
            G_LDB(B0, 0, 0); SCHED; G_LDA(At, 0, 0); G_STAGE(SA_(1, 1), a1, oA[1]);
            WAIT_L(8); BAR; WAIT_L(0); G_MMA(0, 0, At, B0); BAR; SCHED;
            if (last && has_next) P.offs(nxt, oA);
            const unsigned a2 = last ? nA : cA + (t + 2) * 128, p0 = last ? nB0 : cB0 + (t + 2) * 128, p1 = last ? nB1 : cB1 + (t + 2) * 128;
            G_LDB(B1, 0, 1); G_STAGE(SB_(0, 0), p0, oB);
            BAR; WAIT_L(0); G_MMA(0, 1, At, B1); BAR;
            G_LDA(At, 0, 1); G_STAGE(SA_(0, 0), a2, oA[0]);
            BAR; WAIT_L(0); G_MMA(1, 0, At, B0); BAR; SCHED;
            G_STAGE(SB_(0, 1), p1, oB);
            WAIT_V(6); BAR; G_MMA(1, 1, At, B1); BAR;
            G_LDB(B0, 1, 0); SCHED; G_LDA(At, 1, 0); G_STAGE(SA_(0, 1), a2, oA[1]);
            WAIT_L(8); BAR; WAIT_L(0); G_MMA(0, 0, At, B0); BAR; SCHED;
            G_LDB(B1, 1, 1); G_STAGE(SB_(1, 0), p0 + 128, oB);
            BAR; WAIT_L(0); G_MMA(0, 1, At, B1); BAR;
            G_LDA(At, 1, 1); G_STAGE(SA_(1, 0), a2 + 128, oA[0]);
            BAR; WAIT_L(0); G_MMA(1, 0, At, B0); BAR; SCHED;
            G_STAGE(SB_(1, 1), p1 + 128, oB);
            WAIT_V(6); BAR; G_MMA(1, 1, At, B1); BAR;
        }
        { int tz = threadIdx.x; asm volatile("" : "+v"(tz)); const int wz = __builtin_amdgcn_readfirstlane(tz >> 6), lz = tz & 63; P.epi(acc, cur, wz >> 2, wz & 3, lz & 15, lz >> 4); }
        if (!has_next) break;
#pragma unroll
        for (int a = 0; a < 2; ++a)
#pragma unroll
            for (int b = 0; b < 2; ++b)
#pragma unroll
                for (int m = 0; m < 4; ++m)
#pragma unroll
                    for (int n = 0; n < 2; ++n) acc[a][b][m][n] = (f32x4){0.f, 0.f, 0.f, 0.f};
        cur = nxt; cA = nA; cB0 = nB0; cB1 = nB1; ++ui;
    }
    WAIT_V(0);
    if (wr == 0) BAR;
    BAR;
    __syncthreads();
}

typedef int v8i32 __attribute__((ext_vector_type(8)));
#define F8_LDA(dst, b, h) do { _Pragma("unroll") for (int m = 0; m < 4; ++m) { const u32x4 _lo = *(const LAS u32x4*)(lds + SA_(b, h) + aoff + m * 2048), _hi = *(const LAS u32x4*)(lds + SA_(b, h) + aoff + m * 2048 + 16); \
    dst[m] = (v8i32){(int)_lo.x, (int)_lo.y, (int)_lo.z, (int)_lo.w, (int)_hi.x, (int)_hi.y, (int)_hi.z, (int)_hi.w}; } } while (0)
#define F8_LDB(dst, b, h) do { _Pragma("unroll") for (int n = 0; n < 2; ++n) { const u32x4 _lo = *(const LAS u32x4*)(lds + SB_(b, h) + boff + n * 2048), _hi = *(const LAS u32x4*)(lds + SB_(b, h) + boff + n * 2048 + 16); \
    dst[n] = (v8i32){(int)_lo.x, (int)_lo.y, (int)_lo.z, (int)_lo.w, (int)_hi.x, (int)_hi.y, (int)_hi.z, (int)_hi.w}; } } while (0)
#define F8_MMA(ai, bj, At, Bt) do { __builtin_amdgcn_s_setprio(1); _Pragma("unroll") for (int m = 0; m < 4; ++m) _Pragma("unroll") for (int n = 0; n < 2; ++n) \
    acc[ai][bj][m][n] = __builtin_amdgcn_mfma_scale_f32_16x16x128_f8f6f4(Bt[n], At[m], acc[ai][bj][m][n], 0, 0, 0, 0x7a7a7a7a  , 0, 0x7f7f7f7f  ); __builtin_amdgcn_s_setprio(0); } while (0)
template <class Prov>
__device__ __forceinline__ void gemm_stream_f8(LAS unsigned char* lds, const __amdgpu_buffer_rsrc_t srd, const Prov& P) {
    const int tid = ltid(), wid = __builtin_amdgcn_readfirstlane(tid >> 6), lane = tid & 63, wr = wid >> 2, wc = wid & 3, fr = lane & 15, fq = lane >> 4;
    const unsigned ldsw = (unsigned)wid * 1024u;
    const int aoff = lds_byte(wr * 64 + fr, fq * 16), boff = lds_byte(wc * 32 + fr, fq * 16);
    typename Prov::Unit cur, nxt;
    if (!P.next(0, cur)) return;
    unsigned oA[2][2]; P.offs(cur, oA);
    const unsigned oB[2] = {P.offB[0], P.offB[1]};
    const int nt = P.nt;
    f32x4 acc[2][2][4][2];
#pragma unroll
    for (int a = 0; a < 2; ++a)
#pragma unroll
        for (int b = 0; b < 2; ++b)
#pragma unroll
            for (int m = 0; m < 4; ++m)
#pragma unroll
                for (int n = 0; n < 2; ++n) acc[a][b][m][n] = (f32x4){0.f, 0.f, 0.f, 0.f};
    v8i32 At[4], B0[2], B1[2];
    unsigned cA = cur.A, cB0 = cur.B0, cB1 = cur.B1;
    G_STAGE(SB_(0, 0), cB0, oB); G_STAGE(SA_(0, 0), cA, oA[0]); G_STAGE(SB_(0, 1), cB1, oB); G_STAGE(SA_(0, 1), cA, oA[1]);
    if (wr == 1) BAR;
    WAIT_V(4); BAR;
    G_STAGE(SB_(1, 0), cB0 + 128, oB); G_STAGE(SA_(1, 0), cA + 128, oA[0]); G_STAGE(SB_(1, 1), cB1 + 128, oB);
    WAIT_V(6); BAR;
    int ui = 0;
    for (;;) {
        const bool has_next = P.next(ui + 1, nxt);
        const unsigned nA = has_next ? nxt.A : cA, nB0 = has_next ? nxt.B0 : cB0, nB1 = has_next ? nxt.B1 : cB1;
        for (int t = 0; t < nt; t += 2) {
            const bool last = (t == nt - 2);
            const unsigned a1 = cA + (t + 1) * 128;
            F8_LDB(B0, 0, 0); SCHED; F8_LDA(At, 0, 0); G_STAGE(SA_(1, 1), a1, oA[1]);
            WAIT_L(8); BAR; WAIT_L(0); F8_MMA(0, 0, At, B0); BAR; SCHED;
            if (last && has_next) P.offs(nxt, oA);
            const unsigned a2 = last ? nA : cA + (t + 2) * 128, p0 = last ? nB0 : cB0 + (t + 2) * 128, p1 = last ? nB1 : cB1 + (t + 2) * 128;
            F8_LDB(B1, 0, 1); G_STAGE(SB_(0, 0), p0, oB);
            BAR; WAIT_L(0); F8_MMA(0, 1, At, B1); BAR;
            F8_LDA(At, 0, 1); G_STAGE(SA_(0, 0), a2, oA[0]);
            BAR; WAIT_L(0); F8_MMA(1, 0, At, B0); BAR; SCHED;
            G_STAGE(SB_(0, 1), p1, oB);
            WAIT_V(6); BAR; F8_MMA(1, 1, At, B1); BAR;
            F8_LDB(B0, 1, 0); SCHED; F8_LDA(At, 1, 0); G_STAGE(SA_(0, 1), a2, oA[1]);
            WAIT_L(8); BAR; WAIT_L(0); F8_MMA(0, 0, At, B0); BAR; SCHED;
            F8_LDB(B1, 1, 1); G_STAGE(SB_(1, 0), p0 + 128, oB);
            BAR; WAIT_L(0); F8_MMA(0, 1, At, B1); BAR;
            F8_LDA(At, 1, 1); G_STAGE(SA_(1, 0), a2 + 128, oA[0]);
            BAR; WAIT_L(0); F8_MMA(1, 0, At, B0); BAR; SCHED;
            G_STAGE(SB_(1, 1), p1 + 128, oB);
            WAIT_V(6); BAR; F8_MMA(1, 1, At, B1); BAR;
        }
        { int tz = threadIdx.x; asm volatile("" : "+v"(tz)); const int wz = __builtin_amdgcn_readfirstlane(tz >> 6), lz = tz & 63; P.epi(acc, cur, wz >> 2, wz & 3, lz & 15, lz >> 4); }
        if (!has_next) break;
#pragma unroll
        for (int a = 0; a < 2; ++a)
#pragma unroll
            for (int b = 0; b < 2; ++b)
#pragma unroll
                for (int m = 0; m < 4; ++m)
#pragma unroll
                    for (int n = 0; n < 2; ++n) acc[a][b][m][n] = (f32x4){0.f, 0.f, 0.f, 0.f};
        cur = nxt; cA = nA; cB0 = nB0; cB1 = nB1; ++ui;
    }
    WAIT_V(0);
    if (wr == 0) BAR;
    BAR;
    __syncthreads();
}

#define EPI_ROWS(ai, m) (ai * 128 + wr * 64 + m * 16 + fr)
#define EPI_COLS(bj, n) (bj * 128 + wc * 32 + n * 16 + fq * 4)
#define EPI_ROW16(ai, m) (ai * 128 + wr * 64 + m * 16)
typedef const f32x4 (&AccRef)[2][2][4][2];

struct EpiPool {
    const float* x; const float* scale; float* o; int row0, col0;
    __device__ __forceinline__ void operator()(AccRef acc, int wr, int wc, int fr, int fq) const {
#pragma unroll
        for (int ai = 0; ai < 2; ++ai)
#pragma unroll
            for (int m = 0; m < 4; ++m) { const size_t rb = (size_t)(row0 + EPI_ROW16(ai, m)) * DM;
#pragma unroll
                for (int bj = 0; bj < 2; ++bj) { const int cb = col0 + bj * 128 + wc * 32; f32x4 x0, x1; ld_rows8_f32(x + rb + cb, DM, fr, fq, x0, x1);
                    const f32x4 s0 = ld4(scale + cb + fq * 4), s1 = ld4(scale + cb + 16 + fq * 4);
                    st_rows8_f32(o + rb + cb, DM, fr, fq, x0 + s0 * acc[ai][bj][m][0], x1 + s1 * acc[ai][bj][m][1]); }
                if (m == 3) asm volatile("" ::: "memory"); }
    }
};
struct EpiRes {
    const bf16_t* base; bf16_t* o; int row0, col0;
    __device__ __forceinline__ void operator()(AccRef acc, int wr, int wc, int fr, int fq) const {
#pragma unroll
        for (int ai = 0; ai < 2; ++ai)
#pragma unroll
            for (int m = 0; m < 4; ++m) { const size_t rb = (size_t)(row0 + EPI_ROW16(ai, m)) * DM;
#pragma unroll
                for (int bj = 0; bj < 2; ++bj) { const int cb = col0 + bj * 128 + wc * 32; u32x2 w0, w1; ld_pair_bf16(base + (size_t)(row0 + EPI_ROWS(ai, m)) * DM + cb, fq, w0, w1);
                    const f32x4 x0 = (f32x4){bf_lo(w0.x), bf_hi(w0.x), bf_lo(w0.y), bf_hi(w0.y)}, x1 = (f32x4){bf_lo(w1.x), bf_hi(w1.x), bf_lo(w1.y), bf_hi(w1.y)};
                    st_pair_bf16(o + (size_t)(row0 + EPI_ROWS(ai, m)) * DM + cb, x0 + acc[ai][bj][m][0], x1 + acc[ai][bj][m][1], fq); }
                if (m == 3) asm volatile("" ::: "memory"); }
    }
};
struct EpiBf16 {
    bf16_t* o; int ld, row0, col0;
    __device__ __forceinline__ void operator()(AccRef acc, int wr, int wc, int fr, int fq) const {
#pragma unroll
        for (int ai = 0; ai < 2; ++ai)
#pragma unroll
            for (int m = 0; m < 4; ++m) { const size_t ro = (size_t)(row0 + EPI_ROWS(ai, m)) * ld;
#pragma unroll
                for (int bj = 0; bj < 2; ++bj) st_pair_bf16(o + ro + col0 + bj * 128 + wc * 32, acc[ai][bj][m][0], acc[ai][bj][m][1], fq); }
    }
};
template <bool STATS>
struct EpiPle {
    const bf16_t* x2; const float* rs2; const bf16_t* pp; float* o; bf16_t* xb; float* ss; int row0, col0;
    __device__ __forceinline__ void operator()(AccRef acc, int wr, int wc, int fr, int fq) const {
#pragma unroll
        for (int ai = 0; ai < 2; ++ai)
#pragma unroll
            for (int m = 0; m < 4; ++m) { const int row = row0 + EPI_ROWS(ai, m); const size_t ro = (size_t)row * DM; float sq = 0.f; const float rs = rs2[row];
#pragma unroll
                for (int bj = 0; bj < 2; ++bj) { f32x4 rr[2]; u32x2 pwv[2], xwv[2]; const int cb = col0 + bj * 128 + wc * 32; const size_t rb = (size_t)(row0 + EPI_ROW16(ai, m)) * DM;
                    ld_pair_bf16(x2 + ro + cb, fq, xwv[0], xwv[1]); ld_pair_bf16(pp + ro + cb, fq, pwv[0], pwv[1]);
#pragma unroll
                    for (int n = 0; n < 2; ++n) { const f32x4 a = acc[ai][bj][m][n]; const u32x2 pw = pwv[n], xw = xwv[n];
                        f32x4 r; r[0] = bf_lo(xw.x) + sigmoidf_(a[0] * rs) * bf_lo(pw.x); r[1] = bf_hi(xw.x) + sigmoidf_(a[1] * rs) * bf_hi(pw.x);
                        r[2] = bf_lo(xw.y) + sigmoidf_(a[2] * rs) * bf_lo(pw.y); r[3] = bf_hi(xw.y) + sigmoidf_(a[3] * rs) * bf_hi(pw.y);
                        rr[n] = r;
                        if (STATS) sq += r[0] * r[0] + r[1] * r[1] + r[2] * r[2] + r[3] * r[3]; }
                    if (STATS) st_pair_bf16(xb + ro + cb, rr[0], rr[1], fq);
                    else st_rows8_f32(o + rb + cb, DM, fr, fq, rr[0], rr[1]); }
                if (STATS) { sq += __shfl_xor(sq, 16); sq += __shfl_xor(sq, 32); if (fq == 0) ss[(size_t)row * 16 + (col0 >> 8) * 4 + wc] = sq; }
                if (m == 3) asm volatile("" ::: "memory"); }
    }
};
__device__ __forceinline__ float sum16(const float* p, int n4) { float t = 0.f; for (int i = 0; i < n4; ++i) { const f32x4 v = ld4(p + 4 * i); t += (v[0] + v[1]) + (v[2] + v[3]); } return t; }
struct EpiLat {
    const float* ss3; bf16_t* o; float* ssq; float* sskv; int row0, col0;
    __device__ __forceinline__ void operator()(AccRef acc, int wr, int wc, int fr, int fq) const {
#pragma unroll
        for (int ai = 0; ai < 2; ++ai)
#pragma unroll
            for (int m = 0; m < 4; ++m) { const int row = row0 + EPI_ROWS(ai, m); const float rs = rsqrtf(sum16(ss3 + (size_t)row * 16, 4) * (1.0f / DM) + EPS); float sq[2];
#pragma unroll
                for (int bj = 0; bj < 2; ++bj) { sq[bj] = 0.f;
#pragma unroll
                    for (int n = 0; n < 2; ++n) { const f32x4 v = acc[ai][bj][m][n] * rs; sq[bj] += v[0] * v[0] + v[1] * v[1] + v[2] * v[2] + v[3] * v[3]; }
                    st_pair_bf16(o + (size_t)row * LATP + col0 + bj * 128 + wc * 32, acc[ai][bj][m][0] * rs, acc[ai][bj][m][1] * rs, fq);
                    sq[bj] += __shfl_xor(sq[bj], 16); sq[bj] += __shfl_xor(sq[bj], 32); }
                if (fq == 0) {
                    const int h0 = col0 >> 7;
#pragma unroll
                    for (int bj = 0; bj < 2; ++bj) { const int h = h0 + bj; if (h < 3) ssq[(size_t)row * 16 + 4 * h + wc] = sq[bj]; else if (h < 5) sskv[(size_t)row * 16 + 4 * (h - 3) + wc] = sq[bj]; } } }
    }
};
struct EpiBf16S {
    bf16_t* o; int ld; const float* ss; int np4; float inv_k; int row0, col0;
    __device__ __forceinline__ void operator()(AccRef acc, int wr, int wc, int fr, int fq) const {
#pragma unroll
        for (int ai = 0; ai < 2; ++ai)
#pragma unroll
            for (int m = 0; m < 4; ++m) { const int row = row0 + EPI_ROWS(ai, m); const float rs = rsqrtf(sum16(ss + (size_t)row * 16, np4) * inv_k + EPS); const size_t ro = (size_t)row * ld;
#pragma unroll
                for (int bj = 0; bj < 2; ++bj) st_pair_bf16(o + ro + col0 + bj * 128 + wc * 32, acc[ai][bj][m][0] * rs, acc[ai][bj][m][1] * rs, fq); }
    }
};
struct EpiKV {
    bf16_t* o; const float* ss; unsigned char* vt; int row0, col0;
    __device__ __forceinline__ void operator()(AccRef acc, int wr, int wc, int fr, int fq) const {
        const int t = fr & 3; const unsigned selq = 0x0c0c0400u + (unsigned)t * 0x0101u;
        const bool hi8 = fr >= 8;
#pragma unroll
        for (int ai = 0; ai < 2; ++ai) { float rs[4];
#pragma unroll
            for (int m = 0; m < 4; ++m) { const int row = row0 + EPI_ROWS(ai, m); rs[m] = rsqrtf(sum16(ss + (size_t)row * 16, 2) * (1.0f / KVL) + EPS);
                st_pair_bf16(o + (size_t)row * (NH * 256) + col0 + wc * 32, acc[ai][0][m][0] * rs[m], acc[ai][0][m][1] * rs[m], fq); }
            const int tok0 = row0 + ai * 128 + wr * 64, b = tok0 / SEQ, kt = (tok0 % SEQ) >> 6;
            unsigned char* tile = vt + ((size_t)(b * NH + (col0 >> 8)) * (SEQ / 64) + kt) * 8192;
#pragma unroll
            for (int n = 0; n < 2; ++n) { unsigned W[4];
#pragma unroll
                for (int m = 0; m < 4; ++m) { const f32x4 v = acc[ai][1][m][n] * rs[m]; const int D = (int)pk4_fp8(v[0], v[1], v[2], v[3]);
                    const unsigned q0 = (unsigned)__builtin_amdgcn_update_dpp(0, D, 0x00, 0xf, 0xf, false), q1 = (unsigned)__builtin_amdgcn_update_dpp(0, D, 0x55, 0xf, 0xf, false);
                    const unsigned q2 = (unsigned)__builtin_amdgcn_update_dpp(0, D, 0xAA, 0xf, 0xf, false), q3 = (unsigned)__builtin_amdgcn_update_dpp(0, D, 0xFF, 0xf, 0xf, false);
                    const unsigned lo = __builtin_amdgcn_perm(q1, q0, selq), hi = __builtin_amdgcn_perm(q3, q2, selq);
                    W[m] = lo | (hi << 16); }
                const unsigned s0 = hi8 ? W[0] : W[2], s1 = hi8 ? W[1] : W[3];
                const unsigned r0 = (unsigned)__builtin_amdgcn_update_dpp(0, (int)s0, 0x128, 0xf, 0xf, false), r1 = (unsigned)__builtin_amdgcn_update_dpp(0, (int)s1, 0x128, 0xf, 0xf, false);
                u32x4 ov; ov.x = hi8 ? r0 : W[0]; ov.y = hi8 ? W[2] : r0; ov.z = hi8 ? r1 : W[1]; ov.w = hi8 ? W[3] : r1;
                const int d = wc * 32 + n * 16 + fq * 4 + t;
                *(u32x4*)(tile + d * 64 + ((fr >> 2) & 1) * 32 + (fr >> 3) * 16) = ov; }
            asm volatile("" ::: "memory"); }
    }
};
struct EpiMoe1 {
    const float* bg; const float* bu; unsigned char* act; int nv;
    __device__ __forceinline__ void operator()(AccRef acc, int wr, int wc, int fr, int fq) const {
        f32x4 bgv[2], buv[2];
#pragma unroll
        for (int n = 0; n < 2; ++n) { const int c = wc * 32 + n * 16 + fq * 4; bgv[n] = ld4(bg + c); buv[n] = ld4(bu + c); }
#pragma unroll
        for (int ai = 0; ai < 2; ++ai)
#pragma unroll
            for (int m = 0; m < 4; ++m) { const int r = EPI_ROWS(ai, m);
                unsigned dw[2];
#pragma unroll
                for (int n = 0; n < 2; ++n) {
                    const f32x4 g4 = acc[ai][0][m][n] + bgv[n], u4 = acc[ai][1][m][n] + buv[n]; float a[4];
#pragma unroll
                    for (int j = 0; j < 4; j += 2) {
                        const f32x2 g = (f32x2){fminf(g4[j], 7.0f), fminf(g4[j + 1], 7.0f)}, u = (f32x2){fminf(fmaxf(u4[j], -7.0f), 7.0f), fminf(fmaxf(u4[j + 1], -7.0f), 7.0f)};
                        const f32x2 t = g * (f32x2){-1.702f * 1.4426950408889634f, -1.702f * 1.4426950408889634f};
                        const f32x2 d = (f32x2){__builtin_amdgcn_exp2f(t.x), __builtin_amdgcn_exp2f(t.y)} + (f32x2){1.0f, 1.0f};
                        const f32x2 q = (u + (f32x2){1.0f, 1.0f}) * g * (f32x2){__builtin_amdgcn_rcpf(d.x), __builtin_amdgcn_rcpf(d.y)};
                        a[j] = q.x; a[j + 1] = q.y; }
                    dw[n] = pk4_fp8(a[0], a[1], a[2], a[3]); }
                const auto sw = __builtin_amdgcn_permlane16_swap(dw[0], dw[1], false, false);
                u32x2 w; w.x = sw[0]; w.y = sw[1];
                if (r < nv) *(u32x2*)(act + (size_t)r * DFF + wc * 32 + (fq & 1) * 16 + (fq >> 1) * 8) = w; }
    }
};
constexpr float SLOT_SCALE = 8.0f;
struct EpiMoe2 {
    const float* bd; LAS const int* lpair; LAS const float* lgate; bf16_t* slot; int nv, col0;
    __device__ __forceinline__ void operator()(AccRef acc, int wr, int wc, int fr, int fq) const {
        f32x4 bv[2][2];
#pragma unroll
        for (int bj = 0; bj < 2; ++bj)
#pragma unroll
            for (int n = 0; n < 2; ++n) bv[bj][n] = ld4(bd + col0 + EPI_COLS(bj, n));
#pragma unroll
        for (int ai = 0; ai < 2; ++ai)
#pragma unroll
            for (int m = 0; m < 4; ++m) { const int r = EPI_ROWS(ai, m); const int pair = lpair[r]; const float g = lgate[r] * SLOT_SCALE; unsigned char* orow = (unsigned char*)slot + (size_t)pair * DM + col0;
#pragma unroll
                for (int bj = 0; bj < 2; ++bj) {
                    unsigned dq[2];
#pragma unroll
                    for (int n = 0; n < 2; ++n) { f32x4 v = (acc[ai][bj][m][n] + bv[bj][n]) * g;
#pragma unroll
                        for (int j = 0; j < 4; ++j) v[j] = __builtin_amdgcn_fmed3f(v[j], -440.0f, 440.0f);
                        dq[n] = pk4_fp8(v[0], v[1], v[2], v[3]); }
                    const auto sw = __builtin_amdgcn_permlane16_swap(dq[0], dq[1], false, false);
                    u32x2 w; w.x = sw[0]; w.y = sw[1];
                    if (r < nv) *(u32x2*)(orow + bj * 128 + wc * 32 + (fq & 1) * 16 + (fq >> 1) * 8) = w;
                    asm volatile("" ::: "memory"); } }
    }
};

__device__ __forceinline__ void offs_contig(const int (&R)[2], const int (&C)[2], unsigned ldaB, unsigned ldbB, unsigned (&offA)[2][2], unsigned (&offB)[2]) {
#pragma unroll
    for (int i = 0; i < 2; ++i) { offA[0][i] = (unsigned)R[i] * ldaB + C[i] * 2; offA[1][i] = (unsigned)(R[i] + 128) * ldaB + C[i] * 2; offB[i] = (unsigned)R[i] * ldbB + C[i] * 2; }
}

template <int N, int K>
__device__ __forceinline__ void tr_load(const float* __restrict__ src, const float* __restrict__ ksc, int u, int r, int c4, f32x4 (&v)[8]) {
    constexpr int TN = (N + 255) / 256, TK = K / 64, PTM = TN * TK;
    const int mat = u / PTM, rem = u - mat * PTM, tn = rem / TK, tk = rem - tn * TK;
    const bool ok = (N % 256 == 0) || (tn * 256 + c4 < N);
    const float* s = src + (size_t)mat * K * N + (size_t)(tk * 64 + r) * N + (ok ? tn * 256 + c4 : 0);
#pragma unroll
    for (int p = 0; p < 8; ++p) { f32x4 t = ld4(s + (size_t)p * 8 * N); if (N % 256 != 0) { if (!ok) t = (f32x4){0.f, 0.f, 0.f, 0.f}; } if (ksc) t = t * ksc[tk * 64 + p * 8 + r]; v[p] = t; }
}
template <int N, int K>
__device__ __forceinline__ void transpose_seg(LAS unsigned char* lds, const float* __restrict__ src, bf16_t* __restrict__ dst, int nmat, int& rot, const float* __restrict__ ksc = nullptr) {
    constexpr int TN = (N + 255) / 256, TK = K / 64, PTM = TN * TK;
    const int G = gridDim.x, tid = threadIdx.x, total = nmat * PTM;
    LAS float* tile = (LAS float*)lds;
    const int r = tid >> 6, c4 = (tid & 63) * 4, nl = tid >> 1, kh = (tid & 1) * 32;
    int u = (int)blockIdx.x - rot; if (u < 0) u += G;
    f32x4 v[8];
    if (u < total) tr_load<N, K>(src, ksc, u, r, c4, v);
    while (u < total) {
#pragma unroll
        for (int p = 0; p < 8; ++p) *(LAS f32x4*)(tile + (p * 8 + r) * 260 + c4) = v[p];
        __syncthreads();
        const int mat = u / PTM, rem = u - mat * PTM, tn = rem / TK, tk = rem - tn * TK;
        const int un = u + G;
        if (un < total) tr_load<N, K>(src, ksc, un, r, c4, v);
        float w[32];
#pragma unroll
        for (int j = 0; j < 32; ++j) w[j] = tile[(kh + j) * 260 + nl];
        bf16_t* d = dst + ((size_t)mat * TN * 256 + tn * 256 + nl) * K + tk * 64 + kh;
#pragma unroll
        for (int q = 0; q < 4; ++q) { u32x4 o; o.x = cvt_pk_bf16(w[q * 8 + 0], w[q * 8 + 1]); o.y = cvt_pk_bf16(w[q * 8 + 2], w[q * 8 + 3]);
            o.z = cvt_pk_bf16(w[q * 8 + 4], w[q * 8 + 5]); o.w = cvt_pk_bf16(w[q * 8 + 6], w[q * 8 + 7]); *(u32x4*)(d + q * 8) = o; }
        __syncthreads();
        u = un;
    }
    rot = (rot + total) % G;
}
template <int N, int K>
__device__ __forceinline__ void transpose_seg_f8(LAS unsigned char* lds, const float* __restrict__ src, unsigned char* __restrict__ dst, int nmat, int& rot, const float* __restrict__ ksc = nullptr) {
    constexpr int TN = (N + 255) / 256, TK = K / 64, PTM = TN * TK;
    const int G = gridDim.x, tid = threadIdx.x, total = nmat * PTM;
    LAS float* tile = (LAS float*)lds;
    const int r = tid >> 6, c4 = (tid & 63) * 4, nl = tid >> 1, kh = (tid & 1) * 32;
    int u = (int)blockIdx.x - rot; if (u < 0) u += G;
    f32x4 v[8];
    if (u < total) tr_load<N, K>(src, ksc, u, r, c4, v);
    while (u < total) {
#pragma unroll
        for (int p = 0; p < 8; ++p) *(LAS f32x4*)(tile + (p * 8 + r) * 260 + c4) = v[p];
        __syncthreads();
        const int mat = u / PTM, rem = u - mat * PTM, tn = rem / TK, tk = rem - tn * TK;
        const int un = u + G;
        if (un < total) tr_load<N, K>(src, ksc, un, r, c4, v);
        float w[32];
#pragma unroll
        for (int j = 0; j < 32; ++j) w[j] = tile[(kh + j) * 260 + nl] * 32.0f;
        unsigned char* d = dst + ((size_t)mat * TN * 256 + tn * 256 + nl) * K + tk * 64 + kh;
#pragma unroll
        for (int q = 0; q < 2; ++q) { u32x4 o; o.x = pk4_fp8(w[q * 16 + 0], w[q * 16 + 1], w[q * 16 + 2], w[q * 16 + 3]); o.y = pk4_fp8(w[q * 16 + 4], w[q * 16 + 5], w[q * 16 + 6], w[q * 16 + 7]);
            o.z = pk4_fp8(w[q * 16 + 8], w[q * 16 + 9], w[q * 16 + 10], w[q * 16 + 11]); o.w = pk4_fp8(w[q * 16 + 12], w[q * 16 + 13], w[q * 16 + 14], w[q * 16 + 15]); *(u32x4*)(d + q * 16) = o; }
        __syncthreads();
        u = un;
    }
    rot = (rot + total) % G;
}
__device__ __forceinline__ void rope_table_phase(const int* __restrict__ pos, float* __restrict__ cs) {
    for (int idx = blockIdx.x * NTHREADS + threadIdx.x; idx < T * 32; idx += gridDim.x * NTHREADS) { const int tok = idx >> 5, i = idx & 31;
        const float ang = (float)pos[tok] * exp2f(-(float)i * (13.287712379549449f / 32.0f));
        double tr = (double)ang * 0.15915494309189535; tr -= __builtin_rint(tr); const float frv = (float)tr;
        *(f32x2*)(cs + (size_t)idx * 2) = (f32x2){__builtin_amdgcn_cosf(frv), __builtin_amdgcn_sinf(frv)}; }
}
__device__ __forceinline__ void cvt_p_phase(const float* __restrict__ p, bf16_t* __restrict__ pb) {
    const size_t n8 = (size_t)2 * T * PLE / 8, stride = (size_t)gridDim.x * NTHREADS;
    size_t i = (size_t)blockIdx.x * NTHREADS + threadIdx.x;
    for (; i + 3 * stride < n8; i += 4 * stride) { f32x4 a[4], b[4];
#pragma unroll
        for (int k = 0; k < 4; ++k) { a[k] = ld4(p + (i + k * stride) * 8); b[k] = ld4(p + (i + k * stride) * 8 + 4); }
#pragma unroll
        for (int k = 0; k < 4; ++k) { u32x4 o; o.x = cvt_pk_bf16(a[k][0], a[k][1]); o.y = cvt_pk_bf16(a[k][2], a[k][3]); o.z = cvt_pk_bf16(b[k][0], b[k][1]); o.w = cvt_pk_bf16(b[k][2], b[k][3]);
            *(u32x4*)(pb + (i + k * stride) * 8) = o; } }
    for (; i < n8; i += stride) { const f32x4 a = ld4(p + i * 8), b = ld4(p + i * 8 + 4);
        u32x4 o; o.x = cvt_pk_bf16(a[0], a[1]); o.y = cvt_pk_bf16(a[2], a[3]); o.z = cvt_pk_bf16(b[0], b[1]); o.w = cvt_pk_bf16(b[2], b[3]);
        *(u32x4*)(pb + i * 8) = o; }
}
template <int WIN>
__device__ __forceinline__ void pool_diff_cols(const float* __restrict__ x, LAS const float* rs, const f32x2 gv, bf16_t* __restrict__ diff, int t0, int s0, int c) {
    constexpr int NR = 32 + WIN - 1;
    f32x2 h[NR];
#pragma unroll
    for (int j = 0; j < NR; ++j) { const int row = t0 - (WIN - 1) + j; const bool ok = (s0 - (WIN - 1) + j) >= 0;
        h[j] = *(const f32x2*)(x + (size_t)(ok ? row : t0) * DM + c); }
#pragma unroll
    for (int j = 0; j < NR; ++j) { const int ri = 15 - (WIN - 1) + j; const bool ok = (s0 - (WIN - 1) + j) >= 0; h[j] = ok ? h[j] * rs[ri] * gv : (f32x2){0.f, 0.f}; }
    f32x2 W = (f32x2){0.f, 0.f};
#pragma unroll
    for (int j = 0; j < WIN - 1; ++j) W += h[j];
#pragma unroll
    for (int i = 0; i < 32; ++i) {
        W += h[i + WIN - 1];
        const int s = s0 + i; const int cnt = (s + 1 < WIN) ? s + 1 : WIN;
        const f32x2 d = W * (1.0f / (float)cnt) - h[i + WIN - 1];
        *(unsigned*)(diff + (size_t)(t0 + i) * DM + c) = cvt_pk_bf16(d.x, d.y);
        W -= h[i];
    }
}
__device__ __forceinline__ void pool_diff_phase(LAS unsigned char* lds, const float* __restrict__ x, const float* __restrict__ g, bf16_t* __restrict__ diff) {
    LAS float* rs = (LAS float*)lds;
    const int tid = threadIdx.x, wid = tid >> 6, lane = tid & 63;
    const int c = tid * 2, grp = __builtin_amdgcn_readfirstlane(c >> 8);
    const f32x2 gv = *(const f32x2*)(g + c);
    for (int run = blockIdx.x; run < T / 32; run += gridDim.x) {
        const int t0 = run * 32, s0 = t0 % SEQ, back = s0 < 15 ? s0 : 15;
        __syncthreads();
        { f32x4 v[6][4]; const int r0 = 15 - back + wid;
#pragma unroll
          for (int k = 0; k < 6; ++k) { const int r = r0 + 8 * k; const float* xr = x + (size_t)(t0 - 15 + (r < 47 ? r : 46)) * DM;
#pragma unroll
              for (int q = 0; q < 4; ++q) v[k][q] = ld4(xr + q * 256 + lane * 4); }
#pragma unroll
          for (int k = 0; k < 6; ++k) { const int r = r0 + 8 * k; float ss = 0.f;
#pragma unroll
              for (int q = 0; q < 4; ++q) ss += v[k][q][0] * v[k][q][0] + v[k][q][1] * v[k][q][1] + v[k][q][2] * v[k][q][2] + v[k][q][3] * v[k][q][3];
              ss = wave_sum(ss);
              if (lane == 0 && r < 47) rs[r] = rsqrtf(ss * (1.0f / DM) + EPS); } }
        __syncthreads();
        if (grp == 0) pool_diff_cols<2>(x, rs, gv, diff, t0, s0, c);
        else if (grp == 1) pool_diff_cols<4>(x, rs, gv, diff, t0, s0, c);
        else if (grp == 2) pool_diff_cols<8>(x, rs, gv, diff, t0, s0, c);
        else pool_diff_cols<16>(x, rs, gv, diff, t0, s0, c);
    }
}

template <bool XBF> __device__ __forceinline__ void combine_phase(const float* __restrict__ x1, const bf16_t* __restrict__ slot, bf16_t* __restrict__ x2, unsigned char* __restrict__ x2q, float* __restrict__ rs2) {
    const int tid = threadIdx.x, wid = tid >> 6, lane = tid & 63;
    for (int row0 = blockIdx.x * 8 + wid; row0 < T; row0 += gridDim.x * 16) {
        const int row1 = row0 + gridDim.x * 8; const bool has1 = row1 < T;
        f32x4 xa[2][4]; unsigned sw[2][4][4];
#pragma unroll
        for (int t = 0; t < 2; ++t) { const int row = (t && has1) ? row1 : row0;
#pragma unroll
            for (int q = 0; q < 4; ++q) { const int col = q * 256 + lane * 4;
                if (XBF) { const u32x2 w = *(const u32x2*)((const bf16_t*)x1 + (size_t)row * DM + col); xa[t][q] = (f32x4){bf_lo(w.x), bf_hi(w.x), bf_lo(w.y), bf_hi(w.y)}; } else xa[t][q] = ld4(x1 + (size_t)row * DM + col);
#pragma unroll
                for (int k = 0; k < 4; ++k) sw[t][q][k] = *(const unsigned*)((const unsigned char*)slot + ((size_t)row * 4 + k) * DM + col); } }
#pragma unroll
        for (int t = 0; t < 2; ++t) { if (t == 1 && !has1) break; const int row = t ? row1 : row0; float ss = 0.f;
#pragma unroll
            for (int q = 0; q < 4; ++q) { const int col = q * 256 + lane * 4; f32x4 a = xa[t][q];
                { f32x2 s01 = (f32x2){0.f, 0.f}, s23 = (f32x2){0.f, 0.f};
#pragma unroll
                  for (int k = 0; k < 4; ++k) { const int w = (int)sw[t][q][k]; s01 += __builtin_amdgcn_cvt_pk_f32_fp8(w, false); s23 += __builtin_amdgcn_cvt_pk_f32_fp8(w, true); }
                  a[0] += s01.x * (1.0f / SLOT_SCALE); a[1] += s01.y * (1.0f / SLOT_SCALE); a[2] += s23.x * (1.0f / SLOT_SCALE); a[3] += s23.y * (1.0f / SLOT_SCALE); }
                xa[t][q] = a; st4bf(x2 + (size_t)row * DM + col, a); *(unsigned*)(x2q + (size_t)row * DM + col) = pk4_fp8(a[0], a[1], a[2], a[3]); ss += a[0] * a[0] + a[1] * a[1] + a[2] * a[2] + a[3] * a[3]; }
            ss = wave_sum(ss); if (lane == 0) rs2[row] = rsqrtf(ss * (1.0f / DM) + EPS); }
    }
}
__device__ __forceinline__ void k_finalize_phase(const bf16_t* __restrict__ kvf, const bf16_t* __restrict__ lat, const float* __restrict__ cst, const float* __restrict__ khn, bf16_t* __restrict__ K) {
    const int tid = ltid(), wid = tid >> 6, lane = tid & 63, h = lane >> 3, j = lane & 7;
    const bool x2h = j >= 4;
    f32x4 gn[4], gr[2];
#pragma unroll
    for (int q = 0; q < 4; ++q) gn[q] = ld4(khn + j * 16 + q * 4);
#pragma unroll
    for (int q = 0; q < 2; ++q) gr[q] = ld4(khn + 128 + j * 8 + q * 4);
    const int nb = (j >> 2) * 64 + (j & 3) * 8, rbyte = 128 + (j & 1) * 32 + (j >> 1) * 8;
    constexpr int KT = 2;
    for (int tok0 = blockIdx.x * 8 + wid; tok0 < T; tok0 += gridDim.x * 8 * KT) {
        u32x4 n0[KT], n1[KT], rp[KT]; f32x4 cs[KT][4];
#pragma unroll
        for (int t = 0; t < KT; ++t) { const int tk = tok0 + t * (int)gridDim.x * 8; const int tok = tk < T ? tk : tok0;
            const bf16_t* kp = kvf + (size_t)tok * (NH * 256) + h * 256 + j * 16; n0[t] = *(const u32x4*)kp; n1[t] = *(const u32x4*)(kp + 8);
            rp[t] = *(const u32x4*)(lat + (size_t)tok * LATP + QL + KVL + j * 8);
#pragma unroll
            for (int q = 0; q < 4; ++q) cs[t][q] = ld4(cst + (size_t)tok * 64 + (j & 3) * 16 + q * 4); }
#pragma unroll
        for (int t = 0; t < KT; ++t) { const int tok = tok0 + t * (int)gridDim.x * 8; if (tok >= T) break;
            const int b = tok / SEQ, sq = tok % SEQ;
            float v[16], r[8];
#define UNP8(dst, o_, w_) { dst[o_ + 0] = bf_lo(w_.x); dst[o_ + 1] = bf_hi(w_.x); dst[o_ + 2] = bf_lo(w_.y); dst[o_ + 3] = bf_hi(w_.y); dst[o_ + 4] = bf_lo(w_.z); dst[o_ + 5] = bf_hi(w_.z); dst[o_ + 6] = bf_lo(w_.w); dst[o_ + 7] = bf_hi(w_.w); }
            UNP8(v, 0, n0[t]) UNP8(v, 8, n1[t]) UNP8(r, 0, rp[t])
#undef UNP8
            float ss = 0.f;
#pragma unroll
            for (int i = 0; i < 16; ++i) ss += v[i] * v[i];
#pragma unroll
            for (int i = 0; i < 8; ++i) ss += r[i] * r[i];
            ss += __shfl_xor(ss, 1); ss += __shfl_xor(ss, 2); ss += __shfl_xor(ss, 4);
            const float rstd = rsqrtf(ss * (1.0f / QKD) + EPS);
#pragma unroll
            for (int i = 0; i < 16; ++i) v[i] *= rstd * gn[i >> 2][i & 3];
#pragma unroll
            for (int i = 0; i < 8; ++i) r[i] *= rstd * gr[i >> 2][i & 3];
            float ro[8];
#pragma unroll
            for (int i = 0; i < 8; ++i) { const float o = __shfl_xor(r[i], 4); const float c = cs[t][i >> 1][(i & 1) * 2], sn = cs[t][i >> 1][(i & 1) * 2 + 1];
                ro[i] = x2h ? (r[i] * c + o * sn) : (r[i] * c - o * sn); }
            unsigned char* kr = (unsigned char*)K + ((size_t)(b * NH + h) * SEQ + sq) * QKD;
            u32x2 w;
            w.x = pk4_fp8(v[0], v[1], v[2], v[3]); w.y = pk4_fp8(v[4], v[5], v[6], v[7]); *(u32x2*)(kr + nb) = w;
            w.x = pk4_fp8(v[8], v[9], v[10], v[11]); w.y = pk4_fp8(v[12], v[13], v[14], v[15]); *(u32x2*)(kr + nb + 32) = w;
            w.x = pk4_fp8(ro[0], ro[1], ro[2], ro[3]); w.y = pk4_fp8(ro[4], ro[5], ro[6], ro[7]); *(u32x2*)(kr + rbyte) = w;
        }
    }
}

__device__ __forceinline__ void v_transpose_phase(const bf16_t* __restrict__ kvf, unsigned char* __restrict__ VT) {
    const int tid = ltid(), wid = tid >> 6, lane = tid & 63;
    for (int item = blockIdx.x * 8 + wid; item < (T / 64) * NH; item += gridDim.x * 8) {
        const int h = item & 7, tt = item >> 3, b = tt / (SEQ / 64), kt = tt % (SEQ / 64);
        const bf16_t* src = kvf + (size_t)tt * 64 * (NH * 256) + h * 256 + 128 + 2 * lane;
        unsigned v[64];
#pragma unroll
        for (int k = 0; k < 64; ++k) v[k] = *(const unsigned*)(src + (size_t)k * (NH * 256));
        unsigned char* dst = VT + ((size_t)(b * NH + h) * (SEQ / 64) + kt) * 8192 + lane * 128;
#pragma unroll
        for (int half = 0; half < 2; ++half)
#pragma unroll
            for (int w4 = 0; w4 < 4; ++w4) { u32x4 o;
#pragma unroll
                for (int e = 0; e < 4; ++e) { const int w = w4 * 4 + e, kb = 32 * ((w >> 2) & 1) + 8 * (w & 3) + 4 * (w >> 3);
                    const unsigned q = half ? pk4_fp8(bf_hi(v[kb]), bf_hi(v[kb + 1]), bf_hi(v[kb + 2]), bf_hi(v[kb + 3])) : pk4_fp8(bf_lo(v[kb]), bf_lo(v[kb + 1]), bf_lo(v[kb + 2]), bf_lo(v[kb + 3]));
                    if (e == 0) o.x = q; else if (e == 1) o.y = q; else if (e == 2) o.z = q; else o.w = q; }
                *(u32x4*)(dst + half * 64 + w4 * 16) = o; }
    }
}

constexpr int RT_PART = 0, RT_SSX = 32768, RT_RSTD = RT_SSX + 2048, RT_HIST = RT_RSTD + 256, RT_BASE = RT_HIST + 128, RT_PE = RT_BASE + 128, RT_PRANK = RT_PE + 1024, RT_PGATE = RT_PRANK + 1024;
static_assert(RT_PGATE + 1024 <= BARW_OFF, "router LDS map");
static_assert(WS_END < 0x7ffffff0ull, "workspace must fit one 2 GiB buffer descriptor");
__device__ __forceinline__ void wrg_phase(const float* __restrict__ g, const float* __restrict__ rw, float* __restrict__ wrg) {
    for (int i = blockIdx.x * NTHREADS + threadIdx.x; i < 2 * DM * NE / 4; i += gridDim.x * NTHREADS) { const f32x4 w = ld4(rw + (size_t)i * 4); *(f32x4*)(wrg + (size_t)i * 4) = w * g[i >> 3]; }
}
template <bool XBF>   __device__ __forceinline__ void route_phase(LAS unsigned char* lds, const float* __restrict__ x1, const float* __restrict__ g, const float* __restrict__ wrg, const float* __restrict__ rb,
                                            bf16_t* __restrict__ hn, unsigned* gcnt, int* __restrict__ list, float* __restrict__ gate) {
    const int tid = ltid(), wid = __builtin_amdgcn_readfirstlane(tid >> 6), lane = tid & 63, i32 = lane & 31, kk = lane >> 5, tg = wid >> 2, kq = wid & 3;
    LAS float* part = (LAS float*)(lds + RT_PART); LAS float* ssx = (LAS float*)(lds + RT_SSX); LAS float* rstd_l = (LAS float*)(lds + RT_RSTD);
    LAS int* hist = (LAS int*)(lds + RT_HIST); LAS int* sbase = (LAS int*)(lds + RT_BASE);
    LAS int* pe = (LAS int*)(lds + RT_PE); LAS int* prank = (LAS int*)(lds + RT_PRANK); LAS float* pgate = (LAS float*)(lds + RT_PGATE);
    const float bias = rb[lane & 31];
    const int kbase = kq * 256 + kk * 128;
    for (int blk = blockIdx.x; blk < T / 64; blk += gridDim.x) {
        __syncthreads();
        if (tid < 32) hist[tid] = 0;
        const int tok = blk * 64 + tg * 32 + i32;
        f32x4 xr[32]; float ss = 0.f;
        if (XBF) { const bf16_t* xp = (const bf16_t*)x1 + (size_t)tok * DM + kbase; u32x4 xw[16];
#pragma unroll
            for (int q = 0; q < 16; ++q) xw[q] = *(const u32x4*)(xp + q * 8);
#pragma unroll
            for (int q = 0; q < 16; ++q) { xr[2 * q] = (f32x4){bf_lo(xw[q].x), bf_hi(xw[q].x), bf_lo(xw[q].y), bf_hi(xw[q].y)}; xr[2 * q + 1] = (f32x4){bf_lo(xw[q].z), bf_hi(xw[q].z), bf_lo(xw[q].w), bf_hi(xw[q].w)}; } }
        else { const float* xp = x1 + (size_t)tok * DM + kbase;
#pragma unroll
            for (int q = 0; q < 32; ++q) xr[q] = ld4(xp + q * 4); }
#pragma unroll
        for (int q = 0; q < 32; ++q) ss += xr[q][0] * xr[q][0] + xr[q][1] * xr[q][1] + xr[q][2] * xr[q][2] + xr[q][3] * xr[q][3];
        ssx[(tg * 32 + i32) * 8 + kq * 2 + kk] = ss;
        f32x16 D;
#pragma unroll
        for (int r = 0; r < 16; ++r) D[r] = 0.f;
        const float* wp = wrg + (size_t)kbase * NE + i32; asm volatile("" : "+v"(wp));
        float bA[16], bB[16];
#define RT_LDB(dst, c) _Pragma("unroll") for (int j = 0; j < 16; ++j) dst[j] = wp[((c) * 16 + j) * NE];
#define RT_MMA(src, c) _Pragma("unroll") for (int j = 0; j < 16; ++j) D = __builtin_amdgcn_mfma_f32_32x32x2f32(xr[(c) * 4 + (j >> 2)][j & 3], src[j], D, 0, 0, 0);
        RT_LDB(bA, 0)
        RT_LDB(bB, 1) asm volatile("" ::: "memory"); RT_MMA(bA, 0)
        RT_LDB(bA, 2) asm volatile("" ::: "memory"); RT_MMA(bB, 1)
        RT_LDB(bB, 3) asm volatile("" ::: "memory"); RT_MMA(bA, 2)
        RT_LDB(bA, 4) asm volatile("" ::: "memory"); RT_MMA(bB, 3)
        RT_LDB(bB, 5) asm volatile("" ::: "memory"); RT_MMA(bA, 4)
        RT_LDB(bA, 6) asm volatile("" ::: "memory"); RT_MMA(bB, 5)
        RT_LDB(bB, 7) asm volatile("" ::: "memory"); RT_MMA(bA, 6)
        RT_MMA(bB, 7)
#undef RT_LDB
#undef RT_MMA
#pragma unroll
        for (int r = 0; r < 16; ++r) part[(kq * 64 + tg * 32 + (r & 3) + 8 * (r >> 2) + 4 * kk) * 32 + i32] = D[r];
        __syncthreads();
        if (tid < 64) { float t = 0.f;
#pragma unroll
            for (int j = 0; j < 8; ++j) t += ssx[tid * 8 + j];
            rstd_l[tid] = rsqrtf(t * (1.0f / DM) + EPS); }
        __syncthreads();
        { const float rs = rstd_l[tg * 32 + i32]; unsigned char* hp = (unsigned char*)hn + (size_t)tok * DM + kbase; const float* gp = g + kbase; asm volatile("" : "+v"(gp));
#pragma unroll
          for (int q = 0; q < 8; ++q) { u32x4 o; unsigned ow[4];
#pragma unroll
              for (int t = 0; t < 4; ++t) { const f32x4 gq = ld4(gp + q * 16 + t * 4); const f32x4 a = xr[4 * q + t] * rs * gq; ow[t] = pk4_fp8(a[0], a[1], a[2], a[3]); }
              o.x = ow[0]; o.y = ow[1]; o.z = ow[2]; o.w = ow[3]; *(u32x4*)(hp + q * 16) = o; } }
        const int me = lane & 31;
#pragma unroll
        for (int i = 0; i < 8; ++i) {
            const int tl = wid * 8 + i;
            float logit = ((part[(0 * 64 + tl) * 32 + me] + part[(1 * 64 + tl) * 32 + me]) + (part[(2 * 64 + tl) * 32 + me] + part[(3 * 64 + tl) * 32 + me])) * rstd_l[tl] + bias;
            float tv[4]; int ti[4];
#pragma unroll
            for (int r = 0; r < 4; ++r) { float bv = logit; int bi = me;
#pragma unroll
                for (int msk = 1; msk < 32; msk <<= 1) { const float ov = __shfl_xor(bv, msk); const int oi = __shfl_xor(bi, msk); if (ov > bv || (ov == bv && oi < bi)) { bv = ov; bi = oi; } }
                tv[r] = bv; ti[r] = bi; if (me == bi) logit = -3.0e38f; }
            const float e1 = __expf(tv[1] - tv[0]), e2 = __expf(tv[2] - tv[0]), e3 = __expf(tv[3] - tv[0]); const float isum = 1.0f / (1.0f + e1 + e2 + e3);
            if (lane < 4) { const int e = lane == 0 ? ti[0] : lane == 1 ? ti[1] : lane == 2 ? ti[2] : ti[3];
                const float gt = (lane == 0 ? 1.0f : lane == 1 ? e1 : lane == 2 ? e2 : e3) * isum;
                const int rank = __hip_atomic_fetch_add(hist + e, 1, __ATOMIC_RELAXED, __HIP_MEMORY_SCOPE_WORKGROUP);
                const int pl = tl * 4 + lane; pe[pl] = e; prank[pl] = rank; pgate[pl] = gt; }
        }
        __syncthreads();
        if (tid < 32) sbase[tid] = (int)__hip_atomic_fetch_add(gcnt + tid * 64, (unsigned)hist[tid], __ATOMIC_RELAXED, __HIP_MEMORY_SCOPE_AGENT);
        __syncthreads();
        if (tid < 256) { const int e = pe[tid], slot = sbase[e] + prank[tid], pair = (blk * 64 + (tid >> 2)) * 4 + (tid & 3); list[(size_t)e * T + slot] = pair; gate[pair] = pgate[tid]; }
    }
}

__device__ __forceinline__ bool xcd_deal(int i, int nsplit_log2, int MT, int& gt, int& nj) {
    const int c = (int)blockIdx.x;
    if (gridDim.x == 256) { const int xcd = c & 7, sl = c >> 3; gt = ((i * 8 + xcd) << (5 - nsplit_log2)) + (sl >> nsplit_log2); nj = sl & ((1 << nsplit_log2) - 1); }
    else { const int idx = c + i * (int)gridDim.x; gt = idx >> nsplit_log2; nj = idx & ((1 << nsplit_log2) - 1); }
    return gt < MT;
}
struct UnitC { unsigned A, B0, B1; int row0, col0; };
template <class EpiT>
struct ProvDense {
    typedef UnitC Unit;
    int nt; unsigned offB[2]; unsigned oA0[2][2];
    unsigned A, B; unsigned ldaB, ldbB; int nN, nunits; int a_col_step;
    unsigned b_tile_step;
    int deal_first, deal_stride;
    int mt_per_grp; unsigned b_grp_step;
    EpiT E;
    __device__ __forceinline__ void init(int tid, size_t A_, unsigned ldaB_, size_t B_, unsigned K, int nN_, int nunits_, int a_col_step_, const EpiT& E_, int mt_per_grp_ = 1 << 30, unsigned b_grp_step_ = 0) {
        mt_per_grp = mt_per_grp_; b_grp_step = b_grp_step_; deal_first = 0; deal_stride = 0;
        int R[2], C[2]; stage_coords(tid, R, C); A = (unsigned)A_; B = (unsigned)B_; ldaB = ldaB_; ldbB = K * 2; nN = nN_; nunits = nunits_; a_col_step = a_col_step_; nt = (int)K / 64; b_tile_step = 256u * K * 2u; E = E_;
#pragma unroll
        for (int i = 0; i < 2; ++i) { oA0[0][i] = (unsigned)R[i] * ldaB + C[i] * 2; oA0[1][i] = (unsigned)(R[i] + 128) * ldaB + C[i] * 2; offB[i] = (unsigned)R[i] * ldbB + C[i] * 2; }
    }
    __device__ __forceinline__ bool next(int i, Unit& u) const {
        int mt, nj;
        if (deal_stride > 0) { const int idx = deal_first + i * deal_stride; if (deal_first < 0 || idx >= nunits) return false; mt = idx / nN; nj = idx - mt * nN; }
        else if (nN == 4) { if (!xcd_deal(i, 2, nunits >> 2, mt, nj)) return false; }
        else if (nN == 8) { if (!xcd_deal(i, 3, nunits >> 3, mt, nj)) return false; }
        else { const int idx = (int)blockIdx.x + i * (int)gridDim.x; if (idx >= nunits) return false; mt = idx / nN; nj = idx - mt * nN; }
        u.A = A + (unsigned)mt * 256u * ldaB + (unsigned)nj * (unsigned)a_col_step; u.B0 = B + (unsigned)(mt / mt_per_grp) * b_grp_step + (unsigned)nj * b_tile_step; u.B1 = u.B0 + 128u * ldbB; u.row0 = mt * 256; u.col0 = nj * 256; return true;
    }
    __device__ __forceinline__ void offs(const Unit&, unsigned (&oA)[2][2]) const { oA[0][0] = oA0[0][0]; oA[0][1] = oA0[0][1]; oA[1][0] = oA0[1][0]; oA[1][1] = oA0[1][1]; }
    __device__ __forceinline__ void epi(AccRef acc, const Unit& u, int wr, int wc, int fr, int fq) const { EpiT e = E; e.row0 = u.row0; e.col0 = u.col0; e(acc, wr, wc, fr, fq); }
};

constexpr int MO_CNT = MISC_OFF, MO_OFF = MISC_OFF + 128, MO_TP = MISC_OFF + 256, MO_TE = MISC_OFF + 512;
constexpr int MO_MAXT = 320;
constexpr int MO_DESC = MISC_OFF + 2048;
constexpr int MO_IDX = MISC_OFF + 2560;
constexpr int MO_MAXU = 12;
static_assert(MO_IDX + MO_MAXU * 1024 <= BARW_OFF, "MoE LDS map");
__device__ __forceinline__ void moe_setup(LAS unsigned char* lds, unsigned* gcnt) {
    LAS int* cnt = (LAS int*)(lds + MO_CNT); LAS int* off = (LAS int*)(lds + MO_OFF); LAS int* tp = (LAS int*)(lds + MO_TP); LAS int* te = (LAS int*)(lds + MO_TE);
    const int tid = threadIdx.x;
    __syncthreads();
    if (tid < 64) {
        const int e = tid & 31; const int c = (int)__hip_atomic_load(gcnt + e * 64, __ATOMIC_RELAXED, __HIP_MEMORY_SCOPE_AGENT); const int nt_ = (c + 255) >> 8;
        int so = c, st = nt_;
#pragma unroll
        for (int d = 1; d < 32; d <<= 1) { const int a = __shfl_up(so, d), b = __shfl_up(st, d); if ((tid & 31) >= d) { so += a; st += b; } }
        if (tid < 32) { cnt[e] = c; off[e] = so - c; tp[e] = st - nt_; if (e == 31) tp[32] = st;
            for (int m = 0; m < nt_; ++m) te[st - nt_ + m] = e; }
    }
    __syncthreads();
}
__device__ __forceinline__ void moe_descs(LAS unsigned char* lds, int nsplit_log2) {
    LAS int* cnt = (LAS int*)(lds + MO_CNT); LAS int* off = (LAS int*)(lds + MO_OFF); LAS int* tp = (LAS int*)(lds + MO_TP); LAS int* te = (LAS int*)(lds + MO_TE);
    LAS int* desc = (LAS int*)(lds + MO_DESC);
    const int tid = threadIdx.x;
    if (tid < 16) { int gt, nj;
        if (xcd_deal(tid, nsplit_log2, tp[32], gt, nj)) { const int e = te[gt], mt = gt - tp[e]; int nv = cnt[e] - mt * 256; nv = nv > 256 ? 256 : nv;
            desc[tid * 4 + 0] = e; desc[tid * 4 + 1] = mt; desc[tid * 4 + 2] = nv; desc[tid * 4 + 3] = off[e] + mt * 256; }
        else desc[tid * 4 + 0] = -1; }
    __syncthreads();
}
struct UnitM1 { unsigned A, B0, B1; const float* bg; unsigned char* act; int nv, ul; };
struct ProvMoe1 {
    typedef UnitM1 Unit;
    int nt; unsigned offB[2]; int R0, R1, C0, C1;
    LAS unsigned char* lds; unsigned hn, wgu; const float* bgu; unsigned char* actb; int nunits;
    __device__ __forceinline__ bool next(int i, Unit& u) const {
        int gt, n8; if (i >= MO_MAXU || !xcd_deal(i, 3, nunits >> 3, gt, n8)) return false;
        LAS const int* d = (LAS const int*)(lds + MO_DESC) + i * 4;
        const int e = __builtin_amdgcn_readfirstlane(d[0]), nv = __builtin_amdgcn_readfirstlane(d[2]), p0 = __builtin_amdgcn_readfirstlane(d[3]);
        u.A = hn; u.B0 = wgu + (unsigned)(e * 2048 + n8 * 128) * (unsigned)DM; u.B1 = u.B0 + 1024u * DM;
        u.bg = bgu + e * 2048 + n8 * 128; u.act = actb + (size_t)p0 * DFF + n8 * 128; u.nv = nv; u.ul = i; return true;
    }
    __device__ __forceinline__ void offs(const Unit& u, unsigned (&oA)[2][2]) const {
        LAS const unsigned* ix = (LAS const unsigned*)(lds + MO_IDX) + u.ul * 256;
        oA[0][0] = ix[R0] + C0 * 2; oA[0][1] = ix[R1] + C1 * 2; oA[1][0] = ix[128 + R0] + C0 * 2; oA[1][1] = ix[128 + R1] + C1 * 2;
    }
    __device__ __forceinline__ void epi(AccRef acc, const Unit& u, int wr, int wc, int fr, int fq) const { EpiMoe1 e{u.bg, u.bg + 1024, u.act, u.nv}; e(acc, wr, wc, fr, fq); }
};
__device__ __forceinline__ void moe_gemm1_phase(LAS unsigned char* lds, const __amdgpu_buffer_rsrc_t srd, unsigned hn, unsigned wgu, const float* __restrict__ bgu, const int* __restrict__ list, unsigned char* __restrict__ actb) {
    LAS int* tp = (LAS int*)(lds + MO_TP); LAS int* desc = (LAS int*)(lds + MO_DESC); LAS unsigned* ix = (LAS unsigned*)(lds + MO_IDX);
    const int tid = ltid();
    moe_descs(lds, 3);
    { int pr[MO_MAXU / 2];
#pragma unroll
      for (int k = 0; k < MO_MAXU / 2; ++k) { const int ul = 2 * k + (tid >> 8); const int e = desc[ul * 4 + 0], mt = desc[ul * 4 + 1], nv = desc[ul * 4 + 2]; const int row = tid & 255;
          pr[k] = (e >= 0) ? list[(size_t)e * T + mt * 256 + (row < nv ? row : 0)] : 0; }
#pragma unroll
      for (int k = 0; k < MO_MAXU / 2; ++k) { const int ul = 2 * k + (tid >> 8); ix[ul * 256 + (tid & 255)] = (unsigned)(pr[k] >> 2) * (unsigned)DM; } }
    __syncthreads();
    ProvMoe1 P; int R[2], C[2]; stage_coords(tid, R, C); P.R0 = R[0]; P.R1 = R[1]; P.C0 = C[0]; P.C1 = C[1];
    P.nt = DM / 128; P.offB[0] = (unsigned)R[0] * (unsigned)DM + C[0] * 2; P.offB[1] = (unsigned)R[1] * (unsigned)DM + C[1] * 2;
    P.lds = lds; P.hn = hn; P.wgu = wgu; P.bgu = bgu; P.actb = actb; P.nunits = tp[32] * 8;
    gemm_stream_f8(lds, srd, P);
}
struct UnitM2 { unsigned A, B0, B1; const float* bd; int nv, col0, ul; };
struct ProvMoe2 {
    typedef UnitM2 Unit;
    int nt; unsigned offB[2]; unsigned oA0[2][2];
    LAS unsigned char* lds; unsigned actb, wdn; const float* bdn; const int* list; const float* gate; bf16_t* slot; int nunits;
    __device__ __forceinline__ bool next(int i, Unit& u) const {
        int gt, n4; if (i >= 6 || !xcd_deal(i, 2, nunits >> 2, gt, n4)) return false;
        LAS const int* d = (LAS const int*)(lds + MO_DESC) + i * 4;
        const int e = __builtin_amdgcn_readfirstlane(d[0]), mt = __builtin_amdgcn_readfirstlane(d[1]), nv = __builtin_amdgcn_readfirstlane(d[2]), p0 = __builtin_amdgcn_readfirstlane(d[3]);
        u.A = actb + (unsigned)p0 * (unsigned)DFF; u.B0 = wdn + (unsigned)(e * 1024 + n4 * 256) * (unsigned)DFF; u.B1 = u.B0 + 128u * DFF;
        u.bd = bdn + e * DM; u.nv = nv; u.col0 = n4 * 256; u.ul = i; return true;
    }
    __device__ __forceinline__ void offs(const Unit&, unsigned (&oA)[2][2]) const { oA[0][0] = oA0[0][0]; oA[0][1] = oA0[0][1]; oA[1][0] = oA0[1][0]; oA[1][1] = oA0[1][1]; }
    __device__ __forceinline__ void epi(AccRef acc, const Unit& u, int wr, int wc, int fr, int fq) const { EpiMoe2 e{u.bd, (LAS const int*)(lds + MO_IDX) + u.ul * 512, (LAS const float*)(lds + MO_IDX) + u.ul * 512 + 256, slot, u.nv, u.col0}; e(acc, wr, wc, fr, fq); }
};
__device__ __forceinline__ void moe_gemm2_phase(LAS unsigned char* lds, const __amdgpu_buffer_rsrc_t srd, unsigned actb, unsigned wdn, const float* __restrict__ bdn, const int* __restrict__ list,
                                                const float* __restrict__ gate, bf16_t* __restrict__ slot, int layer, bf16_t* pp_out) {
    LAS int* tp = (LAS int*)(lds + MO_TP);
    const int tid = ltid();
    moe_descs(lds, 2);
    { LAS int* desc = (LAS int*)(lds + MO_DESC); LAS int* lp = (LAS int*)(lds + MO_IDX); LAS float* lg = (LAS float*)(lds + MO_IDX);
      int pr[3]; float gv[3];
#pragma unroll
      for (int k = 0; k < 3; ++k) { const int ul = 2 * k + (tid >> 8); const int e = desc[ul * 4 + 0], mt = desc[ul * 4 + 1], nv = desc[ul * 4 + 2]; const int row = tid & 255;
          pr[k] = (e >= 0) ? list[(size_t)e * T + mt * 256 + (row < nv ? row : 0)] : 0; }
#pragma unroll
      for (int k = 0; k < 3; ++k) gv[k] = gate[pr[k]];
#pragma unroll
      for (int k = 0; k < 3; ++k) { const int ul = 2 * k + (tid >> 8); lp[ul * 512 + (tid & 255)] = pr[k]; lg[ul * 512 + 256 + (tid & 255)] = gv[k]; }
      __syncthreads(); }
    ProvMoe2 P; int R[2], C[2]; stage_coords(tid, R, C); unsigned oB[2]; offs_contig(R, C, DFF, DFF, P.oA0, oB); P.offB[0] = oB[0]; P.offB[1] = oB[1];
    P.nt = DFF / 128; P.lds = lds; P.actb = actb; P.wdn = wdn; P.bdn = bdn; P.list = list; P.gate = gate; P.slot = slot; P.nunits = tp[32] * 4;
    gemm_stream_f8(lds, srd, P);
    {
        const int MT = tp[32], c = (int)blockIdx.x; int first, stride;
        if (gridDim.x == 256) { const int maxr = (MT + 63) >> 6, rem = MT - 64 * (maxr - 1), v = 8 * (c & 7) + (c >> 5);
            if (rem >= 64) { first = c; stride = 256; } else { stride = (64 - rem) * 4; first = v >= rem ? (v - rem) * 4 + ((c >> 3) & 3) : -1; } }
        else { first = c; stride = (int)gridDim.x; }
        ProvDense<EpiBf16> Pv; Pv.init(ltid(), WS_PB + (size_t)layer * T * PLE * 2, PLE * 2, WS_WPP + (size_t)layer * 1024 * PLE * 2, PLE, 4, 256, 0, EpiBf16{pp_out, DM, 0, 0}); Pv.deal_first = first; Pv.deal_stride = stride;
        gemm_stream(lds, srd, Pv);
    }
}

constexpr int AT_VB = 128 * 64, AT_KB = 64 * 192, AT_V0 = 0, AT_K0 = 2 * AT_VB, AT_WS = AT_K0 + 2 * AT_KB;
constexpr float AT_SCALE = 0.07216878364870322f;
constexpr float AT_THR = 3.0f, AT_PSH = 4.0f;
__device__ __forceinline__ int kswz(int row, int cb) { return row * 384 + (cb ^ (((row >> 1) & 7) << 4)); }
__device__ __forceinline__ int crow(int r, int hi) { return (r & 3) + 8 * (r >> 2) + 4 * hi; }
__device__ __forceinline__ int v_st(int k, int c) { const int kk = (k & ~0xC) | ((k & 4) << 1) | ((k & 8) >> 1); return ((kk >> 3) * 4 + (c >> 5)) * 512 + ((kk & 7) * 32 + (c & 31)) * 2; }
__device__ __forceinline__ int v_rd_base(int lane) { return ((lane & 3) << 3) | (((lane >> 2) & 3) << 6) | (((lane >> 4) & 1) << 5) | (((lane >> 5) & 1) << 8); }
constexpr int v_rd_off(int d0, int ks, int half) { return d0 * 512 + ks * 4096 + half * 2048; }
template <int OFF> __device__ __forceinline__ s16x4 tr_read(int vb) { s16x4 r; asm volatile("ds_read_b64_tr_b16 %0, %1 offset:%2" : "=&v"(r) : "v"(vb), "i"(OFF) : "memory"); return r; }
#define SBAR() __builtin_amdgcn_sched_barrier(0)

__device__ __forceinline__ void at_partialSM(f32x16& p0, f32x16& p1, float& m_reg, float& mn, float& alpha) {
    constexpr float C = AT_SCALE * 1.4426950408889634f;
    float pmax = p0[0];
#pragma unroll
    for (int r = 1; r < 16; ++r) pmax = fmaxf(pmax, p0[r]);
#pragma unroll
    for (int r = 0; r < 16; ++r) pmax = fmaxf(pmax, p1[r]);
    { auto rr = __builtin_amdgcn_permlane32_swap(__float_as_uint(pmax), __float_as_uint(pmax), false, false); pmax = fmaxf(__uint_as_float(rr[0]), __uint_as_float(rr[1])); }
    if (__builtin_expect(__all(pmax - m_reg <= AT_THR / AT_SCALE), 1)) { mn = m_reg; alpha = 1.f; }
    else { mn = fmaxf(m_reg, pmax); alpha = __builtin_amdgcn_exp2f((m_reg - mn) * C); m_reg = mn; }
    const float mnC = AT_PSH - mn * C;
    const f32x2 C2 = (f32x2){C, C}, M2 = (f32x2){mnC, mnC};
#pragma unroll
    for (int r = 0; r < 16; r += 2) { const f32x2 t = __builtin_elementwise_fma((f32x2){p0[r], p0[r + 1]}, C2, M2); p0[r] = t.x; p0[r + 1] = t.y; }
#pragma unroll
    for (int r = 0; r < 16; r += 2) { const f32x2 t = __builtin_elementwise_fma((f32x2){p1[r], p1[r + 1]}, C2, M2); p1[r] = t.x; p1[r + 1] = t.y; }
#pragma unroll
    for (int r = 0; r < 16; ++r) p0[r] = __builtin_amdgcn_exp2f(p0[r]);
}
__device__ __forceinline__ void at_qkt(f32x16& p0, f32x16& p1, const LAS unsigned char* Ks, const v8i32 (&q8)[3], const int kb0, const int kb1, bool masked) {
    if (masked) {
#pragma unroll
        for (int r = 0; r < 16; ++r) { p0[r] = -1.0e30f; p1[r] = -1.0e30f; }
        return;
    }
#pragma unroll
    for (int r = 0; r < 16; ++r) { p0[r] = 0.f; p1[r] = 0.f; }
#pragma unroll
    for (int d = 0; d < 3; ++d) {
        const u32x4 a0 = *(const LAS u32x4*)(Ks + kb0 + d * 64), a1 = *(const LAS u32x4*)(Ks + kb1 + d * 64);
        const u32x4 c0 = *(const LAS u32x4*)(Ks + kb0 + d * 64 + 32 * 192), c1 = *(const LAS u32x4*)(Ks + kb1 + d * 64 + 32 * 192);
        const v8i32 b0 = (v8i32){(int)a0.x, (int)a0.y, (int)a0.z, (int)a0.w, (int)a1.x, (int)a1.y, (int)a1.z, (int)a1.w};
        const v8i32 b1 = (v8i32){(int)c0.x, (int)c0.y, (int)c0.z, (int)c0.w, (int)c1.x, (int)c1.y, (int)c1.z, (int)c1.w};
        p0 = __builtin_amdgcn_mfma_scale_f32_32x32x64_f8f6f4(b0, q8[d], p0, 0, 0, 0, 0x7f7f7f7f, 0, 0x7f7f7f7f);
        p1 = __builtin_amdgcn_mfma_scale_f32_32x32x64_f8f6f4(b1, q8[d], p1, 0, 0, 0, 0x7f7f7f7f, 0, 0x7f7f7f7f);
        if (d == 0) __builtin_amdgcn_sched_barrier(0); }
}
__device__ __forceinline__ void at_finishSM(f32x16& p0, f32x16& p1, float alpha, float& l_reg, v8i32& pa) {
#pragma unroll
    for (int r = 0; r < 16; ++r) p1[r] = __builtin_amdgcn_exp2f(p1[r]);
    f32x2 s2 = (f32x2){p0[0], p0[1]} + (f32x2){p1[0], p1[1]};
#pragma unroll
    for (int r = 2; r < 16; r += 2) { s2 += (f32x2){p0[r], p0[r + 1]}; s2 += (f32x2){p1[r], p1[r + 1]}; }
    float ps = s2.x + s2.y;
    { auto rr = __builtin_amdgcn_permlane32_swap(__float_as_uint(ps), __float_as_uint(ps), false, false); ps = __uint_as_float(rr[0]) + __uint_as_float(rr[1]); }
    l_reg = l_reg * alpha + ps;
#define PK4U(P, B, I) { int w_ = pa[I]; w_ = __builtin_amdgcn_cvt_pk_fp8_f32(P[B], P[B + 1], w_, false); w_ = __builtin_amdgcn_cvt_pk_fp8_f32(P[B + 2], P[B + 3], w_, true); pa[I] = w_; }
    PK4U(p0, 0, 0) PK4U(p0, 4, 1) PK4U(p0, 8, 2) PK4U(p0, 12, 3) PK4U(p1, 0, 4) PK4U(p1, 4, 5) PK4U(p1, 8, 6) PK4U(p1, 12, 7)
#undef PK4U
}
__device__ __forceinline__ void at_pv(f32x16 (&o)[4], const LAS unsigned char* Vs, const int vb0, const int vb1, const v8i32 pa) {
#pragma unroll
    for (int d0 = 0; d0 < 4; ++d0) {
        const u32x4 a0 = *(const LAS u32x4*)(Vs + vb0 + d0 * 2048), a1 = *(const LAS u32x4*)(Vs + vb1 + d0 * 2048);
        const v8i32 vf = (v8i32){(int)a0.x, (int)a0.y, (int)a0.z, (int)a0.w, (int)a1.x, (int)a1.y, (int)a1.z, (int)a1.w};
        o[d0] = __builtin_amdgcn_mfma_scale_f32_32x32x64_f8f6f4(pa, vf, o[d0], 0, 0, 0, 0x7f7f7f7f, 0, 0x7f7f7f7f); }
}
constexpr int AT_WT = 45056, WC_PITCH = 1040, WC_GU = 32 * 128, WC_ALL = WC_GU + 32 * 64;
static_assert(AT_WT + 64 * WC_PITCH <= MISC_OFF, "attention LDS map");
struct WConv { int i, ph, pend; };
__device__ __forceinline__ void wc_issue(LAS unsigned char* lds, const float* gu1, const float* dn1, const int u, const int wid, const int lane) {
    const bool dn = u >= WC_GU; const int v = dn ? u - WC_GU : u;
    const int mat = dn ? v >> 6 : v >> 7, tn = dn ? (v >> 4) & 3 : (v >> 4) & 7, tk = v & 15, N = dn ? 1024 : 2048;
    const __amdgpu_buffer_rsrc_t sw = __builtin_amdgcn_make_buffer_rsrc((void*)(dn ? dn1 : gu1), (short)0, 0x7ffffff0, 0x00020000);
    const unsigned so = (unsigned)((mat * 1024 + tk * 64 + wid * 8) * N + tn * 256) * 4u;
#pragma unroll
    for (int r = 0; r < 8; ++r) __builtin_amdgcn_raw_ptr_buffer_load_lds(sw, (LAS unsigned*)(lds + AT_WT + (wid * 8 + r) * WC_PITCH), 16, lane * 16, (int)(so + (unsigned)(r * N) * 4u), 0, 0);
}
__device__ __forceinline__ void wc_consume(LAS unsigned char* lds, unsigned char* ws, const int u) {
    int tz = threadIdx.x; asm volatile("" : "+v"(tz));
    const int nl = tz >> 1, kh = (tz & 1) * 32;
    const bool dn = u >= WC_GU; const int v = dn ? u - WC_GU : u;
    const int mat = dn ? v >> 6 : v >> 7, tn = dn ? (v >> 4) & 3 : (v >> 4) & 7, tk = v & 15;
    const size_t d0 = dn ? WS_WDN + ((size_t)(32 + mat) * 1024 + tn * 256) * 1024 + tk * 64 : WS_WGU + ((size_t)(32 + mat) * 2048 + tn * 256) * 1024 + tk * 64;
    LAS const float* tile = (LAS const float*)(lds + AT_WT);
    float w[32];
#pragma unroll
    for (int j = 0; j < 32; ++j) w[j] = tile[(kh + j) * 260 + nl] * 32.0f;
    unsigned char* d = ws + d0 + (size_t)nl * 1024 + kh;
#pragma unroll
    for (int q = 0; q < 2; ++q) { u32x4 o; o.x = pk4_fp8(w[q * 16 + 0], w[q * 16 + 1], w[q * 16 + 2], w[q * 16 + 3]); o.y = pk4_fp8(w[q * 16 + 4], w[q * 16 + 5], w[q * 16 + 6], w[q * 16 + 7]);
        o.z = pk4_fp8(w[q * 16 + 8], w[q * 16 + 9], w[q * 16 + 10], w[q * 16 + 11]); o.w = pk4_fp8(w[q * 16 + 12], w[q * 16 + 13], w[q * 16 + 14], w[q * 16 + 15]); *(u32x4*)(d + q * 16) = o; }
}
__device__ __forceinline__ void attn_unit(LAS unsigned char* lds, const __amdgpu_buffer_rsrc_t srd, const bf16_t* __restrict__ Qb, const float* __restrict__ csb, const float* __restrict__ qhn, const unsigned Koff, const unsigned Voff, bf16_t* __restrict__ Ob, const int qb, WConv& wc, const float* gu1, const float* dn1, unsigned char* ws) {
    const int tid = ltid(), wid = __builtin_amdgcn_readfirstlane(tid >> 6), lane = tid & 63, r32 = lane & 31, hi = lane >> 5;
    LAS unsigned char* V_lds = lds + AT_V0; LAS unsigned char* K_lds = lds + AT_K0;
    LAS float* wsf = (LAS float*)(lds + AT_WS) + wid * 64; LAS float* li_l = wsf; LAS float* al_l = wsf + 32;
    float m_reg = -1e30f, l_reg = 0; f32x16 o[4]; v8i32 q8[3];
    { const bf16_t* Qw = Qb + (size_t)(wid * 32 + r32) * (NH * QKD) + hi * 8;
      u32x4 qraw[12]; unsigned qd[24]; float ss = 0.f;
#pragma unroll
      for (int d0 = 0; d0 < 12; ++d0) qraw[d0] = *(const u32x4*)(Qw + d0 * 16);
      const float* csr = csb + (size_t)(wid * 32 + r32) * 64 + hi * 16;
#pragma unroll
      for (int d0 = 0; d0 < 12; ++d0) { const u32x4 w = qraw[d0];
          ss += bf_lo(w.x) * bf_lo(w.x) + bf_hi(w.x) * bf_hi(w.x) + bf_lo(w.y) * bf_lo(w.y) + bf_hi(w.y) * bf_hi(w.y) + bf_lo(w.z) * bf_lo(w.z) + bf_hi(w.z) * bf_hi(w.z) + bf_lo(w.w) * bf_lo(w.w) + bf_hi(w.w) * bf_hi(w.w); }
      ss += __shfl_xor(ss, 32);
      const float rstd = rsqrtf(ss * (1.0f / QKD) + EPS);
#define Q_UNPACK(dst, src_) { const u32x4 t_ = (src_); dst[0] = bf_lo(t_.x); dst[1] = bf_hi(t_.x); dst[2] = bf_lo(t_.y); dst[3] = bf_hi(t_.y); dst[4] = bf_lo(t_.z); dst[5] = bf_hi(t_.z); dst[6] = bf_lo(t_.w); dst[7] = bf_hi(t_.w); }
#define Q_PACK(d0, v) { qd[2 * (d0)] = pk4_fp8(v[0], v[1], v[2], v[3]); qd[2 * (d0) + 1] = pk4_fp8(v[4], v[5], v[6], v[7]); }
#pragma unroll
      for (int d0 = 0; d0 < 8; ++d0) { float v[8]; Q_UNPACK(v, qraw[d0]) const f32x4 g0 = ld4(qhn + d0 * 16 + hi * 8), g1 = ld4(qhn + d0 * 16 + hi * 8 + 4);
#pragma unroll
          for (int j = 0; j < 4; ++j) { v[j] *= rstd * g0[j]; v[4 + j] *= rstd * g1[j]; }
          Q_PACK(d0, v) if (d0 & 1) asm volatile("" ::: "memory"); }
#pragma unroll
      for (int dd = 0; dd < 2; ++dd) {
          float x1[8], x2[8]; Q_UNPACK(x1, qraw[8 + dd]) Q_UNPACK(x2, qraw[10 + dd])
          const f32x4 ga = ld4(qhn + (8 + dd) * 16 + hi * 8), gb = ld4(qhn + (8 + dd) * 16 + hi * 8 + 4), gc = ld4(qhn + (10 + dd) * 16 + hi * 8), gd = ld4(qhn + (10 + dd) * 16 + hi * 8 + 4);
#pragma unroll
          for (int j = 0; j < 8; ++j) { const float g1_ = j < 4 ? ga[j & 3] : gb[j & 3], g2_ = j < 4 ? gc[j & 3] : gd[j & 3];
              const float a = x1[j] * rstd * g1_, b = x2[j] * rstd * g2_;
              const f32x2 cv = *(const f32x2*)(csr + dd * 32 + j * 2); const float cs = cv.x, sn = cv.y;
              x1[j] = a * cs - b * sn; x2[j] = b * cs + a * sn; }
          Q_PACK(8 + dd, x1) Q_PACK(10 + dd, x2) asm volatile("" ::: "memory"); }
#undef Q_UNPACK
#undef Q_PACK
#pragma unroll
      for (int d = 0; d < 3; ++d) q8[d] = (v8i32){(int)qd[8 * d + 0], (int)qd[8 * d + 1], (int)qd[8 * d + 2], (int)qd[8 * d + 3], (int)qd[8 * d + 4], (int)qd[8 * d + 5], (int)qd[8 * d + 6], (int)qd[8 * d + 7]};
    }
    asm volatile("" ::: "memory");
#pragma unroll
    for (int d = 0; d < 4; ++d)
#pragma unroll
        for (int r = 0; r < 16; ++r) o[d][r] = 0.f;
    const int NT = 4 * qb + 4, vis = 4 * qb + (wid >> 1);
#define SDMA(k0, kbuf, vbuf) do { int lz_ = lane; asm volatile("" : "+v"(lz_)); unsigned kofs[2], vofs[2]; \
    _Pragma("unroll") for (int _i = 0; _i < 2; ++_i) { const int p = (_i * 8 + wid) * 64 + lz_, row = p / 12, ps = p - row * 12; kofs[_i] = (unsigned)(row * 192 + (((ps & ~3) | ((ps & 3) ^ ((row >> 2) & 3))) << 4)); } \
    { const int p = wid * 64 + lz_, dr = p >> 2, ps = p & 3; vofs[0] = (unsigned)(dr * 64 + ((ps ^ ((dr >> 2) & 3)) << 4)); vofs[1] = 0; } \
    __builtin_amdgcn_raw_ptr_buffer_load_lds(srd, (LAS unsigned*)(K_lds + (kbuf) * AT_KB + wid * 1024), 16, (int)kofs[0], (int)(Koff + (unsigned)(k0) * 192u), 0, 0); \
    if (wid < 4) __builtin_amdgcn_raw_ptr_buffer_load_lds(srd, (LAS unsigned*)(K_lds + (kbuf) * AT_KB + (8 + wid) * 1024), 16, (int)kofs[1], (int)(Koff + (unsigned)(k0) * 192u), 0, 0); \
    __builtin_amdgcn_raw_ptr_buffer_load_lds(srd, (LAS unsigned*)(V_lds + (vbuf) * AT_VB + wid * 1024), 16, (int)vofs[0], (int)(Voff + (unsigned)(k0) * 128u), 0, 0); } while (0)
#define RESC(a) do { if (__any((a) < 1.f)) { if (hi == 0) al_l[r32] = (a); asm volatile("s_waitcnt lgkmcnt(0)" ::: "memory"); \
    _Pragma("unroll") for (int d = 0; d < 4; ++d) _Pragma("unroll") for (int r = 0; r < 16; ++r) o[d][r] *= al_l[crow(r, hi)]; } } while (0)
    f32x16 p0, p1; float mn, al; v8i32 pa = (v8i32){0, 0, 0, 0, 0, 0, 0, 0};
    SDMA(0, 0, 0); asm volatile("s_waitcnt vmcnt(0)" ::: "memory"); __syncthreads();
    for (int j = 0; j < NT; ++j) {
        const int cur = j & 1;
        if (wc.ph == 3 && wc.pend >= 0) { wc_consume(lds, ws, wc.pend); wc.pend = -1; }
        SBAR();
        int lq_ = lane; asm volatile("" : "+v"(lq_));
        const int rq_ = lq_ & 31, hq_ = lq_ >> 5, kx = (rq_ >> 2) & 3, kb0 = rq_ * 192 + (((2 * hq_) ^ kx) << 4), kb1 = rq_ * 192 + (((2 * hq_ + 1) ^ kx) << 4);
        const int vb0 = rq_ * 64 + (((2 * hq_) ^ kx) << 4), vb1 = rq_ * 64 + (((2 * hq_ + 1) ^ kx) << 4);
        if (j <= vis) {
            at_qkt(p0, p1, K_lds + cur * AT_KB, q8, kb0, kb1, false); }
        if (j + 1 < NT) SDMA((j + 1) * 64, cur ^ 1, cur ^ 1);
        bool wiss = false;
        if (wc.ph == 0) { const int u = (int)blockIdx.x + (int)gridDim.x * wc.i; if (u < WC_ALL) { int lw_ = lane; asm volatile("" : "+v"(lw_)); wc_issue(lds, gu1, dn1, u, wid, lw_); wc.pend = u; ++wc.i; wiss = true; } }
        wc.ph = wc.ph == 4 ? 0 : wc.ph + 1;
        SBAR();
        if (j <= vis) {
            at_partialSM(p0, p1, m_reg, mn, al);
            RESC(al);
            at_finishSM(p0, p1, al, l_reg, pa); SBAR();
            at_pv(o, V_lds + cur * AT_VB, vb0, vb1, pa); }
        if (wiss) asm volatile("s_waitcnt vmcnt(8) lgkmcnt(0)" ::: "memory");
        else asm volatile("s_waitcnt vmcnt(0) lgkmcnt(0)" ::: "memory");
        __builtin_amdgcn_s_barrier();
        asm volatile("" ::: "memory");
    }
    if (hi == 0) li_l[r32] = l_reg; asm volatile("s_waitcnt lgkmcnt(0)" ::: "memory");
    { int tz = threadIdx.x; asm volatile("" : "+v"(tz));
      const int lz = tz & 63, rz = lz & 31, hz = lz >> 5; const unsigned loff = (unsigned)(hz * 4 * DM + rz) * 2u;
      const char* Ow = (const char*)(Ob + (size_t)(wid * 32) * DM);
#pragma unroll
      for (int r = 0; r < 16; ++r) { const int rb = (r & 3) + 8 * (r >> 2); const float rl = __builtin_amdgcn_rcpf(li_l[rb + 4 * hz]);
          const char* Or = Ow + (size_t)rb * DM * 2;
#pragma unroll
          for (int d0 = 0; d0 < 4; ++d0) { const unsigned w = cvt_pk_bf16(o[d0][r] * rl, 0.f); *(bf16_t*)(Or + loff + d0 * 64) = (bf16_t)(w & 0xffffu); } } }
    __syncthreads();
#undef SDMA
#undef RESC
}
__device__ __forceinline__ void attn_phase(LAS unsigned char* lds, const __amdgpu_buffer_rsrc_t srd, const bf16_t* __restrict__ qf, const float* __restrict__ cs, const float* __restrict__ qhn, bf16_t* __restrict__ O,
                                           const float* gu1, const float* dn1, unsigned char* ws) {
    WConv wc; wc.i = 0; wc.ph = (int)(blockIdx.x % 5u); wc.pend = -1;
    for (int u = blockIdx.x; u < 256; u += gridDim.x) {
        const int bh = 2 * (u & 7) + ((u >> 3) >> 4), pi = (u >> 3) & 15, b = bh >> 3, h = bh & 7;
        const unsigned Koff = (unsigned)(WS_K + (size_t)bh * SEQ * QKD), Voff = (unsigned)(WS_V + (size_t)bh * SEQ * VD);
#pragma unroll 1
        for (int half = 0; half < 2; ++half) {
            const int qb = half == 0 ? 31 - pi : pi; const size_t row0 = (size_t)b * SEQ + qb * 256;
            attn_unit(lds, srd, qf + row0 * (NH * QKD) + h * QKD, cs + row0 * 64, qhn, Koff, Voff, O + row0 * DM + h * VD, qb, wc, gu1, dn1, ws);
        }
    }
    asm volatile("s_waitcnt vmcnt(0)" ::: "memory"); __syncthreads();
    if (wc.pend >= 0) { wc_consume(lds, ws, wc.pend); wc.pend = -1; }
    for (;;) { const int u = (int)blockIdx.x + (int)gridDim.x * wc.i; if (u >= WC_ALL) break;
        __syncthreads();
        { const int tz = ltid(); wc_issue(lds, gu1, dn1, u, __builtin_amdgcn_readfirstlane(tz >> 6), tz & 63); }
        asm volatile("s_waitcnt vmcnt(0)" ::: "memory"); __syncthreads();
        wc_consume(lds, ws, u); ++wc.i; }
}

#ifndef PH_MASK
#define PH_MASK 0x7FFFF
#endif
typedef const __attribute__((address_space(4))) Params* ParamsK;
__device__ __forceinline__ ParamsK phase_params() { ParamsK q = (ParamsK)__builtin_amdgcn_kernarg_segment_ptr(); asm volatile("" : "+s"(q)); return q; }
#define PIN(i) (pq_->in[i])
#define WSP(T_, OFF) ((T_*)(pq_->ws + (OFF)))
#define WGU WSP(bf16_t, WS_WGU)
#define WDN WSP(bf16_t, WS_WDN)
#define WPG WSP(bf16_t, WS_WPG)
#define WPP WSP(bf16_t, WS_WPP)
#define WPOOL WSP(bf16_t, WS_WPOOL)
#define WIN WSP(bf16_t, WS_WIN)
#define WQB WSP(bf16_t, WS_WQB)
#define WKVB WSP(bf16_t, WS_WKVB)
#define WO WSP(bf16_t, WS_WO)
#define PB WSP(bf16_t, WS_PB)
#define PP WSP(bf16_t, WS_PP)
#define AB WSP(bf16_t, WS_AB)
#define X1 WSP(float, WS_X1)
#define X2 WSP(bf16_t, WS_X2)
#define X3 WSP(float, WS_X3)
#define HN WSP(bf16_t, WS_HN)
#define ACT WSP(bf16_t, WS_ACT)
#define SLOT WSP(bf16_t, WS_SLOT)
#define LIST WSP(int, WS_LIST)
#define GATE WSP(float, WS_GATE)
#define LAT WSP(float, WS_LAT)
#define QN WSP(bf16_t, WS_QN)
#define KVN WSP(bf16_t, WS_KVN)
#define QF WSP(bf16_t, WS_QF)
#define KVF WSP(bf16_t, WS_KVF)
#define QB WSP(bf16_t, WS_Q)
#define KB WSP(bf16_t, WS_K)
#define VB WSP(bf16_t, WS_V)
#define CTLW WSP(unsigned, WS_CTL)

__global__ void __launch_bounds__(NTHREADS, 2) mk_fwd(Params P) {
    extern __shared__ __attribute__((aligned(16))) unsigned char lds_raw[];
    LAS unsigned char* lds = (LAS unsigned char*)lds_raw;
    const int tid = threadIdx.x;
    const int lo = P.ph_lo, hi = P.ph_hi;
    const bool multi = (hi - lo) > 1;
    if (tid == 0) { *(volatile LAS unsigned*)(lds + BARW_OFF) = 0u; *(volatile LAS unsigned*)(lds + BARW_OFF + 4) = 0u; }
    __syncthreads();
    XcdBarrier bar; bar.bar = (unsigned*)(P.ws + WS_CTL); bar.x = 0; bar.st = (volatile LAS unsigned*)(lds + BARW_OFF);
    if (multi) bar = xcd_barrier_post((unsigned*)(P.ws + WS_CTL), (volatile LAS unsigned*)(lds + BARW_OFF));
#define IN(k) ((((PH_MASK) >> (k)) & 1) && lo <= (k) && (k) < hi)
#define SEAM(k) do { if (IN(k) && IN((k) + 1)) xcd_barrier(bar); } while (0)
#define SRD_WS __builtin_amdgcn_make_buffer_rsrc((void*)pq_->ws, (short)0, 0x7ffffff0, 0x00020000)
#define PHASE(k, ...) if (IN(k)) { ParamsK pq_ = phase_params(); __VA_ARGS__ }

    PHASE(0,
        int rot = 0;
        transpose_seg_f8<2048, 1024>(lds, PIN(I_W_GU), WSP(unsigned char, WS_WGU), 32, rot);
        transpose_seg_f8<1024, 1024>(lds, PIN(I_W_DN), WSP(unsigned char, WS_WDN), 32, rot);
        transpose_seg_f8<1024, 1024>(lds, PIN(I_PLE_GATE_W), WSP(unsigned char, WS_WPG), 1, rot, PIN(I_PLE_NORM));
        transpose_seg_f8<1024, 1024>(lds, PIN(I_PLE_GATE_W) + (size_t)1024 * 1024, WSP(unsigned char, WS_WPG) + (size_t)1024 * 1024, 1, rot, PIN(I_PLE_NORM) + DM);
        transpose_seg<1024, 256>(lds, PIN(I_PLE_PROJ_W), WPP, 2, rot);
        transpose_seg<256, 256>(lds, PIN(I_POOL_W), WPOOL, 4, rot);
        transpose_seg<704, 1024>(lds, PIN(I_W_IN), WIN, 1, rot, PIN(I_NORM_MIX) + DM);
        transpose_seg<1536, 384>(lds, PIN(I_W_QB), WQB, 1, rot, PIN(I_Q_NORM));
        transpose_seg<2048, 256>(lds, PIN(I_W_KVB), WKVB, 1, rot, PIN(I_KV_NORM));
        transpose_seg<1024, 1024>(lds, PIN(I_W_O), WO, 1, rot);
        cvt_p_phase(PIN(I_P), PB);
        rope_table_phase((const int*)PIN(I_POS), WSP(float, WS_CS));
        wrg_phase(PIN(I_NORM_FFN), PIN(I_ROUTER_W), WSP(float, WS_WRG));
        pool_diff_phase(lds, PIN(I_X), PIN(I_NORM_MIX), AB);)
    SEAM(0);
    PHASE(1,
        { ProvDense<EpiPool> Pv; Pv.init(ltid(), WS_AB, DM * 2, WS_WPOOL, 256, 4, 256, 512, EpiPool{PIN(I_X), PIN(I_POOL_SCALE), X1, 0, 0}); gemm_stream(lds, SRD_WS, Pv); }
        )
    SEAM(1);
#define ROUTE_CALL(L, XIN) route_phase<(L) == 1>(lds, XIN, PIN(I_NORM_FFN) + (L) * DM, WSP(float, WS_WRG) + (size_t)(L) * DM * NE, PIN(I_ROUTER_B) + (L) * NE, HN, CTLW + CW_GCNT + (L) * 32 * 64, LIST, GATE)
#define MOE_PLE_LAYER(L, PH, XIN, XOUT) \
    if (IN(PH)) { ParamsK pq_ = phase_params(); ROUTE_CALL(L, XIN); } \
    SEAM(PH); \
    PHASE((PH) + 1, moe_setup(lds, CTLW + CW_GCNT + (L) * 32 * 64); \
        moe_gemm1_phase(lds, SRD_WS, (unsigned)WS_HN, (unsigned)(WS_WGU + (size_t)(L) * 32 * 2048 * DM), PIN(I_B_GU) + (size_t)(L) * 32 * 2048, LIST, WSP(unsigned char, WS_ACT));) \
    SEAM((PH) + 1); \
    PHASE((PH) + 2, moe_setup(lds, CTLW + CW_GCNT + (L) * 32 * 64); \
        moe_gemm2_phase(lds, SRD_WS, (unsigned)WS_ACT, (unsigned)(WS_WDN + (size_t)(L) * 32 * 1024 * DFF), PIN(I_B_DN) + (size_t)(L) * 32 * DM, LIST, GATE, SLOT, (L), PP + (size_t)(L) * T * DM);) \
    SEAM((PH) + 2); \
    PHASE((PH) + 3, combine_phase<(L) == 1>(XIN, SLOT, X2, WSP(unsigned char, WS_AB), WSP(float, WS_QN));) \
    SEAM((PH) + 3); \
    PHASE((PH) + 4, ProvDense<EpiPle<(L) == 0> > Pv; Pv.init(ltid(), WS_AB, DM, WS_WPG + (size_t)(L) * 1024 * DM, DM / 2  , 4, 256, 0, EpiPle<(L) == 0>{X2, WSP(float, WS_QN), PP + (size_t)(L) * T * DM, XOUT, HN, WSP(float, WS_STAT), 0, 0}); gemm_stream_f8(lds, SRD_WS, Pv);)

    MOE_PLE_LAYER(0, 2, X1, X3)
    SEAM(6);
    PHASE(8, ProvDense<EpiLat> Pv; Pv.init(ltid(), WS_HN, DM * 2, WS_WIN, DM, 3, 192, 0, EpiLat{WSP(float, WS_STAT), WSP(bf16_t, WS_LAT), WSP(float, WS_STAT) + (size_t)T * 16, WSP(float, WS_STAT) + (size_t)T * 32, 0, 0}); gemm_stream(lds, SRD_WS, Pv);)
    SEAM(8);
    PHASE(10,
        { ProvDense<EpiBf16S> Pv; Pv.init(ltid(), WS_LAT, LATP * 2, WS_WQB, QL, 6, 384, 0, EpiBf16S{QF, NH * QKD, WSP(float, WS_STAT) + (size_t)T * 16, 3, 1.0f / QL, 0, 0}); gemm_stream(lds, SRD_WS, Pv); }
        { ProvDense<EpiKV> Pv; Pv.init(ltid(), WS_LAT + QL * 2, LATP * 2, WS_WKVB, KVL, 8, 512, 0, EpiKV{KVF, WSP(float, WS_STAT) + (size_t)T * 32, pq_->ws + WS_V, 0, 0}); gemm_stream(lds, SRD_WS, Pv); })
    SEAM(10);
    PHASE(11, k_finalize_phase(KVF, WSP(bf16_t, WS_LAT), WSP(float, WS_CS), PIN(I_KH_NORM), KB);)
    SEAM(11);
    PHASE(12, attn_phase(lds, SRD_WS, QF, WSP(float, WS_CS), PIN(I_QH_NORM), AB, PIN(I_W_GU) + (size_t)32 * 1024 * 2048, PIN(I_W_DN) + (size_t)32 * 1024 * 1024, pq_->ws);)
    SEAM(12);
    PHASE(13, ProvDense<EpiRes> Pv; Pv.init(ltid(), WS_AB, DM * 2, WS_WO, DM, 4, 256, 0, EpiRes{HN, (bf16_t*)X1, 0, 0}); gemm_stream(lds, SRD_WS, Pv);)
    SEAM(13);
    MOE_PLE_LAYER(1, 14, X1, pq_->out)
#undef IN
#undef SEAM
}

extern "C" void kernel_launch(void* const* d_in, const int* in_sizes, int n_in, void* d_out, int out_size, void* d_ws, size_t ws_size, hipStream_t stream) {
    static int grid = 0;
    if (grid == 0) {
        if (n_in != N_IN || out_size != T * DM || ws_size < WS_END) { fprintf(stderr, "kernel_launch: shape/workspace mismatch (n_in %d out %d ws %zu need %zu)\n", n_in, out_size, ws_size, (size_t)WS_END); grid = -1; return; }
        int dev = 0, cus = 0, per_cu = 0;
        if (hipGetDevice(&dev) != hipSuccess || hipDeviceGetAttribute(&cus, hipDeviceAttributeMultiprocessorCount, dev) != hipSuccess) { grid = -1; return; }
        if (hipFuncSetAttribute((const void*)mk_fwd, hipFuncAttributeMaxDynamicSharedMemorySize, LDS_BYTES) != hipSuccess) { fprintf(stderr, "kernel_launch: hipFuncSetAttribute failed\n"); grid = -1; return; }
        if (hipOccupancyMaxActiveBlocksPerMultiprocessor(&per_cu, (const void*)mk_fwd, NTHREADS, LDS_BYTES) != hipSuccess || per_cu < 1) { fprintf(stderr, "kernel_launch: occupancy query says %d\n", per_cu); (void)hipGetLastError(); grid = -1; return; }
        grid = cus;
    }
    if (grid < 0) return;
    (void)in_sizes;
    hipMemsetAsync((char*)d_ws + WS_CTL, 0, CTL_BYTES, stream);
    Params p{};
    for (int i = 0; i < N_IN; ++i) p.in[i] = (const float*)d_in[i];
    p.out = (float*)d_out; p.ws = (unsigned char*)d_ws;
#if MK_MULTI
    for (int ph = 0; ph < NPHASE; ++ph) { p.ph_lo = ph; p.ph_hi = ph + 1; hipLaunchKernelGGL(mk_fwd, dim3(grid), dim3(NTHREADS), LDS_BYTES, stream, p); }
#else
    p.ph_lo = 0; p.ph_hi = NPHASE; hipLaunchKernelGGL(mk_fwd, dim3(grid), dim3(NTHREADS), LDS_BYTES, stream, p);
#endif
}
```

```cpp
#include <hip/hip_runtime.h>
#include <cstdio>
#include <cstdint>

#ifndef MK_MULTI
#define MK_MULTI 0
#endif

#define LAS __attribute__((address_space(3)))
typedef unsigned short bf16_t;
typedef short bf16x8 __attribute__((ext_vector_type(8)));
typedef short s16x4 __attribute__((ext_vector_type(4)));
typedef float f32x2 __attribute__((ext_vector_type(2)));
typedef float f32x4 __attribute__((ext_vector_type(4)));
typedef float f32x16 __attribute__((ext_vector_type(16)));
typedef unsigned u32x2 __attribute__((ext_vector_type(2)));
typedef unsigned u32x4 __attribute__((ext_vector_type(4)));

constexpr int T = 16384, DM = 1024, SEQ = 8192, NE = 32, DFF = 1024, PLE = 256;
constexpr int NPAIR = T * 4;
constexpr int QL = 384, KVL = 256, NH = 8, QKD = 192, VD = 128, LATP = 768;
constexpr float EPS = 1e-6f;
constexpr int NTHREADS = 512;
constexpr int LDS_BYTES = 147456;
constexpr int MISC_OFF = 131072;
constexpr int BARW_OFF = LDS_BYTES - 16;
constexpr int NPHASE = 19;

enum { I_X = 0, I_P, I_POS, I_NORM_MIX, I_POOL_W, I_POOL_SCALE, I_W_IN, I_Q_NORM, I_W_QB, I_KV_NORM, I_W_KVB, I_QH_NORM, I_KH_NORM, I_W_O,
       I_NORM_FFN, I_ROUTER_W, I_ROUTER_B, I_W_GU, I_B_GU, I_W_DN, I_B_DN, I_PLE_NORM, I_PLE_GATE_W, I_PLE_PROJ_W, N_IN };

constexpr size_t al256(size_t x) { return (x + 255) & ~(size_t)255; }
constexpr size_t CTL_BYTES = 65536;
constexpr size_t WS_CTL  = 0;
constexpr size_t WS_WGU  = WS_CTL + CTL_BYTES;
constexpr size_t WS_WDN  = WS_WGU + (size_t)2 * 32 * 2048 * 1024 * 2;
constexpr size_t WS_WPG  = WS_WDN + (size_t)2 * 32 * 1024 * 1024 * 2;
constexpr size_t WS_WPP  = WS_WPG + (size_t)2 * 1024 * 1024 * 2;
constexpr size_t WS_WPOOL= WS_WPP + (size_t)2 * 1024 * 256 * 2;
constexpr size_t WS_WIN  = WS_WPOOL + (size_t)4 * 256 * 256 * 2;
constexpr size_t WS_WQB  = WS_WIN + (size_t)768 * 1024 * 2;
constexpr size_t WS_WKVB = WS_WQB + (size_t)1536 * 384 * 2;
constexpr size_t WS_WO   = WS_WKVB + (size_t)2048 * 256 * 2;
constexpr size_t WS_PB   = WS_WO + (size_t)1024 * 1024 * 2;
constexpr size_t WS_PP   = WS_PB + (size_t)2 * T * 256 * 2;
constexpr size_t WS_AB   = WS_PP + (size_t)2 * T * 1024 * 2;
constexpr size_t WS_X1   = WS_AB + (size_t)T * 1024 * 2;
constexpr size_t WS_X2   = WS_X1 + (size_t)T * 1024 * 4;
constexpr size_t WS_X3   = WS_X2 + (size_t)T * 1024 * 4;
constexpr size_t WS_HN   = WS_X3 + (size_t)T * 1024 * 4;
constexpr size_t WS_ACT  = WS_HN + (size_t)T * 1024 * 2;
constexpr size_t WS_SLOT = WS_ACT + (size_t)(NPAIR + 256) * 1024 * 2;
constexpr size_t WS_LIST = WS_SLOT + (size_t)NPAIR * 1024 * 2;
constexpr size_t WS_GATE = WS_LIST + (size_t)32 * T * 4;
constexpr size_t WS_LAT  = WS_GATE + (size_t)NPAIR * 4;
constexpr size_t WS_QN   = WS_LAT + (size_t)T * 768 * 4;
constexpr size_t WS_KVN  = WS_QN + (size_t)T * 384 * 2;
constexpr size_t WS_QF   = WS_KVN + (size_t)T * 256 * 2;
constexpr size_t WS_KVF  = WS_QF + (size_t)T * 1536 * 2;
constexpr size_t WS_Q    = WS_KVF + (size_t)T * 2048 * 2;
constexpr size_t WS_K    = WS_Q + (size_t)T * 8 * 192 * 2;
constexpr size_t WS_V    = WS_K + (size_t)T * 8 * 192 * 2;
constexpr size_t WS_WRG  = WS_V + (size_t)T * 8 * 128 * 2;
constexpr size_t WS_STAT = WS_WRG + (size_t)2 * 1024 * 32 * 4;
constexpr size_t WS_CS   = WS_STAT + (size_t)3 * T * 16 * 4;
constexpr size_t WS_END  = WS_CS + (size_t)T * 32 * 2 * 4;
constexpr int CW_GCNT = 4096;

struct Params { const float* in[N_IN]; float* out; unsigned char* ws; int ph_lo, ph_hi; };

__device__ __forceinline__ unsigned cvt_pk_bf16(float lo, float hi) { unsigned r; asm volatile("v_cvt_pk_bf16_f32 %0, %1, %2" : "=v"(r) : "v"(lo), "v"(hi)); return r; }
__device__ __forceinline__ float bf_lo(unsigned w) { return __uint_as_float(w << 16); }
__device__ __forceinline__ float bf_hi(unsigned w) { return __uint_as_float(w & 0xffff0000u); }
__device__ __forceinline__ float wave_sum(float v) {
#pragma unroll
    for (int o = 32; o > 0; o >>= 1) v += __shfl_xor(v, o);
    return v;
}
__device__ __forceinline__ int ltid() { int t = threadIdx.x; asm volatile("" : "+v"(t)); return t; }
__device__ __forceinline__ f32x4 ld4(const float* p) { return *(const f32x4*)p; }
__device__ __forceinline__ f32x4 ld4bf(const bf16_t* p) { const u32x2 w = *(const u32x2*)p; return (f32x4){bf_lo(w.x), bf_hi(w.x), bf_lo(w.y), bf_hi(w.y)}; }
__device__ __forceinline__ void st4bf(bf16_t* p, f32x4 v) { u32x2 w; w.x = cvt_pk_bf16(v[0], v[1]); w.y = cvt_pk_bf16(v[2], v[3]); *(u32x2*)p = w; }
__device__ __forceinline__ f32x4 dpp_ror8(const f32x4 v) { f32x4 r;
#pragma unroll
    for (int j = 0; j < 4; ++j) r[j] = __uint_as_float((unsigned)__builtin_amdgcn_update_dpp(0, (int)__float_as_uint(v[j]), 0x128, 0xf, 0xf, false));
    return r; }
__device__ __forceinline__ f32x4 sel4(const bool c, const f32x4 a, const f32x4 b) { f32x4 r;
#pragma unroll
    for (int j = 0; j < 4; ++j) r[j] = c ? a[j] : b[j];
    return r; }
__device__ __forceinline__ void ld_rows8_f32(const float* blk16, const size_t ld, const int fr, const int fq, f32x4& x0, f32x4& x1) {
    const bool hi8 = fr >= 8; const float* p = blk16 + (size_t)(fr & 7) * ld + (hi8 ? 16 : 0) + fq * 4;
    const f32x4 L1 = ld4(p), L2 = ld4(p + 8 * ld);
    const f32x4 rv = dpp_ror8(sel4(hi8, L1, L2));
    x0 = sel4(hi8, rv, L1); x1 = sel4(hi8, L2, rv);
}
__device__ __forceinline__ void st_rows8_f32(float* blk16, const size_t ld, const int fr, const int fq, const f32x4 v0, const f32x4 v1) {
    const bool hi8 = fr >= 8; float* p = blk16 + (size_t)(fr & 7) * ld + (hi8 ? 16 : 0) + fq * 4;
    const f32x4 rv = dpp_ror8(sel4(hi8, v0, v1));
    *(f32x4*)p = sel4(hi8, rv, v0); *(f32x4*)(p + 8 * ld) = sel4(hi8, v1, rv);
}
__device__ __forceinline__ void ld_pair_bf16(const bf16_t* blk, const int fq, u32x2& w0, u32x2& w1) {
    const u32x4 w = *(const u32x4*)(blk + (fq & 1) * 16 + (fq >> 1) * 8);
    const auto sx = __builtin_amdgcn_permlane16_swap(w.x, w.z, false, false); const auto sy = __builtin_amdgcn_permlane16_swap(w.y, w.w, false, false);
    w0.x = sx[0]; w0.y = sy[0]; w1.x = sx[1]; w1.y = sy[1];
}
__device__ __forceinline__ void st_pair_bf16(bf16_t* blk, const f32x4 v0, const f32x4 v1, const int fq) {
    const auto sx = __builtin_amdgcn_permlane16_swap(cvt_pk_bf16(v0[0], v0[1]), cvt_pk_bf16(v1[0], v1[1]), false, false);
    const auto sy = __builtin_amdgcn_permlane16_swap(cvt_pk_bf16(v0[2], v0[3]), cvt_pk_bf16(v1[2], v1[3]), false, false);
    u32x4 w; w.x = sx[0]; w.y = sy[0]; w.z = sx[1]; w.w = sy[1];
    *(u32x4*)(blk + (fq & 1) * 16 + (fq >> 1) * 8) = w;
}
__device__ __forceinline__ unsigned pk4_fp8(float a, float b, float c, float d) { int w = __builtin_amdgcn_cvt_pk_fp8_f32(a, b, 0, false); w = __builtin_amdgcn_cvt_pk_fp8_f32(c, d, w, true); return (unsigned)w; }
__device__ __forceinline__ void st_pair_fp8(unsigned char* blk, f32x4 v0, f32x4 v1, const int fq, const float sc) {
#pragma unroll
    for (int j = 0; j < 4; ++j) { v0[j] = __builtin_amdgcn_fmed3f(v0[j] * sc, -440.0f, 440.0f); v1[j] = __builtin_amdgcn_fmed3f(v1[j] * sc, -440.0f, 440.0f); }
    const auto sw = __builtin_amdgcn_permlane16_swap(pk4_fp8(v0[0], v0[1], v0[2], v0[3]), pk4_fp8(v1[0], v1[1], v1[2], v1[3]), false, false);
    u32x2 w; w.x = sw[0]; w.y = sw[1];
    *(u32x2*)(blk + (fq & 1) * 16 + (fq >> 1) * 8) = w;
}
__device__ __forceinline__ void ld_pair_fp8(const unsigned char* blk, const int fq, f32x4& v0, f32x4& v1) {
    const u32x2 w = *(const u32x2*)(blk + (fq & 1) * 16 + (fq >> 1) * 8);
    const auto sw = __builtin_amdgcn_permlane16_swap(w.x, w.y, false, false);
    const f32x2 a0 = __builtin_amdgcn_cvt_pk_f32_fp8((int)sw[0], false), a1 = __builtin_amdgcn_cvt_pk_f32_fp8((int)sw[0], true), b0 = __builtin_amdgcn_cvt_pk_f32_fp8((int)sw[1], false), b1 = __builtin_amdgcn_cvt_pk_f32_fp8((int)sw[1], true);
    v0 = (f32x4){a0.x, a0.y, a1.x, a1.y}; v1 = (f32x4){b0.x, b0.y, b1.x, b1.y};
}
__device__ __forceinline__ float sigmoidf_(float z) { return __builtin_amdgcn_rcpf(1.0f + __builtin_amdgcn_exp2f(-1.4426950408889634f * z)); }

#define XB_TMO      128
#define XB_XCNT(j)  (256  + 64 * (j))
#define XB_XSUB(j)  (1280 + 64 * (j))
#define XB_XGEN(j)  (2304 + 64 * (j))
#define XB_TOP      3328
#define XB_TOPGEN   3392
#define XCD_BAR_WORDS 3456
#define XB_SPIN_CAP (1u << 24)
__device__ __forceinline__ unsigned xb_ld(unsigned* p)              { return __hip_atomic_load(p, __ATOMIC_RELAXED, __HIP_MEMORY_SCOPE_AGENT); }
__device__ __forceinline__ unsigned xb_add(unsigned* p, unsigned v) { return __hip_atomic_fetch_add(p, v, __ATOMIC_RELAXED, __HIP_MEMORY_SCOPE_AGENT); }
__device__ __forceinline__ unsigned xb_xcc_id() { return (unsigned)__builtin_amdgcn_s_getreg((3 << 11) | 20) & 0xFu; }
#define XB_SPIN(cond, bar) do { unsigned _sp = 0; while (cond) { __builtin_amdgcn_s_sleep(1); \
    if ((++_sp & 255u) == 0u) { if (xb_ld(&(bar)[XB_TMO])) break; if (_sp > XB_SPIN_CAP) { atomicAdd(&(bar)[XB_TMO], 1u); break; } } } } while (0)
struct XcdBarrier { unsigned* bar; unsigned x; volatile LAS unsigned* st; };
__device__ __forceinline__ XcdBarrier xcd_barrier_post(unsigned* bar, volatile LAS unsigned* st) {
    XcdBarrier b; b.bar = bar; b.x = xb_xcc_id(); b.st = st;
    if (threadIdx.x == 0) (void)xb_add(&bar[XB_XCNT(b.x)], 1u);
    return b;
}
__device__ __forceinline__ void xcd_barrier_complete(unsigned* bar, unsigned x, unsigned& nloc, unsigned& nx) {
    const unsigned G = gridDim.x * gridDim.y * gridDim.z;
    unsigned sum, cnt, mine, sp = 0u;
    for (;;) {
        sum = 0u; cnt = 0u; mine = 0u;
#pragma unroll
        for (unsigned j = 0; j < 16; ++j) { const unsigned c = xb_ld(&bar[XB_XCNT(j)]); sum += c; cnt += (c > 0u) ? 1u : 0u; mine = (j == x) ? c : mine; }
        if (sum == G) break;
        __builtin_amdgcn_s_sleep(1);
        if ((++sp & 255u) == 0u) { if (xb_ld(&bar[XB_TMO])) break; if (sp > XB_SPIN_CAP) { atomicAdd(&bar[XB_TMO], 1u); break; } }
    }
    nloc = mine > 0u ? mine : 1u; nx = cnt > 0u ? cnt : 1u;
}
__device__ __forceinline__ void xcd_barrier(const XcdBarrier& b) {
    asm volatile("s_waitcnt vmcnt(0)" ::: "memory");
    __syncthreads();
    if (threadIdx.x == 0) {
        unsigned* bar = b.bar;
        __builtin_amdgcn_s_waitcnt(0);
        unsigned nloc = b.st[0], nx = b.st[1];
        if (nloc == 0u) { xcd_barrier_complete(bar, b.x, nloc, nx); b.st[0] = nloc; b.st[1] = nx; }
        const unsigned old = xb_add(&bar[XB_XSUB(b.x)], 1u);
        const unsigned gen = old / nloc;
        if (old + 1u == (gen + 1u) * nloc) {
            __builtin_amdgcn_fence(__ATOMIC_RELEASE, "agent");
            asm volatile("s_waitcnt vmcnt(0)" ::: "memory");
            const unsigned og = xb_add(&bar[XB_TOP], 1u);
            const unsigned tg = og / nx;
            if (og + 1u == (tg + 1u) * nx) xb_add(&bar[XB_TOPGEN], 1u);
            else XB_SPIN(xb_ld(&bar[XB_TOPGEN]) == tg, bar);
            __builtin_amdgcn_fence(__ATOMIC_ACQUIRE, "agent");
            xb_add(&bar[XB_XGEN(b.x)], 1u);
            asm volatile("s_waitcnt vmcnt(0)" ::: "memory");
        } else {
            XB_SPIN(xb_ld(&bar[XB_XGEN(b.x)]) == gen, bar);
            __builtin_amdgcn_fence(__ATOMIC_ACQUIRE, "agent");
            asm volatile("s_waitcnt vmcnt(0)" ::: "memory");
        }
    }
    __syncthreads();
}

constexpr int HTB = 16384;
__device__ __forceinline__ int lds_byte(int r, int c) { const int st = (r >> 4) * 2 + (c >> 5), rr = r & 15, cc = c & 31, ob = rr * 64 + cc * 2; return st * 1024 + (ob ^ (((ob >> 9) & 1) << 5)); }
__device__ __forceinline__ void stage_rc(int b, int& R, int& C) { const int st = b / 1024, sb = b % 1024, swz = sb ^ (((sb >> 9) & 1) << 5); R = (st >> 1) * 16 + swz / 64; C = (st & 1) * 32 + (swz % 64) / 2; }
#define SA_(b, h) (((b) * 2 + (h)) * HTB)
#define SB_(b, h) ((4 + (b) * 2 + (h)) * HTB)
#define G_STAGE(bufoff, sbase, voff) do { _Pragma("unroll") for (int _i = 0; _i < 2; ++_i) \
    __builtin_amdgcn_raw_ptr_buffer_load_lds(srd, (LAS unsigned*)(lds + (bufoff) + ldsw + _i * 8192), 16, (int)(voff)[_i], (int)(sbase), 0, 0); } while (0)
#define G_LDA(dst, b, h) do { _Pragma("unroll") for (int m = 0; m < 4; ++m) _Pragma("unroll") for (int k = 0; k < 2; ++k) dst[m][k] = *(const LAS bf16x8*)(lds + SA_(b, h) + aoff + m * 2048 + k * 1024); } while (0)
#define G_LDB(dst, b, h) do { _Pragma("unroll") for (int n = 0; n < 2; ++n) _Pragma("unroll") for (int k = 0; k < 2; ++k) dst[n][k] = *(const LAS bf16x8*)(lds + SB_(b, h) + boff + n * 2048 + k * 1024); } while (0)
#define G_MMA(ai, bj, At, Bt) do { __builtin_amdgcn_s_setprio(1); _Pragma("unroll") for (int m = 0; m < 4; ++m) _Pragma("unroll") for (int n = 0; n < 2; ++n) _Pragma("unroll") for (int k = 0; k < 2; ++k) \
    acc[ai][bj][m][n] = __builtin_amdgcn_mfma_f32_16x16x32_bf16(Bt[n][k], At[m][k], acc[ai][bj][m][n], 0, 0, 0); __builtin_amdgcn_s_setprio(0); } while (0)
#define G_MMA_Z(ai, bj, At, Bt) do { __builtin_amdgcn_s_setprio(1); _Pragma("unroll") for (int m = 0; m < 4; ++m) _Pragma("unroll") for (int n = 0; n < 2; ++n) \
    asm volatile("v_mfma_f32_16x16x32_bf16 %0, %1, %2, 0" : "+v"(acc[ai][bj][m][n]) : "v"(Bt[n][0]), "v"(At[m][0])); \
    _Pragma("unroll") for (int m = 0; m < 4; ++m) _Pragma("unroll") for (int n = 0; n < 2; ++n) acc[ai][bj][m][n] = __builtin_amdgcn_mfma_f32_16x16x32_bf16(Bt[n][1], At[m][1], acc[ai][bj][m][n], 0, 0, 0); \
    __builtin_amdgcn_s_setprio(0); } while (0)
#define G_MMX(FIRST, ai, bj, At, Bt) do { if (FIRST) G_MMA_Z(ai, bj, At, Bt); else G_MMA(ai, bj, At, Bt); } while (0)
#define WAIT_V(n) asm volatile("s_waitcnt vmcnt(" #n ")" ::: "memory")
#define WAIT_L(n) asm volatile("s_waitcnt lgkmcnt(" #n ")" ::: "memory")
#define BAR __builtin_amdgcn_s_barrier()
#define SCHED __builtin_amdgcn_sched_barrier(0)

__device__ __forceinline__ void stage_coords(int tid, int (&R)[2], int (&C)[2]) { stage_rc(tid * 16, R[0], C[0]); stage_rc(tid * 16 + 8192, R[1], C[1]); }

template <class Prov>
__device__ __forceinline__ void gemm_stream(LAS unsigned char* lds, const __amdgpu_buffer_rsrc_t srd, const Prov& P) {
    const int tid = ltid(), wid = __builtin_amdgcn_readfirstlane(tid >> 6), lane = tid & 63, wr = wid >> 2, wc = wid & 3, fr = lane & 15, fq = lane >> 4;
    const unsigned ldsw = (unsigned)wid * 1024u;
    const int aoff = lds_byte(wr * 64 + fr, fq * 8), boff = lds_byte(wc * 32 + fr, fq * 8);
    typename Prov::Unit cur, nxt;
    if (!P.next(0, cur)) return;
    unsigned oA[2][2]; P.offs(cur, oA);
    const unsigned oB[2] = {P.offB[0], P.offB[1]};
    const int nt = P.nt;
    f32x4 acc[2][2][4][2];
    bf16x8 At[4][2], B0[2][2], B1[2][2];
    unsigned cA = cur.A, cB0 = cur.B0, cB1 = cur.B1;
    G_STAGE(SB_(0, 0), cB0, oB); G_STAGE(SA_(0, 0), cA, oA[0]); G_STAGE(SB_(0, 1), cB1, oB); G_STAGE(SA_(0, 1), cA, oA[1]);
    if (wr == 1) BAR;
    WAIT_V(4); BAR;
    G_STAGE(SB_(1, 0), cB0 + 128, oB); G_STAGE(SA_(1, 0), cA + 128, oA[0]); G_STAGE(SB_(1, 1), cB1 + 128, oB);
    WAIT_V(6); BAR;
    int ui = 0;
    for (;;) {
        const bool has_next = P.next(ui + 1, nxt);
        const unsigned nA = has_next ? nxt.A : cA, nB0 = has_next ? nxt.B0 : cB0, nB1 = has_next ? nxt.B1 : cB1;
        for (int t = 0; t < nt; t += 2) {
            const bool last = (t == nt - 2), first = (t == 0);
            const unsigned a1 = cA + (t + 1) * 128;
            G_LDB(B0, 0, 0); SCHED; G_LDA(At, 0, 0); G_STAGE(SA_(1, 1), a1, oA[1]);
            WAIT_L(8); BAR; WAIT_L(0); G_MMX(first, 0, 0, At, B0); BAR; SCHED;
            if (last && has_next) P.offs(nxt, oA);
            const unsigned a2 = last ? nA : cA + (t + 2) * 128, p0 = last ? nB0 : cB0 + (t + 2) * 128, p1 = last ? nB1 : cB1 + (t + 2) * 128;
            G_LDB(B1, 0, 1); G_STAGE(SB_(0, 0), p0, oB);
            BAR; WAIT_L(0); G_MMX(first, 0, 1, At, B1); BAR;
            G_LDA(At, 0, 1); G_STAGE(SA_(0, 0), a2, oA[0]);
            BAR; WAIT_L(0); G_MMX(first, 1, 0, At, B0); BAR; SCHED;
            G_STAGE(SB_(0, 1), p1, oB);
            WAIT_V(6); BAR; G_MMX(first, 1, 1, At, B1); BAR;
            G_LDB(B0, 1, 0); SCHED; G_LDA(At, 1, 0); G_STAGE(SA_(0, 1), a2, oA[1]);
            WAIT_L(8); BAR; WAIT_L(0); G_MMA(0, 0, At, B0); BAR; SCHED;
            G_LDB(B1, 1, 1); G_STAGE(SB_(1, 0), p0 + 128, oB);
            BAR; WAIT_L(0); G_MMA(0, 1, At, B1); BAR;
            G_LDA(At, 1, 1); G_STAGE(SA_(1, 0), a2 + 128, oA[0]);
            BAR; WAIT_L(0); G_MMA(1, 0, At, B0); BAR; SCHED;
            G_STAGE(SB_(1, 1), p1 + 128, oB);
            WAIT_V(6); BAR; G_MMA(1, 1, At, B1); BAR;
        }
        { int tz = threadIdx.x; asm volatile("" : "+v"(tz)); const int wz = __builtin_amdgcn_readfirstlane(tz >> 6), lz = tz & 63; P.epi(acc, cur, wz >> 2, wz & 3, lz & 15, lz >> 4); }
        if (!has_next) break;
        cur = nxt; cA = nA; cB0 = nB0; cB1 = nB1; ++ui;
    }
    WAIT_V(0);
    if (wr == 0) BAR;
    BAR;
    __syncthreads();
}

typedef int v8i32 __attribute__((ext_vector_type(8)));
#define F8_LDA(dst, b, h) do { _Pragma("unroll") for (int m = 0; m < 4; ++m) { const u32x4 _lo = *(const LAS u32x4*)(lds + SA_(b, h) + aoff + m * 2048), _hi = *(const LAS u32x4*)(lds + SA_(b, h) + aoff + m * 2048 + 16); \
    dst[m] = (v8i32){(int)_lo.x, (int)_lo.y, (int)_lo.z, (int)_lo.w, (int)_hi.x, (int)_hi.y, (int)_hi.z, (int)_hi.w}; } } while (0)
#define F8_LDB(dst, b, h) do { _Pragma("unroll") for (int n = 0; n < 2; ++n) { const u32x4 _lo = *(const LAS u32x4*)(lds + SB_(b, h) + boff + n * 2048), _hi = *(const LAS u32x4*)(lds + SB_(b, h) + boff + n * 2048 + 16); \
    dst[n] = (v8i32){(int)_lo.x, (int)_lo.y, (int)_lo.z, (int)_lo.w, (int)_hi.x, (int)_hi.y, (int)_hi.z, (int)_hi.w}; } } while (0)
#define F8_MMA(ai, bj, At, Bt) do { __builtin_amdgcn_s_setprio(1); _Pragma("unroll") for (int m = 0; m < 4; ++m) _Pragma("unroll") for (int n = 0; n < 2; ++n) \
    acc[ai][bj][m][n] = __builtin_amdgcn_mfma_scale_f32_16x16x128_f8f6f4(Bt[n], At[m], acc[ai][bj][m][n], 0, 0, 0, 0x7a7a7a7a  , 0, ASCALE  ); __builtin_amdgcn_s_setprio(0); } while (0)
#define F8_MMA_Z(ai, bj, At, Bt) do { __builtin_amdgcn_s_setprio(1); _Pragma("unroll") for (int m = 0; m < 4; ++m) _Pragma("unroll") for (int n = 0; n < 2; ++n) \
    asm volatile("v_mfma_scale_f32_16x16x128_f8f6f4 %0, %1, %2, 0, %3, %4 op_sel_hi:[0,0,0]" : "+v"(acc[ai][bj][m][n]) : "v"(Bt[n]), "v"(At[m]), "v"(0x7a7a7a7a), "v"(ASCALE)); \
    __builtin_amdgcn_s_setprio(0); } while (0)
#define F8_MMX(FIRST, ai, bj, At, Bt) do { if (FIRST) F8_MMA_Z(ai, bj, At, Bt); else F8_MMA(ai, bj, At, Bt); } while (0)
#define F8_KBODY(FIRST) { \
            const bool last = (t == nt - 2); \
            const unsigned a1 = cA + (t + 1) * 128; \
            F8_LDB(B0, 0, 0); SCHED; F8_LDA(At, 0, 0); G_STAGE(SA_(1, 1), a1, oA[1]); \
            WAIT_L(8); BAR; WAIT_L(0); F8_MMX(FIRST, 0, 0, At, B0); BAR; SCHED; \
            if (last && has_next) P.offs(nxt, oA);                    \
            const unsigned a2 = last ? nA : cA + (t + 2) * 128, p0 = last ? nB0 : cB0 + (t + 2) * 128, p1 = last ? nB1 : cB1 + (t + 2) * 128; \
            F8_LDB(B1, 0, 1); G_STAGE(SB_(0, 0), p0, oB); \
            BAR; WAIT_L(0); F8_MMX(FIRST, 0, 1, At, B1); BAR; \
            F8_LDA(At, 0, 1); G_STAGE(SA_(0, 0), a2, oA[0]); \
            BAR; WAIT_L(0); F8_MMX(FIRST, 1, 0, At, B0); BAR; SCHED; \
            G_STAGE(SB_(0, 1), p1, oB); \
            WAIT_V(6); BAR; F8_MMX(FIRST, 1, 1, At, B1); BAR; \
            F8_LDB(B0, 1, 0); SCHED; F8_LDA(At, 1, 0); G_STAGE(SA_(0, 1), a2, oA[1]); \
            WAIT_L(8); BAR; WAIT_L(0); F8_MMA(0, 0, At, B0); BAR; SCHED; \
            F8_LDB(B1, 1, 1); G_STAGE(SB_(1, 0), p0 + 128, oB); \
            BAR; WAIT_L(0); F8_MMA(0, 1, At, B1); BAR; \
            F8_LDA(At, 1, 1); G_STAGE(SA_(1, 0), a2 + 128, oA[0]); \
            BAR; WAIT_L(0); F8_MMA(1, 0, At, B0); BAR; SCHED; \
            G_STAGE(SB_(1, 1), p1 + 128, oB); \
            WAIT_V(6); BAR; F8_MMA(1, 1, At, B1); BAR; }
template <class Prov, int ASCALE = 0x7f7f7f7f>
__device__ __forceinline__ void gemm_stream_f8(LAS unsigned char* lds, const __amdgpu_buffer_rsrc_t srd, const Prov& P) {
    const int tid = ltid(), wid = __builtin_amdgcn_readfirstlane(tid >> 6), lane = tid & 63, wr = wid >> 2, wc = wid & 3, fr = lane & 15, fq = lane >> 4;
    const unsigned ldsw = (unsigned)wid * 1024u;
    const int aoff = lds_byte(wr * 64 + fr, fq * 16), boff = lds_byte(wc * 32 + fr, fq * 16);
    typename Prov::Unit cur, nxt;
    if (!P.next(0, cur)) return;
    unsigned oA[2][2]; P.offs(cur, oA);
    const unsigned oB[2] = {P.offB[0], P.offB[1]};
    const int nt = P.nt;
    f32x4 acc[2][2][4][2];
    v8i32 At[4], B0[2], B1[2];
    unsigned cA = cur.A, cB0 = cur.B0, cB1 = cur.B1;
    G_STAGE(SB_(0, 0), cB0, oB); G_STAGE(SA_(0, 0), cA, oA[0]); G_STAGE(SB_(0, 1), cB1, oB); G_STAGE(SA_(0, 1), cA, oA[1]);
    if (wr == 1) BAR;
    WAIT_V(4); BAR;
    G_STAGE(SB_(1, 0), cB0 + 128, oB); G_STAGE(SA_(1, 0), cA + 128, oA[0]); G_STAGE(SB_(1, 1), cB1 + 128, oB);
    WAIT_V(6); BAR;
    int ui = 0;
    for (;;) {
        const bool has_next = P.next(ui + 1, nxt);
        const unsigned nA = has_next ? nxt.A : cA, nB0 = has_next ? nxt.B0 : cB0, nB1 = has_next ? nxt.B1 : cB1;
        for (int t = 0; t < nt; t += 2) { const bool first = (t == 0); F8_KBODY(first) }
        { int tz = threadIdx.x; asm volatile("" : "+v"(tz)); const int wz = __builtin_amdgcn_readfirstlane(tz >> 6), lz = tz & 63; P.epi(acc, cur, wz >> 2, wz & 3, lz & 15, lz >> 4); }
        if (!has_next) break;
        cur = nxt; cA = nA; cB0 = nB0; cB1 = nB1; ++ui;
    }
    WAIT_V(0);
    if (wr == 0) BAR;
    BAR;
    __syncthreads();
}

#define EPI_ROWS(ai, m) (ai * 128 + wr * 64 + m * 16 + fr)
#define EPI_COLS(bj, n) (bj * 128 + wc * 32 + n * 16 + fq * 4)
#define EPI_ROW16(ai, m) (ai * 128 + wr * 64 + m * 16)
typedef const f32x4 (&AccRef)[2][2][4][2];

struct EpiPool {
    const float* x; const float* scale; float* o; int row0, col0;
    __device__ __forceinline__ void operator()(AccRef acc, int wr, int wc, int fr, int fq) const {
#pragma unroll
        for (int ai = 0; ai < 2; ++ai)
#pragma unroll
            for (int m = 0; m < 4; ++m) { const size_t rb = (size_t)(row0 + EPI_ROW16(ai, m)) * DM;
#pragma unroll
                for (int bj = 0; bj < 2; ++bj) { const int cb = col0 + bj * 128 + wc * 32; f32x4 x0, x1; ld_rows8_f32(x + rb + cb, DM, fr, fq, x0, x1);
                    const f32x4 s0 = ld4(scale + cb + fq * 4), s1 = ld4(scale + cb + 16 + fq * 4);
                    st_pair_bf16((bf16_t*)o + (size_t)(row0 + EPI_ROWS(ai, m)) * DM + cb, x0 + s0 * acc[ai][bj][m][0], x1 + s1 * acc[ai][bj][m][1], fq); }
                if (m == 3) asm volatile("" ::: "memory"); }
    }
};
struct EpiRes {
    const bf16_t* base; bf16_t* o; int row0, col0;
    __device__ __forceinline__ void operator()(AccRef acc, int wr, int wc, int fr, int fq) const {
#pragma unroll
        for (int ai = 0; ai < 2; ++ai)
#pragma unroll
            for (int m = 0; m < 4; ++m) { const size_t rb = (size_t)(row0 + EPI_ROW16(ai, m)) * DM;
#pragma unroll
                for (int bj = 0; bj < 2; ++bj) { const int cb = col0 + bj * 128 + wc * 32; u32x2 w0, w1; ld_pair_bf16(base + (size_t)(row0 + EPI_ROWS(ai, m)) * DM + cb, fq, w0, w1);
                    const f32x4 x0 = (f32x4){bf_lo(w0.x), bf_hi(w0.x), bf_lo(w0.y), bf_hi(w0.y)}, x1 = (f32x4){bf_lo(w1.x), bf_hi(w1.x), bf_lo(w1.y), bf_hi(w1.y)};
                    st_pair_bf16(o + (size_t)(row0 + EPI_ROWS(ai, m)) * DM + cb, x0 + acc[ai][bj][m][0], x1 + acc[ai][bj][m][1], fq); }
                if (m == 3) asm volatile("" ::: "memory"); }
    }
};
constexpr float PP_SCALE = 16.0f;
struct EpiF8 {
    unsigned char* o; int ld; float sc; int row0, col0;
    __device__ __forceinline__ void operator()(AccRef acc, int wr, int wc, int fr, int fq) const {
#pragma unroll
        for (int ai = 0; ai < 2; ++ai)
#pragma unroll
            for (int m = 0; m < 4; ++m) { const size_t ro = (size_t)(row0 + EPI_ROWS(ai, m)) * ld;
#pragma unroll
                for (int bj = 0; bj < 2; ++bj) st_pair_fp8(o + ro + col0 + bj * 128 + wc * 32, acc[ai][bj][m][0], acc[ai][bj][m][1], fq, sc); }
    }
};
struct EpiBf16 {
    bf16_t* o; int ld, row0, col0;
    __device__ __forceinline__ void operator()(AccRef acc, int wr, int wc, int fr, int fq) const {
#pragma unroll
        for (int ai = 0; ai < 2; ++ai)
#pragma unroll
            for (int m = 0; m < 4; ++m) { const size_t ro = (size_t)(row0 + EPI_ROWS(ai, m)) * ld;
#pragma unroll
                for (int bj = 0; bj < 2; ++bj) st_pair_bf16(o + ro + col0 + bj * 128 + wc * 32, acc[ai][bj][m][0], acc[ai][bj][m][1], fq); }
    }
};
template <bool STATS>
struct EpiPle {
    const bf16_t* x2; const float* rs2; const unsigned char* pp  ; float* o; bf16_t* xb; float* ss; unsigned char* xq; int row0, col0;
    __device__ __forceinline__ void operator()(AccRef acc, int wr, int wc, int fr, int fq) const {
#pragma unroll
        for (int ai = 0; ai < 2; ++ai)
#pragma unroll
            for (int m = 0; m < 4; ++m) { const int row = row0 + EPI_ROWS(ai, m); const size_t ro = (size_t)row * DM; float sq = 0.f; const float rs = rs2[row];
#pragma unroll
                for (int bj = 0; bj < 2; ++bj) { f32x4 rr[2], pvv[2]; u32x2 xwv[2]; const int cb = col0 + bj * 128 + wc * 32; const size_t rb = (size_t)(row0 + EPI_ROW16(ai, m)) * DM;
                    ld_pair_bf16(x2 + ro + cb, fq, xwv[0], xwv[1]); ld_pair_fp8(pp + ro + cb, fq, pvv[0], pvv[1]);
#pragma unroll
                    for (int n = 0; n < 2; ++n) { const f32x4 a = acc[ai][bj][m][n]; const f32x4 pw = pvv[n] * (1.0f / PP_SCALE); const u32x2 xw = xwv[n];
                        f32x4 r; r[0] = bf_lo(xw.x) + sigmoidf_(a[0] * rs) * pw[0]; r[1] = bf_hi(xw.x) + sigmoidf_(a[1] * rs) * pw[1];
                        r[2] = bf_lo(xw.y) + sigmoidf_(a[2] * rs) * pw[2]; r[3] = bf_hi(xw.y) + sigmoidf_(a[3] * rs) * pw[3];
                        rr[n] = r;
                        if (STATS) sq += r[0] * r[0] + r[1] * r[1] + r[2] * r[2] + r[3] * r[3]; }
                    if (STATS) { st_pair_bf16(xb + ro + cb, rr[0], rr[1], fq);
                        unsigned dq[2];
#pragma unroll
                        for (int n = 0; n < 2; ++n) { f32x4 v = rr[n];
#pragma unroll
                            for (int j = 0; j < 4; ++j) v[j] = __builtin_amdgcn_fmed3f(v[j], -440.0f, 440.0f);
                            dq[n] = pk4_fp8(v[0], v[1], v[2], v[3]); }
                        const auto sw = __builtin_amdgcn_permlane16_swap(dq[0], dq[1], false, false);
                        u32x2 w; w.x = sw[0]; w.y = sw[1];
                        *(u32x2*)(xq + ro + cb + (fq & 1) * 16 + (fq >> 1) * 8) = w; }
                    else st_rows8_f32(o + rb + cb, DM, fr, fq, rr[0], rr[1]); }
                if (STATS) { sq += __shfl_xor(sq, 16); sq += __shfl_xor(sq, 32); if (fq == 0) ss[(size_t)row * 16 + (col0 >> 8) * 4 + wc] = sq; }
                if (m == 3) asm volatile("" ::: "memory"); }
    }
};
__device__ __forceinline__ float sum16(const float* p, int n4) { float t = 0.f; for (int i = 0; i < n4; ++i) { const f32x4 v = ld4(p + 4 * i); t += (v[0] + v[1]) + (v[2] + v[3]); } return t; }
struct EpiLat {
    const float* ss3; bf16_t* o; float* ssq; float* sskv; unsigned char* kv8; int row0, col0;
    __device__ __forceinline__ void operator()(AccRef acc, int wr, int wc, int fr, int fq) const {
#pragma unroll
        for (int ai = 0; ai < 2; ++ai)
#pragma unroll
            for (int m = 0; m < 4; ++m) { const int row = row0 + EPI_ROWS(ai, m); const float rs = rsqrtf(sum16(ss3 + (size_t)row * 16, 4) * (1.0f / DM) + EPS); float sq[2];
#pragma unroll
                for (int bj = 0; bj < 2; ++bj) { sq[bj] = 0.f;
#pragma unroll
                    for (int n = 0; n < 2; ++n) { const f32x4 v = acc[ai][bj][m][n] * rs; sq[bj] += v[0] * v[0] + v[1] * v[1] + v[2] * v[2] + v[3] * v[3]; }
                    st_pair_bf16(o + (size_t)row * LATP + col0 + bj * 128 + wc * 32, acc[ai][bj][m][0] * rs, acc[ai][bj][m][1] * rs, fq);
                    { const int hh = (col0 >> 7) + bj;
                      if (hh == 3 || hh == 4) { unsigned dq[2];
#pragma unroll
                          for (int n = 0; n < 2; ++n) { f32x4 v = acc[ai][bj][m][n] * rs;
#pragma unroll
                              for (int j = 0; j < 4; ++j) v[j] = __builtin_amdgcn_fmed3f(v[j], -440.0f, 440.0f);
                              dq[n] = pk4_fp8(v[0], v[1], v[2], v[3]); }
                          const auto sw = __builtin_amdgcn_permlane16_swap(dq[0], dq[1], false, false);
                          u32x2 w; w.x = sw[0]; w.y = sw[1];
                          *(u32x2*)(kv8 + (size_t)row * KVL + (hh - 3) * 128 + wc * 32 + (fq & 1) * 16 + (fq >> 1) * 8) = w; } }
                    sq[bj] += __shfl_xor(sq[bj], 16); sq[bj] += __shfl_xor(sq[bj], 32); }
                if (fq == 0) {
                    const int h0 = col0 >> 7;
#pragma unroll
                    for (int bj = 0; bj < 2; ++bj) { const int h = h0 + bj; if (h < 3) ssq[(size_t)row * 16 + 4 * h + wc] = sq[bj]; else if (h < 5) sskv[(size_t)row * 16 + 4 * (h - 3) + wc] = sq[bj]; } } }
    }
};
struct EpiBf16S {
    bf16_t* o; int ld; const float* ss; int np4; float inv_k; int row0, col0;
    __device__ __forceinline__ void operator()(AccRef acc, int wr, int wc, int fr, int fq) const {
#pragma unroll
        for (int ai = 0; ai < 2; ++ai)
#pragma unroll
            for (int m = 0; m < 4; ++m) { const int row = row0 + EPI_ROWS(ai, m); const float rs = rsqrtf(sum16(ss + (size_t)row * 16, np4) * inv_k + EPS); const size_t ro = (size_t)row * ld;
#pragma unroll
                for (int bj = 0; bj < 2; ++bj) st_pair_bf16(o + ro + col0 + bj * 128 + wc * 32, acc[ai][bj][m][0] * rs, acc[ai][bj][m][1] * rs, fq); }
    }
};
constexpr float KN_SCALE = 8.0f;
struct EpiKV {
    bf16_t* o; const float* ss; unsigned char* vt; int row0, col0;
    __device__ __forceinline__ void operator()(AccRef acc, int wr, int wc, int fr, int fq) const {
        const int t = fr & 3; const unsigned selq = 0x0c0c0400u + (unsigned)t * 0x0101u;
        const bool hi8 = fr >= 8;
#pragma unroll
        for (int ai = 0; ai < 2; ++ai) { float rs[4];
#pragma unroll
            for (int m = 0; m < 4; ++m) { const int row = row0 + EPI_ROWS(ai, m); rs[m] = rsqrtf(sum16(ss + (size_t)row * 16, 2) * (1.0f / KVL) + EPS);
                st_pair_fp8((unsigned char*)o + (size_t)row * (NH * 128) + (col0 >> 8) * 128 + wc * 32, acc[ai][0][m][0] * rs[m], acc[ai][0][m][1] * rs[m], fq, KN_SCALE); }
            const int tok0 = row0 + ai * 128 + wr * 64, b = tok0 / SEQ, kt = (tok0 % SEQ) >> 6;
            unsigned char* tile = vt + ((size_t)(b * NH + (col0 >> 8)) * (SEQ / 64) + kt) * 8192;
#pragma unroll
            for (int n = 0; n < 2; ++n) { unsigned W[4];
#pragma unroll
                for (int m = 0; m < 4; ++m) { const f32x4 v = acc[ai][1][m][n] * rs[m]; const int D = (int)pk4_fp8(v[0], v[1], v[2], v[3]);
                    const unsigned q0 = (unsigned)__builtin_amdgcn_update_dpp(0, D, 0x00, 0xf, 0xf, false), q1 = (unsigned)__builtin_amdgcn_update_dpp(0, D, 0x55, 0xf, 0xf, false);
                    const unsigned q2 = (unsigned)__builtin_amdgcn_update_dpp(0, D, 0xAA, 0xf, 0xf, false), q3 = (unsigned)__builtin_amdgcn_update_dpp(0, D, 0xFF, 0xf, 0xf, false);
                    const unsigned lo = __builtin_amdgcn_perm(q1, q0, selq), hi = __builtin_amdgcn_perm(q3, q2, selq);
                    W[m] = lo | (hi << 16); }
                const unsigned s0 = hi8 ? W[0] : W[2], s1 = hi8 ? W[1] : W[3];
                const unsigned r0 = (unsigned)__builtin_amdgcn_update_dpp(0, (int)s0, 0x128, 0xf, 0xf, false), r1 = (unsigned)__builtin_amdgcn_update_dpp(0, (int)s1, 0x128, 0xf, 0xf, false);
                u32x4 ov; ov.x = hi8 ? r0 : W[0]; ov.y = hi8 ? W[2] : r0; ov.z = hi8 ? r1 : W[1]; ov.w = hi8 ? W[3] : r1;
                const int d = wc * 32 + n * 16 + fq * 4 + t;
                *(u32x4*)(tile + d * 64 + ((fr >> 2) & 1) * 32 + (fr >> 3) * 16) = ov; }
            asm volatile("" ::: "memory"); }
    }
};
struct EpiMoe1 {
    const float* bg; const float* bu; unsigned char* act; int nv;
    __device__ __forceinline__ void operator()(AccRef acc, int wr, int wc, int fr, int fq) const {
        f32x4 bgv[2], buv[2];
#pragma unroll
        for (int n = 0; n < 2; ++n) { const int c = wc * 32 + n * 16 + fq * 4; bgv[n] = ld4(bg + c); buv[n] = ld4(bu + c); }
#pragma unroll
        for (int ai = 0; ai < 2; ++ai)
#pragma unroll
            for (int m = 0; m < 4; ++m) { const int r = EPI_ROWS(ai, m);
                unsigned dw[2];
#pragma unroll
                for (int n = 0; n < 2; ++n) {
                    const f32x4 g4 = acc[ai][0][m][n] + bgv[n], u4 = acc[ai][1][m][n] + buv[n]; float a[4];
#pragma unroll
                    for (int j = 0; j < 4; j += 2) {
                        const f32x2 g = (f32x2){fminf(g4[j], 7.0f), fminf(g4[j + 1], 7.0f)}, u = (f32x2){fminf(fmaxf(u4[j], -7.0f), 7.0f), fminf(fmaxf(u4[j + 1], -7.0f), 7.0f)};
                        const f32x2 t = g * (f32x2){-1.702f * 1.4426950408889634f, -1.702f * 1.4426950408889634f};
                        const f32x2 d = (f32x2){__builtin_amdgcn_exp2f(t.x), __builtin_amdgcn_exp2f(t.y)} + (f32x2){1.0f, 1.0f};
                        const f32x2 q = (u + (f32x2){1.0f, 1.0f}) * g * (f32x2){__builtin_amdgcn_rcpf(d.x), __builtin_amdgcn_rcpf(d.y)};
                        a[j] = q.x; a[j + 1] = q.y; }
                    dw[n] = pk4_fp8(a[0], a[1], a[2], a[3]); }
                const auto sw = __builtin_amdgcn_permlane16_swap(dw[0], dw[1], false, false);
                u32x2 w; w.x = sw[0]; w.y = sw[1];
                if (r < nv) *(u32x2*)(act + (size_t)r * DFF + wc * 32 + (fq & 1) * 16 + (fq >> 1) * 8) = w; }
    }
};
constexpr float SLOT_SCALE = 8.0f;
struct EpiMoe2 {
    const float* bd; LAS const int* lpair; LAS const float* lgate; bf16_t* slot; int nv, col0;
    __device__ __forceinline__ void operator()(AccRef acc, int wr, int wc, int fr, int fq) const {
        f32x4 bv[2][2];
#pragma unroll
        for (int bj = 0; bj < 2; ++bj)
#pragma unroll
            for (int n = 0; n < 2; ++n) bv[bj][n] = ld4(bd + col0 + EPI_COLS(bj, n));
#pragma unroll
        for (int ai = 0; ai < 2; ++ai)
#pragma unroll
            for (int m = 0; m < 4; ++m) { const int r = EPI_ROWS(ai, m); const int pair = lpair[r]; const float g = lgate[r] * SLOT_SCALE; unsigned char* orow = (unsigned char*)slot + (size_t)pair * DM + col0;
#pragma unroll
                for (int bj = 0; bj < 2; ++bj) {
                    unsigned dq[2];
#pragma unroll
                    for (int n = 0; n < 2; ++n) { f32x4 v = (acc[ai][bj][m][n] + bv[bj][n]) * g;
#pragma unroll
                        for (int j = 0; j < 4; ++j) v[j] = __builtin_amdgcn_fmed3f(v[j], -440.0f, 440.0f);
                        dq[n] = pk4_fp8(v[0], v[1], v[2], v[3]); }
                    const auto sw = __builtin_amdgcn_permlane16_swap(dq[0], dq[1], false, false);
                    u32x2 w; w.x = sw[0]; w.y = sw[1];
                    if (r < nv) *(u32x2*)(orow + bj * 128 + wc * 32 + (fq & 1) * 16 + (fq >> 1) * 8) = w;
                    asm volatile("" ::: "memory"); } }
    }
};

__device__ __forceinline__ void offs_contig(const int (&R)[2], const int (&C)[2], unsigned ldaB, unsigned ldbB, unsigned (&offA)[2][2], unsigned (&offB)[2]) {
#pragma unroll
    for (int i = 0; i < 2; ++i) { offA[0][i] = (unsigned)R[i] * ldaB + C[i] * 2; offA[1][i] = (unsigned)(R[i] + 128) * ldaB + C[i] * 2; offB[i] = (unsigned)R[i] * ldbB + C[i] * 2; }
}

template <int N, int K>
__device__ __forceinline__ void tr_load(const float* __restrict__ src, const float* __restrict__ ksc, int u, int r, int c4, f32x4 (&v)[8]) {
    constexpr int TN = (N + 255) / 256, TK = K / 64, PTM = TN * TK;
    const int mat = u / PTM, rem = u - mat * PTM, tn = rem / TK, tk = rem - tn * TK;
    const bool ok = (N % 256 == 0) || (tn * 256 + c4 < N);
    const float* s = src + (size_t)mat * K * N + (size_t)(tk * 64 + r) * N + (ok ? tn * 256 + c4 : 0);
#pragma unroll
    for (int p = 0; p < 8; ++p) { f32x4 t = ld4(s + (size_t)p * 8 * N); if (N % 256 != 0) { if (!ok) t = (f32x4){0.f, 0.f, 0.f, 0.f}; } if (ksc) t = t * ksc[tk * 64 + p * 8 + r]; v[p] = t; }
}
template <int N, int K>
__device__ __forceinline__ void transpose_seg(LAS unsigned char* lds, const float* __restrict__ src, bf16_t* __restrict__ dst, int nmat, int& rot, const float* __restrict__ ksc = nullptr) {
    constexpr int TN = (N + 255) / 256, TK = K / 64, PTM = TN * TK;
    const int G = gridDim.x, tid = threadIdx.x, total = nmat * PTM;
    LAS float* tile = (LAS float*)lds;
    const int r = tid >> 6, c4 = (tid & 63) * 4, nl = tid >> 1, kh = (tid & 1) * 32;
    int u = (int)blockIdx.x - rot; if (u < 0) u += G;
    f32x4 v[8];
    if (u < total) tr_load<N, K>(src, ksc, u, r, c4, v);
    while (u < total) {
#pragma unroll
        for (int p = 0; p < 8; ++p) *(LAS f32x4*)(tile + (p * 8 + r) * 260 + c4) = v[p];
        __syncthreads();
        const int mat = u / PTM, rem = u - mat * PTM, tn = rem / TK, tk = rem - tn * TK;
        const int un = u + G;
        if (un < total) tr_load<N, K>(src, ksc, un, r, c4, v);
        float w[32];
#pragma unroll
        for (int j = 0; j < 32; ++j) w[j] = tile[(kh + j) * 260 + nl];
        bf16_t* d = dst + ((size_t)mat * TN * 256 + tn * 256 + nl) * K + tk * 64 + kh;
#pragma unroll
        for (int q = 0; q < 4; ++q) { u32x4 o; o.x = cvt_pk_bf16(w[q * 8 + 0], w[q * 8 + 1]); o.y = cvt_pk_bf16(w[q * 8 + 2], w[q * 8 + 3]);
            o.z = cvt_pk_bf16(w[q * 8 + 4], w[q * 8 + 5]); o.w = cvt_pk_bf16(w[q * 8 + 6], w[q * 8 + 7]); *(u32x4*)(d + q * 8) = o; }
        __syncthreads();
        u = un;
    }
    rot = (rot + total) % G;
}
template <int N, int K>
__device__ __forceinline__ void transpose_seg_f8(LAS unsigned char* lds, const float* __restrict__ src, unsigned char* __restrict__ dst, int nmat, int& rot, const float* __restrict__ ksc = nullptr) {
    constexpr int TN = (N + 255) / 256, TK = K / 64, PTM = TN * TK;
    const int G = gridDim.x, tid = threadIdx.x, total = nmat * PTM;
    LAS float* tile = (LAS float*)lds;
    const int r = tid >> 6, c4 = (tid & 63) * 4, nl = tid >> 1, kh = (tid & 1) * 32;
    int u = (int)blockIdx.x - rot; if (u < 0) u += G;
    f32x4 v[8];
    if (u < total) tr_load<N, K>(src, ksc, u, r, c4, v);
    while (u < total) {
#pragma unroll
        for (int p = 0; p < 8; ++p) *(LAS f32x4*)(tile + (p * 8 + r) * 260 + c4) = v[p];
        __syncthreads();
        const int mat = u / PTM, rem = u - mat * PTM, tn = rem / TK, tk = rem - tn * TK;
        const int un = u + G;
        if (un < total) tr_load<N, K>(src, ksc, un, r, c4, v);
        float w[32];
#pragma unroll
        for (int j = 0; j < 32; ++j) w[j] = tile[(kh + j) * 260 + nl] * 32.0f;
        unsigned char* d = dst + ((size_t)mat * TN * 256 + tn * 256 + nl) * K + tk * 64 + kh;
#pragma unroll
        for (int q = 0; q < 2; ++q) { u32x4 o; o.x = pk4_fp8(w[q * 16 + 0], w[q * 16 + 1], w[q * 16 + 2], w[q * 16 + 3]); o.y = pk4_fp8(w[q * 16 + 4], w[q * 16 + 5], w[q * 16 + 6], w[q * 16 + 7]);
            o.z = pk4_fp8(w[q * 16 + 8], w[q * 16 + 9], w[q * 16 + 10], w[q * 16 + 11]); o.w = pk4_fp8(w[q * 16 + 12], w[q * 16 + 13], w[q * 16 + 14], w[q * 16 + 15]); *(u32x4*)(d + q * 16) = o; }
        __syncthreads();
        u = un;
    }
    rot = (rot + total) % G;
}
__device__ __forceinline__ void rope_table_phase(const int* __restrict__ pos, float* __restrict__ cs) {
    for (int idx = blockIdx.x * NTHREADS + threadIdx.x; idx < T * 32; idx += gridDim.x * NTHREADS) { const int tok = idx >> 5, i = idx & 31;
        const float ang = (float)pos[tok] * exp2f(-(float)i * (13.287712379549449f / 32.0f));
        double tr = (double)ang * 0.15915494309189535; tr -= __builtin_rint(tr); const float frv = (float)tr;
        *(f32x2*)(cs + (size_t)idx * 2) = (f32x2){__builtin_amdgcn_cosf(frv), __builtin_amdgcn_sinf(frv)}; }
}
__device__ __forceinline__ void cvt_p_phase(const float* __restrict__ p, bf16_t* __restrict__ pb) {
    const size_t n8 = (size_t)2 * T * PLE / 8, stride = (size_t)gridDim.x * NTHREADS;
    size_t i = (size_t)blockIdx.x * NTHREADS + threadIdx.x;
    for (; i + 3 * stride < n8; i += 4 * stride) { f32x4 a[4], b[4];
#pragma unroll
        for (int k = 0; k < 4; ++k) { a[k] = ld4(p + (i + k * stride) * 8); b[k] = ld4(p + (i + k * stride) * 8 + 4); }
#pragma unroll
        for (int k = 0; k < 4; ++k) { u32x4 o; o.x = cvt_pk_bf16(a[k][0], a[k][1]); o.y = cvt_pk_bf16(a[k][2], a[k][3]); o.z = cvt_pk_bf16(b[k][0], b[k][1]); o.w = cvt_pk_bf16(b[k][2], b[k][3]);
            *(u32x4*)(pb + (i + k * stride) * 8) = o; } }
    for (; i < n8; i += stride) { const f32x4 a = ld4(p + i * 8), b = ld4(p + i * 8 + 4);
        u32x4 o; o.x = cvt_pk_bf16(a[0], a[1]); o.y = cvt_pk_bf16(a[2], a[3]); o.z = cvt_pk_bf16(b[0], b[1]); o.w = cvt_pk_bf16(b[2], b[3]);
        *(u32x4*)(pb + i * 8) = o; }
}
template <int WIN>
__device__ __forceinline__ void pool_diff_cols(const float* __restrict__ x, LAS const float* rs, const f32x2 gv, bf16_t* __restrict__ diff, int t0, int s0, int c) {
    constexpr int NR = 32 + WIN - 1;
    f32x2 h[NR];
#pragma unroll
    for (int j = 0; j < NR; ++j) { const int row = t0 - (WIN - 1) + j; const bool ok = (s0 - (WIN - 1) + j) >= 0;
        h[j] = *(const f32x2*)(x + (size_t)(ok ? row : t0) * DM + c); }
#pragma unroll
    for (int j = 0; j < NR; ++j) { const int ri = 15 - (WIN - 1) + j; const bool ok = (s0 - (WIN - 1) + j) >= 0; h[j] = ok ? h[j] * rs[ri] * gv : (f32x2){0.f, 0.f}; }
    f32x2 W = (f32x2){0.f, 0.f};
#pragma unroll
    for (int j = 0; j < WIN - 1; ++j) W += h[j];
#pragma unroll
    for (int i = 0; i < 32; ++i) {
        W += h[i + WIN - 1];
        const int s = s0 + i; const int cnt = (s + 1 < WIN) ? s + 1 : WIN;
        const f32x2 d = W * (1.0f / (float)cnt) - h[i + WIN - 1];
        *(unsigned*)(diff + (size_t)(t0 + i) * DM + c) = cvt_pk_bf16(d.x, d.y);
        W -= h[i];
    }
}
__device__ __forceinline__ void pool_diff_phase(LAS unsigned char* lds, const float* __restrict__ x, const float* __restrict__ g, bf16_t* __restrict__ diff) {
    LAS float* rs = (LAS float*)lds;
    const int tid = threadIdx.x, wid = tid >> 6, lane = tid & 63;
    const int c = tid * 2, grp = __builtin_amdgcn_readfirstlane(c >> 8);
    const f32x2 gv = *(const f32x2*)(g + c);
    for (int run = blockIdx.x; run < T / 32; run += gridDim.x) {
        const int t0 = run * 32, s0 = t0 % SEQ, back = s0 < 15 ? s0 : 15;
        __syncthreads();
        { f32x4 v[6][4]; const int r0 = 15 - back + wid;
#pragma unroll
          for (int k = 0; k < 6; ++k) { const int r = r0 + 8 * k; const float* xr = x + (size_t)(t0 - 15 + (r < 47 ? r : 46)) * DM;
#pragma unroll
              for (int q = 0; q < 4; ++q) v[k][q] = ld4(xr + q * 256 + lane * 4); }
#pragma unroll
          for (int k = 0; k < 6; ++k) { const int r = r0 + 8 * k; float ss = 0.f;
#pragma unroll
              for (int q = 0; q < 4; ++q) ss += v[k][q][0] * v[k][q][0] + v[k][q][1] * v[k][q][1] + v[k][q][2] * v[k][q][2] + v[k][q][3] * v[k][q][3];
              ss = wave_sum(ss);
              if (lane == 0 && r < 47) rs[r] = rsqrtf(ss * (1.0f / DM) + EPS); } }
        __syncthreads();
        if (grp == 0) pool_diff_cols<2>(x, rs, gv, diff, t0, s0, c);
        else if (grp == 1) pool_diff_cols<4>(x, rs, gv, diff, t0, s0, c);
        else if (grp == 2) pool_diff_cols<8>(x, rs, gv, diff, t0, s0, c);
        else pool_diff_cols<16>(x, rs, gv, diff, t0, s0, c);
    }
}

template <bool XBF> __device__ __forceinline__ void combine_phase(const float* __restrict__ x1, const bf16_t* __restrict__ slot, bf16_t* __restrict__ x2, unsigned char* __restrict__ x2q, float* __restrict__ rs2) {
    const int tid = threadIdx.x, wid = tid >> 6, lane = tid & 63;
    for (int row0 = blockIdx.x * 8 + wid; row0 < T; row0 += gridDim.x * 16) {
        const int row1 = row0 + gridDim.x * 8; const bool has1 = row1 < T;
        f32x4 xa[2][4]; unsigned sw[2][4][4];
#pragma unroll
        for (int t = 0; t < 2; ++t) { const int row = (t && has1) ? row1 : row0;
#pragma unroll
            for (int q = 0; q < 4; ++q) { const int col = q * 256 + lane * 4;
                if (XBF) { const u32x2 w = *(const u32x2*)((const bf16_t*)x1 + (size_t)row * DM + col); xa[t][q] = (f32x4){bf_lo(w.x), bf_hi(w.x), bf_lo(w.y), bf_hi(w.y)}; } else xa[t][q] = ld4(x1 + (size_t)row * DM + col);
#pragma unroll
                for (int k = 0; k < 4; ++k) sw[t][q][k] = *(const unsigned*)((const unsigned char*)slot + ((size_t)row * 4 + k) * DM + col); } }
#pragma unroll
        for (int t = 0; t < 2; ++t) { if (t == 1 && !has1) break; const int row = t ? row1 : row0; float ss = 0.f;
#pragma unroll
            for (int q = 0; q < 4; ++q) { const int col = q * 256 + lane * 4; f32x4 a = xa[t][q];
                { f32x2 s01 = (f32x2){0.f, 0.f}, s23 = (f32x2){0.f, 0.f};
#pragma unroll
                  for (int k = 0; k < 4; ++k) { const int w = (int)sw[t][q][k]; s01 += __builtin_amdgcn_cvt_pk_f32_fp8(w, false); s23 += __builtin_amdgcn_cvt_pk_f32_fp8(w, true); }
                  a[0] += s01.x * (1.0f / SLOT_SCALE); a[1] += s01.y * (1.0f / SLOT_SCALE); a[2] += s23.x * (1.0f / SLOT_SCALE); a[3] += s23.y * (1.0f / SLOT_SCALE); }
                xa[t][q] = a; st4bf(x2 + (size_t)row * DM + col, a); *(unsigned*)(x2q + (size_t)row * DM + col) = pk4_fp8(a[0], a[1], a[2], a[3]); ss += a[0] * a[0] + a[1] * a[1] + a[2] * a[2] + a[3] * a[3]; }
            ss = wave_sum(ss); if (lane == 0) rs2[row] = rsqrtf(ss * (1.0f / DM) + EPS); }
    }
}
__device__ __forceinline__ void k_finalize_phase(const bf16_t* __restrict__ kvf, const bf16_t* __restrict__ lat, const float* __restrict__ cst, const float* __restrict__ khn, bf16_t* __restrict__ K) {
    const int tid = ltid(), wid = tid >> 6, lane = tid & 63, h = lane >> 3, j = lane & 7;
    const bool x2h = j >= 4;
    f32x4 gn[4], gr[2];
#pragma unroll
    for (int q = 0; q < 4; ++q) gn[q] = ld4(khn + j * 16 + q * 4);
#pragma unroll
    for (int q = 0; q < 2; ++q) gr[q] = ld4(khn + 128 + j * 8 + q * 4);
    const int nb = (j >> 2) * 64 + (j & 3) * 8, rbyte = 128 + (j & 1) * 32 + (j >> 1) * 8;
    constexpr int KT = 2;
    for (int tok0 = blockIdx.x * 8 + wid; tok0 < T; tok0 += gridDim.x * 8 * KT) {
        u32x4 n0[KT], rp[KT]; f32x4 cs[KT][4];
#pragma unroll
        for (int t = 0; t < KT; ++t) { const int tk = tok0 + t * (int)gridDim.x * 8; const int tok = tk < T ? tk : tok0;
            const unsigned char* kp = (const unsigned char*)kvf + (size_t)tok * (NH * 128) + h * 128 + j * 16; n0[t] = *(const u32x4*)kp;
            rp[t] = *(const u32x4*)(lat + (size_t)tok * LATP + QL + KVL + j * 8);
#pragma unroll
            for (int q = 0; q < 4; ++q) cs[t][q] = ld4(cst + (size_t)tok * 64 + (j & 3) * 16 + q * 4); }
#pragma unroll
        for (int t = 0; t < KT; ++t) { const int tok = tok0 + t * (int)gridDim.x * 8; if (tok >= T) break;
            const int b = tok / SEQ, sq = tok % SEQ;
            float v[16], r[8];
#define UNP8(dst, o_, w_) { dst[o_ + 0] = bf_lo(w_.x); dst[o_ + 1] = bf_hi(w_.x); dst[o_ + 2] = bf_lo(w_.y); dst[o_ + 3] = bf_hi(w_.y); dst[o_ + 4] = bf_lo(w_.z); dst[o_ + 5] = bf_hi(w_.z); dst[o_ + 6] = bf_lo(w_.w); dst[o_ + 7] = bf_hi(w_.w); }
            { const unsigned wv[4] = {n0[t].x, n0[t].y, n0[t].z, n0[t].w};
#pragma unroll
              for (int q = 0; q < 4; ++q) { const f32x2 a = __builtin_amdgcn_cvt_pk_f32_fp8((int)wv[q], false), c2 = __builtin_amdgcn_cvt_pk_f32_fp8((int)wv[q], true);
                  v[q * 4 + 0] = a.x * (1.0f / KN_SCALE); v[q * 4 + 1] = a.y * (1.0f / KN_SCALE); v[q * 4 + 2] = c2.x * (1.0f / KN_SCALE); v[q * 4 + 3] = c2.y * (1.0f / KN_SCALE); } }
            UNP8(r, 0, rp[t])
#undef UNP8
            float ss = 0.f;
#pragma unroll
            for (int i = 0; i < 16; ++i) ss += v[i] * v[i];
#pragma unroll
            for (int i = 0; i < 8; ++i) ss += r[i] * r[i];
            ss += __shfl_xor(ss, 1); ss += __shfl_xor(ss, 2); ss += __shfl_xor(ss, 4);
            const float rstd = rsqrtf(ss * (1.0f / QKD) + EPS);
#pragma unroll
            for (int i = 0; i < 16; ++i) v[i] *= rstd * gn[i >> 2][i & 3];
#pragma unroll
            for (int i = 0; i < 8; ++i) r[i] *= rstd * gr[i >> 2][i & 3];
            float ro[8];
#pragma unroll
            for (int i = 0; i < 8; ++i) { const float o = __shfl_xor(r[i], 4); const float c = cs[t][i >> 1][(i & 1) * 2], sn = cs[t][i >> 1][(i & 1) * 2 + 1];
                ro[i] = x2h ? (r[i] * c + o * sn) : (r[i] * c - o * sn); }
            unsigned char* kr = (unsigned char*)K + ((size_t)(b * NH + h) * SEQ + sq) * QKD;
            u32x2 w;
            w.x = pk4_fp8(v[0], v[1], v[2], v[3]); w.y = pk4_fp8(v[4], v[5], v[6], v[7]); *(u32x2*)(kr + nb) = w;
            w.x = pk4_fp8(v[8], v[9], v[10], v[11]); w.y = pk4_fp8(v[12], v[13], v[14], v[15]); *(u32x2*)(kr + nb + 32) = w;
            w.x = pk4_fp8(ro[0], ro[1], ro[2], ro[3]); w.y = pk4_fp8(ro[4], ro[5], ro[6], ro[7]); *(u32x2*)(kr + rbyte) = w;
        }
    }
}

__device__ __forceinline__ void v_transpose_phase(const bf16_t* __restrict__ kvf, unsigned char* __restrict__ VT) {
    const int tid = ltid(), wid = tid >> 6, lane = tid & 63;
    for (int item = blockIdx.x * 8 + wid; item < (T / 64) * NH; item += gridDim.x * 8) {
        const int h = item & 7, tt = item >> 3, b = tt / (SEQ / 64), kt = tt % (SEQ / 64);
        const bf16_t* src = kvf + (size_t)tt * 64 * (NH * 256) + h * 256 + 128 + 2 * lane;
        unsigned v[64];
#pragma unroll
        for (int k = 0; k < 64; ++k) v[k] = *(const unsigned*)(src + (size_t)k * (NH * 256));
        unsigned char* dst = VT + ((size_t)(b * NH + h) * (SEQ / 64) + kt) * 8192 + lane * 128;
#pragma unroll
        for (int half = 0; half < 2; ++half)
#pragma unroll
            for (int w4 = 0; w4 < 4; ++w4) { u32x4 o;
#pragma unroll
                for (int e = 0; e < 4; ++e) { const int w = w4 * 4 + e, kb = 32 * ((w >> 2) & 1) + 8 * (w & 3) + 4 * (w >> 3);
                    const unsigned q = half ? pk4_fp8(bf_hi(v[kb]), bf_hi(v[kb + 1]), bf_hi(v[kb + 2]), bf_hi(v[kb + 3])) : pk4_fp8(bf_lo(v[kb]), bf_lo(v[kb + 1]), bf_lo(v[kb + 2]), bf_lo(v[kb + 3]));
                    if (e == 0) o.x = q; else if (e == 1) o.y = q; else if (e == 2) o.z = q; else o.w = q; }
                *(u32x4*)(dst + half * 64 + w4 * 16) = o; }
    }
}

constexpr int RT_PART = 0, RT_SSX = 32768, RT_RSTD = RT_SSX + 2048, RT_HIST = RT_RSTD + 256, RT_BASE = RT_HIST + 128, RT_PE = RT_BASE + 128, RT_PRANK = RT_PE + 1024, RT_PGATE = RT_PRANK + 1024;
static_assert(RT_PGATE + 1024 <= BARW_OFF, "router LDS map");
static_assert(WS_END < 0x7ffffff0ull, "workspace must fit one 2 GiB buffer descriptor");
__device__ __forceinline__ void wrg_phase(const float* __restrict__ g, const float* __restrict__ rw, float* __restrict__ wrg) {
    for (int i = blockIdx.x * NTHREADS + threadIdx.x; i < 2 * DM * NE / 4; i += gridDim.x * NTHREADS) { const f32x4 w = ld4(rw + (size_t)i * 4); *(f32x4*)(wrg + (size_t)i * 4) = w * g[i >> 3]; }
}
template <bool XBF>   __device__ __forceinline__ void route_phase(LAS unsigned char* lds, const float* __restrict__ x1, const float* __restrict__ g, const float* __restrict__ wrg, const float* __restrict__ rb,
                                            bf16_t* __restrict__ hn, unsigned* gcnt, int* __restrict__ list, float* __restrict__ gate) {
    const int tid = ltid(), wid = __builtin_amdgcn_readfirstlane(tid >> 6), lane = tid & 63, i32 = lane & 31, kk = lane >> 5, tg = wid >> 2, kq = wid & 3;
    LAS float* part = (LAS float*)(lds + RT_PART); LAS float* ssx = (LAS float*)(lds + RT_SSX); LAS float* rstd_l = (LAS float*)(lds + RT_RSTD);
    LAS int* hist = (LAS int*)(lds + RT_HIST); LAS int* sbase = (LAS int*)(lds + RT_BASE);
    LAS int* pe = (LAS int*)(lds + RT_PE); LAS int* prank = (LAS int*)(lds + RT_PRANK); LAS float* pgate = (LAS float*)(lds + RT_PGATE);
    const float bias = rb[lane & 31];
    const int kbase = kq * 256 + kk * 128;
    for (int blk = blockIdx.x; blk < T / 64; blk += gridDim.x) {
        __syncthreads();
        if (tid < 32) hist[tid] = 0;
        const int tok = blk * 64 + tg * 32 + i32;
        f32x4 xr[32]; float ss = 0.f;
        if (XBF) { const bf16_t* xp = (const bf16_t*)x1 + (size_t)tok * DM + kbase; u32x4 xw[16];
#pragma unroll
            for (int q = 0; q < 16; ++q) xw[q] = *(const u32x4*)(xp + q * 8);
#pragma unroll
            for (int q = 0; q < 16; ++q) { xr[2 * q] = (f32x4){bf_lo(xw[q].x), bf_hi(xw[q].x), bf_lo(xw[q].y), bf_hi(xw[q].y)}; xr[2 * q + 1] = (f32x4){bf_lo(xw[q].z), bf_hi(xw[q].z), bf_lo(xw[q].w), bf_hi(xw[q].w)}; } }
        else { const float* xp = x1 + (size_t)tok * DM + kbase;
#pragma unroll
            for (int q = 0; q < 32; ++q) xr[q] = ld4(xp + q * 4); }
#pragma unroll
        for (int q = 0; q < 32; ++q) ss += xr[q][0] * xr[q][0] + xr[q][1] * xr[q][1] + xr[q][2] * xr[q][2] + xr[q][3] * xr[q][3];
        ssx[(tg * 32 + i32) * 8 + kq * 2 + kk] = ss;
        f32x16 D;
#pragma unroll
        for (int r = 0; r < 16; ++r) D[r] = 0.f;
        const float* wp = wrg + (size_t)kbase * NE + i32; asm volatile("" : "+v"(wp));
        float bA[16], bB[16];
#define RT_LDB(dst, c) _Pragma("unroll") for (int j = 0; j < 16; ++j) dst[j] = wp[((c) * 16 + j) * NE];
#define RT_MMA(src, c) _Pragma("unroll") for (int j = 0; j < 16; ++j) D = __builtin_amdgcn_mfma_f32_32x32x2f32(xr[(c) * 4 + (j >> 2)][j & 3], src[j], D, 0, 0, 0);
        RT_LDB(bA, 0)
        RT_LDB(bB, 1) asm volatile("" ::: "memory"); RT_MMA(bA, 0)
        RT_LDB(bA, 2) asm volatile("" ::: "memory"); RT_MMA(bB, 1)
        RT_LDB(bB, 3) asm volatile("" ::: "memory"); RT_MMA(bA, 2)
        RT_LDB(bA, 4) asm volatile("" ::: "memory"); RT_MMA(bB, 3)
        RT_LDB(bB, 5) asm volatile("" ::: "memory"); RT_MMA(bA, 4)
        RT_LDB(bA, 6) asm volatile("" ::: "memory"); RT_MMA(bB, 5)
        RT_LDB(bB, 7) asm volatile("" ::: "memory"); RT_MMA(bA, 6)
        RT_MMA(bB, 7)
#undef RT_LDB
#undef RT_MMA
#pragma unroll
        for (int r = 0; r < 16; ++r) part[(kq * 64 + tg * 32 + (r & 3) + 8 * (r >> 2) + 4 * kk) * 32 + i32] = D[r];
        __syncthreads();
        if (tid < 64) { float t = 0.f;
#pragma unroll
            for (int j = 0; j < 8; ++j) t += ssx[tid * 8 + j];
            rstd_l[tid] = rsqrtf(t * (1.0f / DM) + EPS); }
        __syncthreads();
        { const float rs = rstd_l[tg * 32 + i32]; unsigned char* hp = (unsigned char*)hn + (size_t)tok * DM + kbase; const float* gp = g + kbase; asm volatile("" : "+v"(gp));
#pragma unroll
          for (int q = 0; q < 8; ++q) { u32x4 o; unsigned ow[4];
#pragma unroll
              for (int t = 0; t < 4; ++t) { const f32x4 gq = ld4(gp + q * 16 + t * 4); const f32x4 a = xr[4 * q + t] * rs * gq; ow[t] = pk4_fp8(a[0], a[1], a[2], a[3]); }
              o.x = ow[0]; o.y = ow[1]; o.z = ow[2]; o.w = ow[3]; *(u32x4*)(hp + q * 16) = o; } }
        const int me = lane & 31;
#pragma unroll
        for (int i = 0; i < 8; ++i) {
            const int tl = wid * 8 + i;
            float logit = ((part[(0 * 64 + tl) * 32 + me] + part[(1 * 64 + tl) * 32 + me]) + (part[(2 * 64 + tl) * 32 + me] + part[(3 * 64 + tl) * 32 + me])) * rstd_l[tl] + bias;
            float tv[4]; int ti[4];
#pragma unroll
            for (int r = 0; r < 4; ++r) { float bv = logit; int bi = me;
#pragma unroll
                for (int msk = 1; msk < 32; msk <<= 1) { const float ov = __shfl_xor(bv, msk); const int oi = __shfl_xor(bi, msk); if (ov > bv || (ov == bv && oi < bi)) { bv = ov; bi = oi; } }
                tv[r] = bv; ti[r] = bi; if (me == bi) logit = -3.0e38f; }
            const float e1 = __expf(tv[1] - tv[0]), e2 = __expf(tv[2] - tv[0]), e3 = __expf(tv[3] - tv[0]); const float isum = 1.0f / (1.0f + e1 + e2 + e3);
            if (lane < 4) { const int e = lane == 0 ? ti[0] : lane == 1 ? ti[1] : lane == 2 ? ti[2] : ti[3];
                const float gt = (lane == 0 ? 1.0f : lane == 1 ? e1 : lane == 2 ? e2 : e3) * isum;
                const int rank = __hip_atomic_fetch_add(hist + e, 1, __ATOMIC_RELAXED, __HIP_MEMORY_SCOPE_WORKGROUP);
                const int pl = tl * 4 + lane; pe[pl] = e; prank[pl] = rank; pgate[pl] = gt; }
        }
        __syncthreads();
        if (tid < 32) sbase[tid] = (int)__hip_atomic_fetch_add(gcnt + tid * 64, (unsigned)hist[tid], __ATOMIC_RELAXED, __HIP_MEMORY_SCOPE_AGENT);
        __syncthreads();
        if (tid < 256) { const int e = pe[tid], slot = sbase[e] + prank[tid], pair = (blk * 64 + (tid >> 2)) * 4 + (tid & 3); list[(size_t)e * T + slot] = pair; gate[pair] = pgate[tid]; }
    }
}

__device__ __forceinline__ bool xcd_deal(int i, int nsplit_log2, int MT, int& gt, int& nj) {
    const int c = (int)blockIdx.x;
    if (gridDim.x == 256) { const int xcd = c & 7, sl = c >> 3; gt = ((i * 8 + xcd) << (5 - nsplit_log2)) + (sl >> nsplit_log2); nj = sl & ((1 << nsplit_log2) - 1); }
    else { const int idx = c + i * (int)gridDim.x; gt = idx >> nsplit_log2; nj = idx & ((1 << nsplit_log2) - 1); }
    return gt < MT;
}
struct UnitC { unsigned A, B0, B1; int row0, col0; };
template <class EpiT>
struct ProvDense {
    typedef UnitC Unit;
    int nt; unsigned offB[2]; unsigned oA0[2][2];
    unsigned A, B; unsigned ldaB, ldbB; int nN, nunits; int a_col_step;
    unsigned b_tile_step;
    int deal_first, deal_stride;
    int mt_per_grp; unsigned b_grp_step;
    EpiT E;
    __device__ __forceinline__ void init(int tid, size_t A_, unsigned ldaB_, size_t B_, unsigned K, int nN_, int nunits_, int a_col_step_, const EpiT& E_, int mt_per_grp_ = 1 << 30, unsigned b_grp_step_ = 0) {
        mt_per_grp = mt_per_grp_; b_grp_step = b_grp_step_; deal_first = 0; deal_stride = 0;
        int R[2], C[2]; stage_coords(tid, R, C); A = (unsigned)A_; B = (unsigned)B_; ldaB = ldaB_; ldbB = K * 2; nN = nN_; nunits = nunits_; a_col_step = a_col_step_; nt = (int)K / 64; b_tile_step = 256u * K * 2u; E = E_;
#pragma unroll
        for (int i = 0; i < 2; ++i) { oA0[0][i] = (unsigned)R[i] * ldaB + C[i] * 2; oA0[1][i] = (unsigned)(R[i] + 128) * ldaB + C[i] * 2; offB[i] = (unsigned)R[i] * ldbB + C[i] * 2; }
    }
    __device__ __forceinline__ bool next(int i, Unit& u) const {
        int mt, nj;
        if (deal_stride > 0) { const int idx = deal_first + i * deal_stride; if (deal_first < 0 || idx >= nunits) return false; mt = idx / nN; nj = idx - mt * nN; }
        else if (nN == 4) { if (!xcd_deal(i, 2, nunits >> 2, mt, nj)) return false; }
        else if (nN == 8) { if (!xcd_deal(i, 3, nunits >> 3, mt, nj)) return false; }
        else if (gridDim.x == 256 && (nN == 3 || nN == 6) && nunits == 64 * nN) {
            const int c = (int)blockIdx.x, u = (c >> 3) + 32 * i; if (u >= 8 * nN) return false; const int q = (nN == 3) ? u / 3 : u / 6; mt = (c & 7) * 8 + q; nj = u - q * nN; }
        else { const int idx = (int)blockIdx.x + i * (int)gridDim.x; if (idx >= nunits) return false; mt = idx / nN; nj = idx - mt * nN; }
        u.A = A + (unsigned)mt * 256u * ldaB + (unsigned)nj * (unsigned)a_col_step; u.B0 = B + (unsigned)(mt / mt_per_grp) * b_grp_step + (unsigned)nj * b_tile_step; u.B1 = u.B0 + 128u * ldbB; u.row0 = mt * 256; u.col0 = nj * 256; return true;
    }
    __device__ __forceinline__ void offs(const Unit&, unsigned (&oA)[2][2]) const { oA[0][0] = oA0[0][0]; oA[0][1] = oA0[0][1]; oA[1][0] = oA0[1][0]; oA[1][1] = oA0[1][1]; }
    __device__ __forceinline__ void epi(AccRef acc, const Unit& u, int wr, int wc, int fr, int fq) const { EpiT e = E; e.row0 = u.row0; e.col0 = u.col0; e(acc, wr, wc, fr, fq); }
};

constexpr int MO_CNT = MISC_OFF, MO_OFF = MISC_OFF + 128, MO_TP = MISC_OFF + 256, MO_TE = MISC_OFF + 512;
constexpr int MO_MAXT = 320;
constexpr int MO_DESC = MISC_OFF + 2048;
constexpr int MO_IDX = MISC_OFF + 2560;
constexpr int MO_MAXU = 12;
static_assert(MO_IDX + MO_MAXU * 1024 <= BARW_OFF, "MoE LDS map");
__device__ __forceinline__ void moe_setup(LAS unsigned char* lds, unsigned* gcnt) {
    LAS int* cnt = (LAS int*)(lds + MO_CNT); LAS int* off = (LAS int*)(lds + MO_OFF); LAS int* tp = (LAS int*)(lds + MO_TP); LAS int* te = (LAS int*)(lds + MO_TE);
    const int tid = threadIdx.x;
    __syncthreads();
    if (tid < 64) {
        const int e = tid & 31; const int c = (int)__hip_atomic_load(gcnt + e * 64, __ATOMIC_RELAXED, __HIP_MEMORY_SCOPE_AGENT); const int nt_ = (c + 255) >> 8;
        int so = c, st = nt_;
#pragma unroll
        for (int d = 1; d < 32; d <<= 1) { const int a = __shfl_up(so, d), b = __shfl_up(st, d); if ((tid & 31) >= d) { so += a; st += b; } }
        if (tid < 32) { cnt[e] = c; off[e] = so - c; tp[e] = st - nt_; if (e == 31) tp[32] = st;
            for (int m = 0; m < nt_; ++m) te[st - nt_ + m] = e; }
    }
    __syncthreads();
}
__device__ __forceinline__ void moe_descs(LAS unsigned char* lds, int nsplit_log2) {
    LAS int* cnt = (LAS int*)(lds + MO_CNT); LAS int* off = (LAS int*)(lds + MO_OFF); LAS int* tp = (LAS int*)(lds + MO_TP); LAS int* te = (LAS int*)(lds + MO_TE);
    LAS int* desc = (LAS int*)(lds + MO_DESC);
    const int tid = threadIdx.x;
    if (tid < 16) { int gt, nj;
        if (xcd_deal(tid, nsplit_log2, tp[32], gt, nj)) { const int e = te[gt], mt = gt - tp[e]; int nv = cnt[e] - mt * 256; nv = nv > 256 ? 256 : nv;
            desc[tid * 4 + 0] = e; desc[tid * 4 + 1] = mt; desc[tid * 4 + 2] = nv; desc[tid * 4 + 3] = off[e] + mt * 256; }
        else desc[tid * 4 + 0] = -1; }
    __syncthreads();
}
struct UnitM1 { unsigned A, B0, B1; const float* bg; unsigned char* act; int nv, ul; };
struct ProvMoe1 {
    typedef UnitM1 Unit;
    int nt; unsigned offB[2]; int R0, R1, C0, C1;
    LAS unsigned char* lds; unsigned hn, wgu; const float* bgu; unsigned char* actb; int nunits;
    __device__ __forceinline__ bool next(int i, Unit& u) const {
        int gt, n8; if (i >= MO_MAXU || !xcd_deal(i, 3, nunits >> 3, gt, n8)) return false;
        LAS const int* d = (LAS const int*)(lds + MO_DESC) + i * 4;
        const int e = __builtin_amdgcn_readfirstlane(d[0]), nv = __builtin_amdgcn_readfirstlane(d[2]), p0 = __builtin_amdgcn_readfirstlane(d[3]);
        u.A = hn; u.B0 = wgu + (unsigned)(e * 2048 + n8 * 128) * (unsigned)DM; u.B1 = u.B0 + 1024u * DM;
        u.bg = bgu + e * 2048 + n8 * 128; u.act = actb + (size_t)p0 * DFF + n8 * 128; u.nv = nv; u.ul = i; return true;
    }
    __device__ __forceinline__ void offs(const Unit& u, unsigned (&oA)[2][2]) const {
        LAS const unsigned* ix = (LAS const unsigned*)(lds + MO_IDX) + u.ul * 256;
        oA[0][0] = ix[R0] + C0 * 2; oA[0][1] = ix[R1] + C1 * 2; oA[1][0] = ix[128 + R0] + C0 * 2; oA[1][1] = ix[128 + R1] + C1 * 2;
    }
    __device__ __forceinline__ void epi(AccRef acc, const Unit& u, int wr, int wc, int fr, int fq) const { EpiMoe1 e{u.bg, u.bg + 1024, u.act, u.nv}; e(acc, wr, wc, fr, fq); }
};
__device__ __forceinline__ void moe_gemm1_phase(LAS unsigned char* lds, const __amdgpu_buffer_rsrc_t srd, unsigned hn, unsigned wgu, const float* __restrict__ bgu, const int* __restrict__ list, unsigned char* __restrict__ actb) {
    LAS int* tp = (LAS int*)(lds + MO_TP); LAS int* desc = (LAS int*)(lds + MO_DESC); LAS unsigned* ix = (LAS unsigned*)(lds + MO_IDX);
    const int tid = ltid();
    moe_descs(lds, 3);
    { int pr[MO_MAXU / 2];
#pragma unroll
      for (int k = 0; k < MO_MAXU / 2; ++k) { const int ul = 2 * k + (tid >> 8); const int e = desc[ul * 4 + 0], mt = desc[ul * 4 + 1], nv = desc[ul * 4 + 2]; const int row = tid & 255;
          pr[k] = (e >= 0) ? list[(size_t)e * T + mt * 256 + (row < nv ? row : 0)] : 0; }
#pragma unroll
      for (int k = 0; k < MO_MAXU / 2; ++k) { const int ul = 2 * k + (tid >> 8); ix[ul * 256 + (tid & 255)] = (unsigned)(pr[k] >> 2) * (unsigned)DM; } }
    __syncthreads();
    ProvMoe1 P; int R[2], C[2]; stage_coords(tid, R, C); P.R0 = R[0]; P.R1 = R[1]; P.C0 = C[0]; P.C1 = C[1];
    P.nt = DM / 128; P.offB[0] = (unsigned)R[0] * (unsigned)DM + C[0] * 2; P.offB[1] = (unsigned)R[1] * (unsigned)DM + C[1] * 2;
    P.lds = lds; P.hn = hn; P.wgu = wgu; P.bgu = bgu; P.actb = actb; P.nunits = tp[32] * 8;
    gemm_stream_f8(lds, srd, P);
}
struct UnitM2 { unsigned A, B0, B1; const float* bd; int nv, col0, ul; };
struct ProvMoe2 {
    typedef UnitM2 Unit;
    int nt; unsigned offB[2]; unsigned oA0[2][2];
    LAS unsigned char* lds; unsigned actb, wdn; const float* bdn; const int* list; const float* gate; bf16_t* slot; int nunits;
    __device__ __forceinline__ bool next(int i, Unit& u) const {
        int gt, n4; if (i >= 6 || !xcd_deal(i, 2, nunits >> 2, gt, n4)) return false;
        LAS const int* d = (LAS const int*)(lds + MO_DESC) + i * 4;
        const int e = __builtin_amdgcn_readfirstlane(d[0]), mt = __builtin_amdgcn_readfirstlane(d[1]), nv = __builtin_amdgcn_readfirstlane(d[2]), p0 = __builtin_amdgcn_readfirstlane(d[3]);
        u.A = actb + (unsigned)p0 * (unsigned)DFF; u.B0 = wdn + (unsigned)(e * 1024 + n4 * 256) * (unsigned)DFF; u.B1 = u.B0 + 128u * DFF;
        u.bd = bdn + e * DM; u.nv = nv; u.col0 = n4 * 256; u.ul = i; return true;
    }
    __device__ __forceinline__ void offs(const Unit&, unsigned (&oA)[2][2]) const { oA[0][0] = oA0[0][0]; oA[0][1] = oA0[0][1]; oA[1][0] = oA0[1][0]; oA[1][1] = oA0[1][1]; }
    __device__ __forceinline__ void epi(AccRef acc, const Unit& u, int wr, int wc, int fr, int fq) const { EpiMoe2 e{u.bd, (LAS const int*)(lds + MO_IDX) + u.ul * 512, (LAS const float*)(lds + MO_IDX) + u.ul * 512 + 256, slot, u.nv, u.col0}; e(acc, wr, wc, fr, fq); }
};
__device__ __forceinline__ void moe_gemm2_phase(LAS unsigned char* lds, const __amdgpu_buffer_rsrc_t srd, unsigned actb, unsigned wdn, const float* __restrict__ bdn, const int* __restrict__ list,
                                                const float* __restrict__ gate, bf16_t* __restrict__ slot, int layer, bf16_t* pp_out) {
    LAS int* tp = (LAS int*)(lds + MO_TP);
    const int tid = ltid();
    moe_descs(lds, 2);
    { LAS int* desc = (LAS int*)(lds + MO_DESC); LAS int* lp = (LAS int*)(lds + MO_IDX); LAS float* lg = (LAS float*)(lds + MO_IDX);
      int pr[3]; float gv[3];
#pragma unroll
      for (int k = 0; k < 3; ++k) { const int ul = 2 * k + (tid >> 8); const int e = desc[ul * 4 + 0], mt = desc[ul * 4 + 1], nv = desc[ul * 4 + 2]; const int row = tid & 255;
          pr[k] = (e >= 0) ? list[(size_t)e * T + mt * 256 + (row < nv ? row : 0)] : 0; }
#pragma unroll
      for (int k = 0; k < 3; ++k) gv[k] = gate[pr[k]];
#pragma unroll
      for (int k = 0; k < 3; ++k) { const int ul = 2 * k + (tid >> 8); lp[ul * 512 + (tid & 255)] = pr[k]; lg[ul * 512 + 256 + (tid & 255)] = gv[k]; }
      __syncthreads(); }
    ProvMoe2 P; int R[2], C[2]; stage_coords(tid, R, C); unsigned oB[2]; offs_contig(R, C, DFF, DFF, P.oA0, oB); P.offB[0] = oB[0]; P.offB[1] = oB[1];
    P.nt = DFF / 128; P.lds = lds; P.actb = actb; P.wdn = wdn; P.bdn = bdn; P.list = list; P.gate = gate; P.slot = slot; P.nunits = tp[32] * 4;
    gemm_stream_f8(lds, srd, P);
    {
        const int MT = tp[32], c = (int)blockIdx.x; int first, stride;
        if (gridDim.x == 256) { const int maxr = (MT + 63) >> 6, rem = MT - 64 * (maxr - 1), v = 8 * (c & 7) + (c >> 5);
            if (rem >= 64) { first = c; stride = 256; } else { stride = (64 - rem) * 4; first = v >= rem ? (v - rem) * 4 + ((c >> 3) & 3) : -1; } }
        else { first = c; stride = (int)gridDim.x; }
        ProvDense<EpiF8> Pv; Pv.init(ltid(), WS_PB + (size_t)layer * T * PLE * 2, PLE * 2, WS_WPP + (size_t)layer * 1024 * PLE * 2, PLE, 4, 256, 0, EpiF8{(unsigned char*)pp_out, DM, PP_SCALE, 0, 0}); Pv.deal_first = first; Pv.deal_stride = stride;
        gemm_stream(lds, srd, Pv);
    }
}

constexpr int AT_VB = 128 * 64, AT_KB = 64 * 192, AT_V0 = 0, AT_K0 = 2 * AT_VB, AT_WS = AT_K0 + 2 * AT_KB;
constexpr float AT_SCALE = 0.07216878364870322f;
constexpr float AT_THR = 3.0f, AT_PSH = 4.0f;
__device__ __forceinline__ int kswz(int row, int cb) { return row * 384 + (cb ^ (((row >> 1) & 7) << 4)); }
__device__ __forceinline__ int crow(int r, int hi) { return (r & 3) + 8 * (r >> 2) + 4 * hi; }
__device__ __forceinline__ int v_st(int k, int c) { const int kk = (k & ~0xC) | ((k & 4) << 1) | ((k & 8) >> 1); return ((kk >> 3) * 4 + (c >> 5)) * 512 + ((kk & 7) * 32 + (c & 31)) * 2; }
__device__ __forceinline__ int v_rd_base(int lane) { return ((lane & 3) << 3) | (((lane >> 2) & 3) << 6) | (((lane >> 4) & 1) << 5) | (((lane >> 5) & 1) << 8); }
constexpr int v_rd_off(int d0, int ks, int half) { return d0 * 512 + ks * 4096 + half * 2048; }
template <int OFF> __device__ __forceinline__ s16x4 tr_read(int vb) { s16x4 r; asm volatile("ds_read_b64_tr_b16 %0, %1 offset:%2" : "=&v"(r) : "v"(vb), "i"(OFF) : "memory"); return r; }
#define SBAR() __builtin_amdgcn_sched_barrier(0)

__device__ __forceinline__ void at_partialSM(f32x16& p0, f32x16& p1, float& m_reg, float& mn, float& alpha) {
    constexpr float C = AT_SCALE * 1.4426950408889634f;
    float pmax = p0[0];
#pragma unroll
    for (int r = 1; r < 16; ++r) pmax = fmaxf(pmax, p0[r]);
#pragma unroll
    for (int r = 0; r < 16; ++r) pmax = fmaxf(pmax, p1[r]);
    { auto rr = __builtin_amdgcn_permlane32_swap(__float_as_uint(pmax), __float_as_uint(pmax), false, false); pmax = fmaxf(__uint_as_float(rr[0]), __uint_as_float(rr[1])); }
    if (__builtin_expect(__all(pmax - m_reg <= AT_THR / AT_SCALE), 1)) { mn = m_reg; alpha = 1.f; }
    else { mn = fmaxf(m_reg, pmax); alpha = __builtin_amdgcn_exp2f((m_reg - mn) * C); m_reg = mn; }
    const float mnC = AT_PSH - mn * C;
    const f32x2 C2 = (f32x2){C, C}, M2 = (f32x2){mnC, mnC};
#pragma unroll
    for (int r = 0; r < 16; r += 2) { const f32x2 t = __builtin_elementwise_fma((f32x2){p0[r], p0[r + 1]}, C2, M2); p0[r] = t.x; p0[r + 1] = t.y; }
#pragma unroll
    for (int r = 0; r < 16; r += 2) { const f32x2 t = __builtin_elementwise_fma((f32x2){p1[r], p1[r + 1]}, C2, M2); p1[r] = t.x; p1[r + 1] = t.y; }
#pragma unroll
    for (int r = 0; r < 16; ++r) p0[r] = __builtin_amdgcn_exp2f(p0[r]);
}
__device__ __forceinline__ void at_qkt(f32x16& p0, f32x16& p1, const LAS unsigned char* Ks, const v8i32 (&q8)[3], const int kb0, const int kb1, bool masked) {
    if (masked) {
#pragma unroll
        for (int r = 0; r < 16; ++r) { p0[r] = -1.0e30f; p1[r] = -1.0e30f; }
        return;
    }
#pragma unroll
    for (int r = 0; r < 16; ++r) { p0[r] = 0.f; p1[r] = 0.f; }
#pragma unroll
    for (int d = 0; d < 3; ++d) {
        const u32x4 a0 = *(const LAS u32x4*)(Ks + kb0 + d * 64), a1 = *(const LAS u32x4*)(Ks + kb1 + d * 64);
        const u32x4 c0 = *(const LAS u32x4*)(Ks + kb0 + d * 64 + 32 * 192), c1 = *(const LAS u32x4*)(Ks + kb1 + d * 64 + 32 * 192);
        const v8i32 b0 = (v8i32){(int)a0.x, (int)a0.y, (int)a0.z, (int)a0.w, (int)a1.x, (int)a1.y, (int)a1.z, (int)a1.w};
        const v8i32 b1 = (v8i32){(int)c0.x, (int)c0.y, (int)c0.z, (int)c0.w, (int)c1.x, (int)c1.y, (int)c1.z, (int)c1.w};
        p0 = __builtin_amdgcn_mfma_scale_f32_32x32x64_f8f6f4(b0, q8[d], p0, 0, 0, 0, 0x7f7f7f7f, 0, 0x7f7f7f7f);
        p1 = __builtin_amdgcn_mfma_scale_f32_32x32x64_f8f6f4(b1, q8[d], p1, 0, 0, 0, 0x7f7f7f7f, 0, 0x7f7f7f7f);
        if (d == 0) __builtin_amdgcn_sched_barrier(0); }
}
__device__ __forceinline__ void at_finishSM(f32x16& p0, f32x16& p1, float alpha, float& l_reg, v8i32& pa) {
#pragma unroll
    for (int r = 0; r < 16; ++r) p1[r] = __builtin_amdgcn_exp2f(p1[r]);
    f32x2 s2 = (f32x2){p0[0], p0[1]} + (f32x2){p1[0], p1[1]};
#pragma unroll
    for (int r = 2; r < 16; r += 2) { s2 += (f32x2){p0[r], p0[r + 1]}; s2 += (f32x2){p1[r], p1[r + 1]}; }
    float ps = s2.x + s2.y;
    { auto rr = __builtin_amdgcn_permlane32_swap(__float_as_uint(ps), __float_as_uint(ps), false, false); ps = __uint_as_float(rr[0]) + __uint_as_float(rr[1]); }
    l_reg = l_reg * alpha + ps;
#define PK4U(P, B, I) { int w_ = pa[I]; w_ = __builtin_amdgcn_cvt_pk_fp8_f32(P[B], P[B + 1], w_, false); w_ = __builtin_amdgcn_cvt_pk_fp8_f32(P[B + 2], P[B + 3], w_, true); pa[I] = w_; }
    PK4U(p0, 0, 0) PK4U(p0, 4, 1) PK4U(p0, 8, 2) PK4U(p0, 12, 3) PK4U(p1, 0, 4) PK4U(p1, 4, 5) PK4U(p1, 8, 6) PK4U(p1, 12, 7)
#undef PK4U
}
__device__ __forceinline__ void at_pv(f32x16 (&o)[4], const LAS unsigned char* Vs, const int vb0, const int vb1, const v8i32 pa) {
#pragma unroll
    for (int d0 = 0; d0 < 4; ++d0) {
        const u32x4 a0 = *(const LAS u32x4*)(Vs + vb0 + d0 * 2048), a1 = *(const LAS u32x4*)(Vs + vb1 + d0 * 2048);
        const v8i32 vf = (v8i32){(int)a0.x, (int)a0.y, (int)a0.z, (int)a0.w, (int)a1.x, (int)a1.y, (int)a1.z, (int)a1.w};
        o[d0] = __builtin_amdgcn_mfma_scale_f32_32x32x64_f8f6f4(pa, vf, o[d0], 0, 0, 0, 0x7f7f7f7f, 0, 0x7f7f7f7f); }
}
constexpr int AT_WT = 45056, WC_PITCH = 1040, WC_GU = 32 * 128, WC_ALL = WC_GU + 32 * 64;
static_assert(AT_WT + 64 * WC_PITCH <= MISC_OFF, "attention LDS map");
struct WConv { int i, ph, pend; };
__device__ __forceinline__ void wc_issue(LAS unsigned char* lds, const float* gu1, const float* dn1, const int u, const int wid, const int lane) {
    const bool dn = u >= WC_GU; const int v = dn ? u - WC_GU : u;
    const int mat = dn ? v >> 6 : v >> 7, tn = dn ? (v >> 4) & 3 : (v >> 4) & 7, tk = v & 15, N = dn ? 1024 : 2048;
    const __amdgpu_buffer_rsrc_t sw = __builtin_amdgcn_make_buffer_rsrc((void*)(dn ? dn1 : gu1), (short)0, 0x7ffffff0, 0x00020000);
    const unsigned so = (unsigned)((mat * 1024 + tk * 64 + wid * 8) * N + tn * 256) * 4u;
#pragma unroll
    for (int r = 0; r < 8; ++r) __builtin_amdgcn_raw_ptr_buffer_load_lds(sw, (LAS unsigned*)(lds + AT_WT + (wid * 8 + r) * WC_PITCH), 16, lane * 16, (int)(so + (unsigned)(r * N) * 4u), 0, 0);
}
__device__ __forceinline__ void wc_consume(LAS unsigned char* lds, unsigned char* ws, const int u) {
    int tz = threadIdx.x; asm volatile("" : "+v"(tz));
    const int nl = tz >> 1, kh = (tz & 1) * 32;
    const bool dn = u >= WC_GU; const int v = dn ? u - WC_GU : u;
    const int mat = dn ? v >> 6 : v >> 7, tn = dn ? (v >> 4) & 3 : (v >> 4) & 7, tk = v & 15;
    const size_t d0 = dn ? WS_WDN + ((size_t)(32 + mat) * 1024 + tn * 256) * 1024 + tk * 64 : WS_WGU + ((size_t)(32 + mat) * 2048 + tn * 256) * 1024 + tk * 64;
    LAS const float* tile = (LAS const float*)(lds + AT_WT);
    float w[32];
#pragma unroll
    for (int j = 0; j < 32; ++j) w[j] = tile[(kh + j) * 260 + nl] * 32.0f;
    unsigned char* d = ws + d0 + (size_t)nl * 1024 + kh;
#pragma unroll
    for (int q = 0; q < 2; ++q) { u32x4 o; o.x = pk4_fp8(w[q * 16 + 0], w[q * 16 + 1], w[q * 16 + 2], w[q * 16 + 3]); o.y = pk4_fp8(w[q * 16 + 4], w[q * 16 + 5], w[q * 16 + 6], w[q * 16 + 7]);
        o.z = pk4_fp8(w[q * 16 + 8], w[q * 16 + 9], w[q * 16 + 10], w[q * 16 + 11]); o.w = pk4_fp8(w[q * 16 + 12], w[q * 16 + 13], w[q * 16 + 14], w[q * 16 + 15]); *(u32x4*)(d + q * 16) = o; }
}
__device__ __forceinline__ void attn_unit(LAS unsigned char* lds, const __amdgpu_buffer_rsrc_t srd, const bf16_t* __restrict__ Qb, const float* __restrict__ csb, const float* __restrict__ qhn, const unsigned Koff, const unsigned Voff, bf16_t* __restrict__ Ob, const int qb, WConv& wc, const float* gu1, const float* dn1, unsigned char* ws) {
    const int tid = ltid(), wid = __builtin_amdgcn_readfirstlane(tid >> 6), lane = tid & 63, r32 = lane & 31, hi = lane >> 5;
    LAS unsigned char* V_lds = lds + AT_V0; LAS unsigned char* K_lds = lds + AT_K0;
    LAS float* wsf = (LAS float*)(lds + AT_WS) + wid * 64; LAS float* li_l = wsf; LAS float* al_l = wsf + 32;
    float m_reg = -1e30f, l_reg = 0; f32x16 o[4]; v8i32 q8[3];
    { const bf16_t* Qw = Qb + (size_t)(wid * 32 + r32) * (NH * QKD) + hi * 8;
      u32x4 qraw[12]; unsigned qd[24]; float ss = 0.f;
#pragma unroll
      for (int d0 = 0; d0 < 12; ++d0) qraw[d0] = *(const u32x4*)(Qw + d0 * 16);
      const float* csr = csb + (size_t)(wid * 32 + r32) * 64 + hi * 16;
#pragma unroll
      for (int d0 = 0; d0 < 12; ++d0) { const u32x4 w = qraw[d0];
          ss += bf_lo(w.x) * bf_lo(w.x) + bf_hi(w.x) * bf_hi(w.x) + bf_lo(w.y) * bf_lo(w.y) + bf_hi(w.y) * bf_hi(w.y) + bf_lo(w.z) * bf_lo(w.z) + bf_hi(w.z) * bf_hi(w.z) + bf_lo(w.w) * bf_lo(w.w) + bf_hi(w.w) * bf_hi(w.w); }
      ss += __shfl_xor(ss, 32);
      const float rstd = rsqrtf(ss * (1.0f / QKD) + EPS);
#define Q_UNPACK(dst, src_) { const u32x4 t_ = (src_); dst[0] = bf_lo(t_.x); dst[1] = bf_hi(t_.x); dst[2] = bf_lo(t_.y); dst[3] = bf_hi(t_.y); dst[4] = bf_lo(t_.z); dst[5] = bf_hi(t_.z); dst[6] = bf_lo(t_.w); dst[7] = bf_hi(t_.w); }
#define Q_PACK(d0, v) { qd[2 * (d0)] = pk4_fp8(v[0], v[1], v[2], v[3]); qd[2 * (d0) + 1] = pk4_fp8(v[4], v[5], v[6], v[7]); }
#pragma unroll
      for (int d0 = 0; d0 < 8; ++d0) { float v[8]; Q_UNPACK(v, qraw[d0]) const f32x4 g0 = ld4(qhn + d0 * 16 + hi * 8), g1 = ld4(qhn + d0 * 16 + hi * 8 + 4);
#pragma unroll
          for (int j = 0; j < 4; ++j) { v[j] *= rstd * g0[j]; v[4 + j] *= rstd * g1[j]; }
          Q_PACK(d0, v) if (d0 & 1) asm volatile("" ::: "memory"); }
#pragma unroll
      for (int dd = 0; dd < 2; ++dd) {
          float x1[8], x2[8]; Q_UNPACK(x1, qraw[8 + dd]) Q_UNPACK(x2, qraw[10 + dd])
          const f32x4 ga = ld4(qhn + (8 + dd) * 16 + hi * 8), gb = ld4(qhn + (8 + dd) * 16 + hi * 8 + 4), gc = ld4(qhn + (10 + dd) * 16 + hi * 8), gd = ld4(qhn + (10 + dd) * 16 + hi * 8 + 4);
#pragma unroll
          for (int j = 0; j < 8; ++j) { const float g1_ = j < 4 ? ga[j & 3] : gb[j & 3], g2_ = j < 4 ? gc[j & 3] : gd[j & 3];
              const float a = x1[j] * rstd * g1_, b = x2[j] * rstd * g2_;
              const f32x2 cv = *(const f32x2*)(csr + dd * 32 + j * 2); const float cs = cv.x, sn = cv.y;
              x1[j] = a * cs - b * sn; x2[j] = b * cs + a * sn; }
          Q_PACK(8 + dd, x1) Q_PACK(10 + dd, x2) asm volatile("" ::: "memory"); }
#undef Q_UNPACK
#undef Q_PACK
#pragma unroll
      for (int d = 0; d < 3; ++d) q8[d] = (v8i32){(int)qd[8 * d + 0], (int)qd[8 * d + 1], (int)qd[8 * d + 2], (int)qd[8 * d + 3], (int)qd[8 * d + 4], (int)qd[8 * d + 5], (int)qd[8 * d + 6], (int)qd[8 * d + 7]};
    }
    asm volatile("" ::: "memory");
#pragma unroll
    for (int d = 0; d < 4; ++d)
#pragma unroll
        for (int r = 0; r < 16; ++r) o[d][r] = 0.f;
    const int NT = 4 * qb + 4, vis = 4 * qb + (wid >> 1);
#define SDMA(k0, kbuf, vbuf) do { int lz_ = lane; asm volatile("" : "+v"(lz_)); unsigned kofs[2], vofs[2]; \
    _Pragma("unroll") for (int _i = 0; _i < 2; ++_i) { const int p = (_i * 8 + wid) * 64 + lz_, row = p / 12, ps = p - row * 12; kofs[_i] = (unsigned)(row * 192 + (((ps & ~3) | ((ps & 3) ^ ((row >> 2) & 3))) << 4)); } \
    { const int p = wid * 64 + lz_, dr = p >> 2, ps = p & 3; vofs[0] = (unsigned)(dr * 64 + ((ps ^ ((dr >> 2) & 3)) << 4)); vofs[1] = 0; } \
    __builtin_amdgcn_raw_ptr_buffer_load_lds(srd, (LAS unsigned*)(K_lds + (kbuf) * AT_KB + wid * 1024), 16, (int)kofs[0], (int)(Koff + (unsigned)(k0) * 192u), 0, 0); \
    if (wid < 4) __builtin_amdgcn_raw_ptr_buffer_load_lds(srd, (LAS unsigned*)(K_lds + (kbuf) * AT_KB + (8 + wid) * 1024), 16, (int)kofs[1], (int)(Koff + (unsigned)(k0) * 192u), 0, 0); \
    __builtin_amdgcn_raw_ptr_buffer_load_lds(srd, (LAS unsigned*)(V_lds + (vbuf) * AT_VB + wid * 1024), 16, (int)vofs[0], (int)(Voff + (unsigned)(k0) * 128u), 0, 0); } while (0)
#define RESC(a) do { if (__any((a) < 1.f)) { if (hi == 0) al_l[r32] = (a); asm volatile("s_waitcnt lgkmcnt(0)" ::: "memory"); \
    _Pragma("unroll") for (int d = 0; d < 4; ++d) _Pragma("unroll") for (int r = 0; r < 16; ++r) o[d][r] *= al_l[crow(r, hi)]; } } while (0)
    f32x16 p0, p1; float mn, al; v8i32 pa = (v8i32){0, 0, 0, 0, 0, 0, 0, 0};
    SDMA(0, 0, 0); asm volatile("s_waitcnt vmcnt(0)" ::: "memory"); __syncthreads();
    for (int j = 0; j < NT; ++j) {
        const int cur = j & 1;
        if (wc.ph == 3 && wc.pend >= 0) { wc_consume(lds, ws, wc.pend); wc.pend = -1; }
        SBAR();
        int lq_ = lane; asm volatile("" : "+v"(lq_));
        const int rq_ = lq_ & 31, hq_ = lq_ >> 5, kx = (rq_ >> 2) & 3, kb0 = rq_ * 192 + (((2 * hq_) ^ kx) << 4), kb1 = rq_ * 192 + (((2 * hq_ + 1) ^ kx) << 4);
        const int vb0 = rq_ * 64 + (((2 * hq_) ^ kx) << 4), vb1 = rq_ * 64 + (((2 * hq_ + 1) ^ kx) << 4);
        if (j <= vis) {
            at_qkt(p0, p1, K_lds + cur * AT_KB, q8, kb0, kb1, false); }
        if (j + 1 < NT) SDMA((j + 1) * 64, cur ^ 1, cur ^ 1);
        bool wiss = false;
        if (wc.ph == 0) { const int u = (int)blockIdx.x + (int)gridDim.x * wc.i; if (u < WC_ALL) { int lw_ = lane; asm volatile("" : "+v"(lw_)); wc_issue(lds, gu1, dn1, u, wid, lw_); wc.pend = u; ++wc.i; wiss = true; } }
        wc.ph = wc.ph == 4 ? 0 : wc.ph + 1;
        SBAR();
        if (j <= vis) {
            at_partialSM(p0, p1, m_reg, mn, al);
            RESC(al);
            at_finishSM(p0, p1, al, l_reg, pa); SBAR();
            at_pv(o, V_lds + cur * AT_VB, vb0, vb1, pa); }
        if (wiss) asm volatile("s_waitcnt vmcnt(8) lgkmcnt(0)" ::: "memory");
        else asm volatile("s_waitcnt vmcnt(0) lgkmcnt(0)" ::: "memory");
        __builtin_amdgcn_s_barrier();
        asm volatile("" ::: "memory");
    }
    if (hi == 0) li_l[r32] = l_reg; asm volatile("s_waitcnt lgkmcnt(0)" ::: "memory");
    { int tz = threadIdx.x; asm volatile("" : "+v"(tz));
      const int lz = tz & 63, rz = lz & 31, hz = lz >> 5; const unsigned loff = (unsigned)(hz * 4 * DM + rz);
      unsigned char* Ow = (unsigned char*)Ob + (size_t)(wid * 32) * DM;
#pragma unroll
      for (int r = 0; r < 16; ++r) { const int rb = (r & 3) + 8 * (r >> 2); const float rl = __builtin_amdgcn_rcpf(li_l[rb + 4 * hz]) * 32.0f;
          unsigned char* Or = Ow + (size_t)rb * DM;
#pragma unroll
          for (int d0 = 0; d0 < 4; ++d0) { const float v = __builtin_amdgcn_fmed3f(o[d0][r] * rl, -440.0f, 440.0f); Or[loff + d0 * 32] = (unsigned char)(__builtin_amdgcn_cvt_pk_fp8_f32(v, 0.f, 0, false) & 0xff); } } }
    __syncthreads();
#undef SDMA
#undef RESC
}
__device__ __forceinline__ void attn_phase(LAS unsigned char* lds, const __amdgpu_buffer_rsrc_t srd, const bf16_t* __restrict__ qf, const float* __restrict__ cs, const float* __restrict__ qhn, bf16_t* __restrict__ O,
                                           const float* gu1, const float* dn1, unsigned char* ws) {
    WConv wc; wc.i = 0; wc.ph = (int)(blockIdx.x % 5u); wc.pend = -1;
    for (int u = blockIdx.x; u < 256; u += gridDim.x) {
        const int bh = 2 * (u & 7) + ((u >> 3) >> 4), pi = (u >> 3) & 15, b = bh >> 3, h = bh & 7;
        const unsigned Koff = (unsigned)(WS_K + (size_t)bh * SEQ * QKD), Voff = (unsigned)(WS_V + (size_t)bh * SEQ * VD);
#pragma unroll 1
        for (int half = 0; half < 2; ++half) {
            const int qb = half == 0 ? 31 - pi : pi; const size_t row0 = (size_t)b * SEQ + qb * 256;
            attn_unit(lds, srd, qf + row0 * (NH * QKD) + h * QKD, cs + row0 * 64, qhn, Koff, Voff, (bf16_t*)((unsigned char*)O + row0 * DM + h * VD), qb, wc, gu1, dn1, ws);
        }
    }
    asm volatile("s_waitcnt vmcnt(0)" ::: "memory"); __syncthreads();
    if (wc.pend >= 0) { wc_consume(lds, ws, wc.pend); wc.pend = -1; }
    for (;;) { const int u = (int)blockIdx.x + (int)gridDim.x * wc.i; if (u >= WC_ALL) break;
        __syncthreads();
        { const int tz = ltid(); wc_issue(lds, gu1, dn1, u, __builtin_amdgcn_readfirstlane(tz >> 6), tz & 63); }
        asm volatile("s_waitcnt vmcnt(0)" ::: "memory"); __syncthreads();
        wc_consume(lds, ws, u); ++wc.i; }
}

#ifndef PH_MASK
#define PH_MASK 0x7FFFF
#endif
typedef const __attribute__((address_space(4))) Params* ParamsK;
__device__ __forceinline__ ParamsK phase_params() { ParamsK q = (ParamsK)__builtin_amdgcn_kernarg_segment_ptr(); asm volatile("" : "+s"(q)); return q; }
#define PIN(i) (pq_->in[i])
#define WSP(T_, OFF) ((T_*)(pq_->ws + (OFF)))
#define WGU WSP(bf16_t, WS_WGU)
#define WDN WSP(bf16_t, WS_WDN)
#define WPG WSP(bf16_t, WS_WPG)
#define WPP WSP(bf16_t, WS_WPP)
#define WPOOL WSP(bf16_t, WS_WPOOL)
#define WIN WSP(bf16_t, WS_WIN)
#define WQB WSP(bf16_t, WS_WQB)
#define WKVB WSP(bf16_t, WS_WKVB)
#define WO WSP(bf16_t, WS_WO)
#define PB WSP(bf16_t, WS_PB)
#define PP WSP(bf16_t, WS_PP)
#define AB WSP(bf16_t, WS_AB)
#define X1 WSP(float, WS_X1)
#define X2 WSP(bf16_t, WS_X2)
#define X3 WSP(float, WS_X3)
#define HN WSP(bf16_t, WS_HN)
#define ACT WSP(bf16_t, WS_ACT)
#define SLOT WSP(bf16_t, WS_SLOT)
#define LIST WSP(int, WS_LIST)
#define GATE WSP(float, WS_GATE)
#define LAT WSP(float, WS_LAT)
#define QN WSP(bf16_t, WS_QN)
#define KVN WSP(bf16_t, WS_KVN)
#define QF WSP(bf16_t, WS_QF)
#define KVF WSP(bf16_t, WS_KVF)
#define QB WSP(bf16_t, WS_Q)
#define KB WSP(bf16_t, WS_K)
#define VB WSP(bf16_t, WS_V)
#define CTLW WSP(unsigned, WS_CTL)

__global__ void __launch_bounds__(NTHREADS, 2) mk_fwd(Params P) {
    extern __shared__ __attribute__((aligned(16))) unsigned char lds_raw[];
    LAS unsigned char* lds = (LAS unsigned char*)lds_raw;
    const int tid = threadIdx.x;
    const int lo = P.ph_lo, hi = P.ph_hi;
    const bool multi = (hi - lo) > 1;
    if (tid == 0) { *(volatile LAS unsigned*)(lds + BARW_OFF) = 0u; *(volatile LAS unsigned*)(lds + BARW_OFF + 4) = 0u; }
    __syncthreads();
    XcdBarrier bar; bar.bar = (unsigned*)(P.ws + WS_CTL); bar.x = 0; bar.st = (volatile LAS unsigned*)(lds + BARW_OFF);
    if (multi) bar = xcd_barrier_post((unsigned*)(P.ws + WS_CTL), (volatile LAS unsigned*)(lds + BARW_OFF));
#define IN(k) ((((PH_MASK) >> (k)) & 1) && lo <= (k) && (k) < hi)
#define SEAM(k) do { if (IN(k) && IN((k) + 1)) xcd_barrier(bar); } while (0)
#define SRD_WS __builtin_amdgcn_make_buffer_rsrc((void*)pq_->ws, (short)0, 0x7ffffff0, 0x00020000)
#define PHASE(k, ...) if (IN(k)) { ParamsK pq_ = phase_params(); __VA_ARGS__ }

    PHASE(0,
        int rot = 0;
        transpose_seg_f8<2048, 1024>(lds, PIN(I_W_GU), WSP(unsigned char, WS_WGU), 32, rot);
        transpose_seg_f8<1024, 1024>(lds, PIN(I_W_DN), WSP(unsigned char, WS_WDN), 32, rot);
        transpose_seg_f8<1024, 1024>(lds, PIN(I_PLE_GATE_W), WSP(unsigned char, WS_WPG), 1, rot, PIN(I_PLE_NORM));
        transpose_seg_f8<1024, 1024>(lds, PIN(I_PLE_GATE_W) + (size_t)1024 * 1024, WSP(unsigned char, WS_WPG) + (size_t)1024 * 1024, 1, rot, PIN(I_PLE_NORM) + DM);
        transpose_seg<1024, 256>(lds, PIN(I_PLE_PROJ_W), WPP, 2, rot);
        transpose_seg<256, 256>(lds, PIN(I_POOL_W), WPOOL, 4, rot);
        transpose_seg_f8<704, 1024>(lds, PIN(I_W_IN), WSP(unsigned char, WS_WIN), 1, rot, PIN(I_NORM_MIX) + DM);
        transpose_seg<1536, 384>(lds, PIN(I_W_QB), WQB, 1, rot, PIN(I_Q_NORM));
        transpose_seg_f8<2048, 256>(lds, PIN(I_W_KVB), WSP(unsigned char, WS_WKVB), 1, rot, PIN(I_KV_NORM));
        transpose_seg_f8<1024, 1024>(lds, PIN(I_W_O), WSP(unsigned char, WS_WO), 1, rot);
        cvt_p_phase(PIN(I_P), PB);
        rope_table_phase((const int*)PIN(I_POS), WSP(float, WS_CS));
        wrg_phase(PIN(I_NORM_FFN), PIN(I_ROUTER_W), WSP(float, WS_WRG));
        pool_diff_phase(lds, PIN(I_X), PIN(I_NORM_MIX), AB);)
    SEAM(0);
    PHASE(1,
        { ProvDense<EpiPool> Pv; Pv.init(ltid(), WS_AB, DM * 2, WS_WPOOL, 256, 4, 256, 512, EpiPool{PIN(I_X), PIN(I_POOL_SCALE), X1, 0, 0}); gemm_stream(lds, SRD_WS, Pv); }
        )
    SEAM(1);
#define ROUTE_CALL(L, XIN) route_phase<true>(lds, XIN, PIN(I_NORM_FFN) + (L) * DM, WSP(float, WS_WRG) + (size_t)(L) * DM * NE, PIN(I_ROUTER_B) + (L) * NE, HN, CTLW + CW_GCNT + (L) * 32 * 64, LIST, GATE)
#define MOE_PLE_LAYER(L, PH, XIN, XOUT) \
    if (IN(PH)) { ParamsK pq_ = phase_params(); ROUTE_CALL(L, XIN); } \
    SEAM(PH); \
    PHASE((PH) + 1, moe_setup(lds, CTLW + CW_GCNT + (L) * 32 * 64); \
        moe_gemm1_phase(lds, SRD_WS, (unsigned)WS_HN, (unsigned)(WS_WGU + (size_t)(L) * 32 * 2048 * DM), PIN(I_B_GU) + (size_t)(L) * 32 * 2048, LIST, WSP(unsigned char, WS_ACT));) \
    SEAM((PH) + 1); \
    PHASE((PH) + 2, moe_setup(lds, CTLW + CW_GCNT + (L) * 32 * 64); \
        moe_gemm2_phase(lds, SRD_WS, (unsigned)WS_ACT, (unsigned)(WS_WDN + (size_t)(L) * 32 * 1024 * DFF), PIN(I_B_DN) + (size_t)(L) * 32 * DM, LIST, GATE, SLOT, (L), PP + (size_t)(L) * T * DM);) \
    SEAM((PH) + 2); \
    PHASE((PH) + 3, combine_phase<true>(XIN, SLOT, X2, WSP(unsigned char, WS_AB), WSP(float, WS_QN));) \
    SEAM((PH) + 3); \
    PHASE((PH) + 4, ProvDense<EpiPle<(L) == 0> > Pv; Pv.init(ltid(), WS_AB, DM, WS_WPG + (size_t)(L) * 1024 * DM, DM / 2  , 4, 256, 0, EpiPle<(L) == 0>{X2, WSP(float, WS_QN), (const unsigned char*)(PP + (size_t)(L) * T * DM), XOUT, HN, WSP(float, WS_STAT), WSP(unsigned char, WS_ACT)  , 0, 0}); gemm_stream_f8(lds, SRD_WS, Pv);)

    MOE_PLE_LAYER(0, 2, X1, X3)
    SEAM(6);
    PHASE(8, ProvDense<EpiLat> Pv; Pv.init(ltid(), WS_ACT  , DM, WS_WIN, DM / 2  , 3, 192, 0, EpiLat{WSP(float, WS_STAT), WSP(bf16_t, WS_LAT), WSP(float, WS_STAT) + (size_t)T * 16, WSP(float, WS_STAT) + (size_t)T * 32, WSP(unsigned char, WS_ACT + (size_t)T * DM), 0, 0}); gemm_stream_f8(lds, SRD_WS, Pv);)
    SEAM(8);
    PHASE(10,
        { ProvDense<EpiBf16S> Pv; Pv.init(ltid(), WS_LAT, LATP * 2, WS_WQB, QL, 6, 384, 0, EpiBf16S{QF, NH * QKD, WSP(float, WS_STAT) + (size_t)T * 16, 3, 1.0f / QL, 0, 0}); gemm_stream(lds, SRD_WS, Pv); }
        { ProvDense<EpiKV> Pv; Pv.init(ltid(), WS_ACT + (size_t)T * DM  , KVL, WS_WKVB, KVL / 2  , 8, 512, 0, EpiKV{KVF, WSP(float, WS_STAT) + (size_t)T * 32, pq_->ws + WS_V, 0, 0}); gemm_stream_f8(lds, SRD_WS, Pv); })
    SEAM(10);
    PHASE(11, k_finalize_phase(KVF, WSP(bf16_t, WS_LAT), WSP(float, WS_CS), PIN(I_KH_NORM), KB);)
    SEAM(11);
    PHASE(12, attn_phase(lds, SRD_WS, QF, WSP(float, WS_CS), PIN(I_QH_NORM), AB, PIN(I_W_GU) + (size_t)32 * 1024 * 2048, PIN(I_W_DN) + (size_t)32 * 1024 * 1024, pq_->ws);)
    SEAM(12);
    PHASE(13, ProvDense<EpiRes> Pv; Pv.init(ltid(), WS_AB, DM, WS_WO, DM / 2  , 4, 256, 0, EpiRes{HN, (bf16_t*)X1, 0, 0}); gemm_stream_f8<ProvDense<EpiRes>, 0x7a7a7a7a>(lds, SRD_WS, Pv);)
    SEAM(13);
    MOE_PLE_LAYER(1, 14, X1, pq_->out)
#undef IN
#undef SEAM
}

extern "C" void kernel_launch(void* const* d_in, const int* in_sizes, int n_in, void* d_out, int out_size, void* d_ws, size_t ws_size, hipStream_t stream) {
    static int grid = 0;
    if (grid == 0) {
        if (n_in != N_IN || out_size != T * DM || ws_size < WS_END) { fprintf(stderr, "kernel_launch: shape/workspace mismatch (n_in %d out %d ws %zu need %zu)\n", n_in, out_size, ws_size, (size_t)WS_END); grid = -1; return; }
        int dev = 0, cus = 0, per_cu = 0;
        if (hipGetDevice(&dev) != hipSuccess || hipDeviceGetAttribute(&cus, hipDeviceAttributeMultiprocessorCount, dev) != hipSuccess) { grid = -1; return; }
        if (hipFuncSetAttribute((const void*)mk_fwd, hipFuncAttributeMaxDynamicSharedMemorySize, LDS_BYTES) != hipSuccess) { fprintf(stderr, "kernel_launch: hipFuncSetAttribute failed\n"); grid = -1; return; }
        if (hipOccupancyMaxActiveBlocksPerMultiprocessor(&per_cu, (const void*)mk_fwd, NTHREADS, LDS_BYTES) != hipSuccess || per_cu < 1) { fprintf(stderr, "kernel_launch: occupancy query says %d\n", per_cu); (void)hipGetLastError(); grid = -1; return; }
        grid = cus;
    }
    if (grid < 0) return;
    (void)in_sizes;
    hipMemsetAsync((char*)d_ws + WS_CTL, 0, CTL_BYTES, stream);
    Params p{};
    for (int i = 0; i < N_IN; ++i) p.in[i] = (const float*)d_in[i];
    p.out = (float*)d_out; p.ws = (unsigned char*)d_ws;
#if MK_MULTI
    for (int ph = 0; ph < NPHASE; ++ph) { p.ph_lo = ph; p.ph_hi = ph + 1; hipLaunchKernelGGL(mk_fwd, dim3(grid), dim3(NTHREADS), LDS_BYTES, stream, p); }
#else
    p.ph_lo = 0; p.ph_hi = NPHASE; hipLaunchKernelGGL(mk_fwd, dim3(grid), dim3(NTHREADS), LDS_BYTES, stream, p);
#endif
}
```
